# Optimizing an MI355X kernel written in HIP

```python
import jax
import jax.numpy as jnp
from jax import lax
import numpy as np


D_MODEL = 2048
BATCH = 4
SEQ = 4096
DEPTH = 1

GRID_W = 64
CTX_LEN = 256
RET_HEADS = 8
RET_DK = 128
RET_DV = 256
RET_CHUNK = 128
ROPE_AXIS_DIM = RET_DK // 2
ROPE_BASE = 10000.0
NA_HEADS = 16
NA_DH = 128
NA_KR_MAX = 8
NA_KC = 16
NA_QCB = NA_KC
NA_KCB = 2 * NA_KC
N_EXPERTS = 32
TOP_K = 4
D_FF = 2048
MOE_BLOCK = 128
SWIGLU_ALPHA = 1.702
SWIGLU_LIMIT = 7.0
NORM_EPS = 1e-6
GN_EPS = 1e-5
NEG_INF = -1e30
RET_QK_W = RET_HEADS * RET_DK
RET_V_W = RET_HEADS * RET_DV
NA_W = NA_HEADS * NA_DH
IN_SPLITS = (RET_QK_W, RET_QK_W, RET_V_W, RET_V_W, NA_W, NA_W, NA_W, D_MODEL, D_MODEL)
IN_W = sum(IN_SPLITS)

kernel_name = 'hybrid_retention_natten_moe_dit'


def rmsnorm(x, g):
    xf = x.astype(jnp.float32)
    y = xf * lax.rsqrt(jnp.mean(xf * xf, axis=-1, keepdims=True) + NORM_EPS)
    return (y * g.astype(jnp.float32)).astype(x.dtype)


def modulate(h, shift, scale):
    return h * (1.0 + scale) + shift


def split_heads(t, n_heads):
    b, n, w = t.shape
    return t.reshape(b, n, n_heads, w // n_heads).transpose(0, 2, 1, 3)


def flip(t):
    return t[:, :, ::-1]


def axial_rope_tables(n):
    t = jnp.arange(n)
    row = (t // GRID_W).astype(jnp.float32)
    col = (t % GRID_W).astype(jnp.float32)
    inv = ROPE_BASE ** (-jnp.arange(0, ROPE_AXIS_DIM, 2, dtype=jnp.float32) / ROPE_AXIS_DIM)
    ang = jnp.stack([row[:, None] * inv, col[:, None] * inv], axis=1)
    return jnp.cos(ang), jnp.sin(ang)


def apply_axial_rope(x, cos, sin):
    b, n, h, d = x.shape
    xf = x.astype(jnp.float32).reshape(b, n, h, 2, 2, ROPE_AXIS_DIM // 2)
    x1, x2 = xf[..., 0, :], xf[..., 1, :]
    cs = cos[None, :, None]
    sn = sin[None, :, None]
    out = jnp.stack([x1 * cs - x2 * sn, x2 * cs + x1 * sn], axis=-2)
    return out.reshape(b, n, h, d).astype(x.dtype)


def chunk_states(k, v, lg, r0):
    b, h, n, dk = k.shape
    dv = v.shape[-1]
    nc = n // RET_CHUNK
    kc = k.reshape(b, h, nc, RET_CHUNK, dk)
    vc = v.reshape(b, h, nc, RET_CHUNK, dv)
    pos = jnp.arange(RET_CHUNK, dtype=jnp.float32)
    zeta = jnp.exp((RET_CHUNK - 1 - pos)[None, :] * lg[:, None])
    u = jnp.einsum('bhncd,bhnce->bhnde', kc * zeta[None, :, None, :, None], vc)
    g_chunk = jnp.exp(RET_CHUNK * lg)[None, :, None, None]

    def step(r, u_i):
        return g_chunk * r + u_i, r

    r_final, r_prev = lax.scan(step, r0, jnp.moveaxis(u, 2, 0))
    return jnp.moveaxis(r_prev, 0, 2), r_final


def retention_out(q, k, v, lg, r_prev):
    b, h, n, dk = q.shape
    dv = v.shape[-1]
    nc = n // RET_CHUNK
    qc = q.reshape(b, h, nc, RET_CHUNK, dk)
    kc = k.reshape(b, h, nc, RET_CHUNK, dk)
    vc = v.reshape(b, h, nc, RET_CHUNK, dv)
    pos = jnp.arange(RET_CHUNK, dtype=jnp.float32)
    diff = pos[:, None] - pos[None, :]
    dmask = jnp.where(diff >= 0, jnp.exp(jnp.maximum(diff, 0.0)[None] * lg[:, None, None]), 0.0)
    s = jnp.einsum('bhncd,bhnmd->bhncm', qc, kc) * dmask[None, :, None]
    inner = jnp.einsum('bhncm,bhnme->bhnce', s, vc)
    xi = jnp.exp((pos + 1.0)[None, :] * lg[:, None])
    cross = jnp.einsum('bhncd,bhnde->bhnce', qc * xi[None, :, None, :, None], r_prev)
    return (inner + cross).reshape(b, h, n, dv)


def retention_head_out(o, g, w_pa):
    b, h, n, dv = o.shape
    of = o.astype(jnp.float32)
    mu = jnp.mean(of, axis=-1, keepdims=True)
    var = jnp.mean(jnp.square(of - mu), axis=-1, keepdims=True)
    on = ((of - mu) * lax.rsqrt(var + GN_EPS)).transpose(0, 2, 1, 3).reshape(b, n, h * dv).astype(g.dtype)
    return (jax.nn.silu(g) * on) @ w_pa


def bidirectional_retention(q, k, v, lg_f, lg_b, r_init_f, r_init_b):
    prev_f, _ = chunk_states(k, v, lg_f, r_init_f)
    prev_b, _ = chunk_states(flip(k), flip(v), lg_b, r_init_b)
    return retention_out(q, k, v, lg_f, prev_f) + flip(retention_out(flip(q), flip(k), flip(v), lg_b, prev_b))


def neighbourhood_attention(q, k, v, kc, vc, rpb):
    b, h, s, d = q.shape
    rows = s // GRID_W
    kr = min(NA_KR_MAX, rows)
    scale = d ** -0.5
    qg = q.reshape(b, h, rows, GRID_W, d)
    kg = k.reshape(b, h, rows, GRID_W, d)
    vg = v.reshape(b, h, rows, GRID_W, d)
    n_cb = GRID_W // NA_QCB
    qcols = jnp.arange(GRID_W).reshape(n_cb, NA_QCB)
    kstart = jnp.clip(jnp.arange(n_cb) * NA_QCB - NA_KC // 2, 0, GRID_W - NA_KCB)
    kcols = kstart[:, None] + jnp.arange(NA_KCB)
    cs = jnp.clip(qcols - NA_KC // 2, 0, GRID_W - NA_KC)
    col_ok = (kcols[:, None, :] >= cs[:, :, None]) & (kcols[:, None, :] < cs[:, :, None] + NA_KC)
    dc_idx = jnp.clip(kcols[:, None, :] - qcols[:, :, None], -(NA_KC - 1), NA_KC - 1) + NA_KC - 1
    mask = jnp.broadcast_to(col_ok[:, :, None, :], (n_cb, NA_QCB, kr, NA_KCB)).reshape(n_cb, NA_QCB, kr * NA_KCB)
    rpb_f = rpb.astype(jnp.float32)
    n_loc = kr * NA_KCB

    def row_block(r):
        rs = jnp.clip(r - kr // 2, 0, rows - kr)
        k_rows = lax.dynamic_slice_in_dim(kg, rs, kr, axis=2)
        v_rows = lax.dynamic_slice_in_dim(vg, rs, kr, axis=2)
        k_blk = k_rows[:, :, :, kcols].transpose(0, 1, 3, 2, 4, 5).reshape(b, h, n_cb, n_loc, d)
        v_blk = v_rows[:, :, :, kcols].transpose(0, 1, 3, 2, 4, 5).reshape(b, h, n_cb, n_loc, d)
        q_blk = lax.dynamic_index_in_dim(qg, r, axis=2, keepdims=False).reshape(b, h, n_cb, NA_QCB, d)
        dr_idx = rs + jnp.arange(kr) - r + NA_KR_MAX - 1
        bias = rpb_f[:, dr_idx][:, :, dc_idx]
        bias = bias.transpose(0, 2, 3, 1, 4).reshape(h, n_cb, NA_QCB, n_loc)
        s_loc = jnp.einsum('bhjqd,bhjkd->bhjqk', q_blk, k_blk).astype(jnp.float32) * scale + bias
        s_loc = jnp.where(mask, s_loc, NEG_INF)
        s_ctx = jnp.einsum('bhjqd,bhkd->bhjqk', q_blk, kc).astype(jnp.float32) * scale
        p = jax.nn.softmax(jnp.concatenate([s_loc, s_ctx], axis=-1), axis=-1).astype(v.dtype)
        o = jnp.einsum('bhjqk,bhjkd->bhjqd', p[..., :n_loc], v_blk) + jnp.einsum('bhjqk,bhkd->bhjqd', p[..., n_loc:], vc)
        return o.reshape(b, h, GRID_W, d)

    out = lax.map(row_block, jnp.arange(rows))
    return out.transpose(1, 0, 3, 2, 4).reshape(b, s, h * d)


def context_attention(q, k, v):
    b, h, n, d = q.shape
    s = jnp.einsum('bhqd,bhkd->bhqk', q, k).astype(jnp.float32) * d ** -0.5
    p = jax.nn.softmax(s, axis=-1).astype(v.dtype)
    return jnp.einsum('bhqk,bhkd->bhqd', p, v).transpose(0, 2, 1, 3).reshape(b, n, h * d)


def token_mixer(h, hc, w_in, w_pa, w_pb, w_o, dec_f, dec_b, rpb, with_ctx_out):
    b, s, _ = h.shape
    cuts = [int(i) for i in np.cumsum(IN_SPLITS)[:-1]]
    q_r, k_r, v_r, g_r, q_n, k_n, v_n, g_a, g_b = jnp.split(h @ w_in, cuts, axis=-1)
    qc_r, kc_r, vc_r, gc_r, qc_n, kc_n, vc_n, gc_a, gc_b = jnp.split(hc @ w_in, cuts, axis=-1)

    cos, sin = axial_rope_tables(s)
    q = apply_axial_rope(q_r.reshape(b, s, RET_HEADS, RET_DK), cos, sin).transpose(0, 2, 1, 3)
    k = apply_axial_rope(k_r.reshape(b, s, RET_HEADS, RET_DK), cos, sin).transpose(0, 2, 1, 3) * RET_DK ** -0.5
    v = split_heads(v_r, RET_HEADS)
    kc = split_heads(kc_r, RET_HEADS) * RET_DK ** -0.5
    vc = split_heads(vc_r, RET_HEADS)
    lg_f = jax.nn.log_sigmoid(dec_f.astype(jnp.float32))
    lg_b = jax.nn.log_sigmoid(dec_b.astype(jnp.float32))
    r0 = jnp.zeros((b, RET_HEADS, RET_DK, RET_DV), jnp.float32)
    _, r_cf = chunk_states(kc, vc, lg_f, r0)
    _, r_cb = chunk_states(flip(kc), flip(vc), lg_b, r0)
    ret = retention_head_out(bidirectional_retention(q, k, v, lg_f, lg_b, r_cf, r_cb), g_r, w_pa)

    kc_na = split_heads(kc_n, NA_HEADS)
    vc_na = split_heads(vc_n, NA_HEADS)
    na = neighbourhood_attention(split_heads(q_n, NA_HEADS), split_heads(k_n, NA_HEADS), split_heads(v_n, NA_HEADS), kc_na, vc_na, rpb) @ w_pb

    y = (jax.nn.sigmoid(g_a) * ret + jax.nn.sigmoid(g_b) * na) @ w_o
    if not with_ctx_out:
        return y, None

    qc = split_heads(qc_r, RET_HEADS)
    ret_c = retention_head_out(bidirectional_retention(qc, kc, vc, lg_f, lg_b, r0, r0), gc_r, w_pa)
    na_c = context_attention(split_heads(qc_n, NA_HEADS), kc_na, vc_na) @ w_pb
    yc = (jax.nn.sigmoid(gc_a) * ret_c + jax.nn.sigmoid(gc_b) * na_c) @ w_o
    return y, yc


def clamped_swiglu(gate, up):
    gate = jnp.minimum(gate, SWIGLU_LIMIT)
    up = jnp.clip(up, -SWIGLU_LIMIT, SWIGLU_LIMIT)
    return gate * jax.nn.sigmoid(SWIGLU_ALPHA * gate) * (up + 1.0)


def moe_ffn(h, w_router, b_router, w_gate, b_gate, w_up, b_up, w_down, b_down):
    shape = h.shape
    dm = shape[-1]
    t = h.reshape(-1, dm)
    n_tok = t.shape[0]
    logits = (t @ w_router + b_router).astype(jnp.float32)
    top_v, top_i = lax.top_k(logits, TOP_K)
    top_w = jax.nn.softmax(top_v, axis=-1)
    n_asg = n_tok * TOP_K
    n_blocks = -(-(n_asg + N_EXPERTS * (MOE_BLOCK - 1)) // MOE_BLOCK)
    e_flat = top_i.reshape(-1)
    tok_flat = jnp.arange(n_asg, dtype=jnp.int32) // TOP_K
    w_flat = top_w.reshape(-1)
    order = jnp.argsort(e_flat)
    e_sorted = e_flat[order]
    counts = jnp.zeros((N_EXPERTS,), jnp.int32).at[e_flat].add(1)
    padded = (counts + MOE_BLOCK - 1) // MOE_BLOCK * MOE_BLOCK
    start = jnp.cumsum(counts) - counts
    pend = jnp.cumsum(padded)
    pstart = pend - padded
    dest = pstart[e_sorted] + jnp.arange(n_asg, dtype=jnp.int32) - start[e_sorted]
    slot_tok = jnp.full((n_blocks * MOE_BLOCK,), n_tok, jnp.int32).at[dest].set(tok_flat[order])
    slot_w = jnp.zeros((n_blocks * MOE_BLOCK,), jnp.float32).at[dest].set(w_flat[order])
    block_e = jnp.minimum(jnp.searchsorted(pend, jnp.arange(n_blocks, dtype=jnp.int32) * MOE_BLOCK, side='right'), N_EXPERTS - 1)
    t_pad = jnp.concatenate([t, jnp.zeros((1, dm), t.dtype)], axis=0)
    xb = t_pad[slot_tok].reshape(n_blocks, MOE_BLOCK, dm)

    def expert_block(args):
        xblk, e = args
        a = clamped_swiglu(xblk @ w_gate[e] + b_gate[e], xblk @ w_up[e] + b_up[e])
        return a @ w_down[e] + b_down[e]

    yb = lax.map(expert_block, (xb, block_e))
    y = jnp.zeros((n_tok + 1, dm), jnp.float32).at[slot_tok].add(yb.reshape(-1, dm).astype(jnp.float32) * slot_w[:, None])
    return y[:n_tok].reshape(shape).astype(h.dtype)


def setup_inputs(seed: int = 0) -> dict:
    key = jax.random.key(seed)
    ks = jax.random.split(key, 26)

    def nrm(k, shape, scale):
        return jax.random.normal(k, shape, jnp.float32) * scale

    base_logit = jnp.log(2.0 ** (5.0 + jnp.arange(RET_HEADS, dtype=jnp.float32)) - 1.0)
    return {
        'x': nrm(ks[0], (BATCH, SEQ, D_MODEL), 1.0),
        'c': nrm(ks[1], (BATCH, D_MODEL), 1.0),
        'ctx': nrm(ks[2], (BATCH, CTX_LEN, D_MODEL), 1.0),
        'c_ctx': nrm(ks[3], (D_MODEL,), 1.0),
        'ada_w': nrm(ks[4], (DEPTH, D_MODEL, 6 * D_MODEL), 0.5 * D_MODEL ** -0.5),
        'ada_b': nrm(ks[5], (DEPTH, 6 * D_MODEL), 0.02),
        'norm1_g': 1.0 + nrm(ks[6], (DEPTH, D_MODEL), 0.02),
        'norm2_g': 1.0 + nrm(ks[7], (DEPTH, D_MODEL), 0.02),
        'w_in': nrm(ks[8], (DEPTH, D_MODEL, IN_W), D_MODEL ** -0.5),
        'w_pa': nrm(ks[9], (DEPTH, RET_V_W, D_MODEL), RET_V_W ** -0.5),
        'w_pb': nrm(ks[10], (DEPTH, NA_W, D_MODEL), NA_W ** -0.5),
        'w_o': nrm(ks[11], (DEPTH, D_MODEL, D_MODEL), D_MODEL ** -0.5),
        'ret_decay_fwd': base_logit + nrm(ks[12], (DEPTH, RET_HEADS), 0.05),
        'ret_decay_bwd': base_logit + nrm(ks[13], (DEPTH, RET_HEADS), 0.05),
        'na_rpb': nrm(ks[14], (DEPTH, NA_HEADS, 2 * NA_KR_MAX - 1, 2 * NA_KC - 1), 0.1),
        'w_router': nrm(ks[15], (DEPTH, D_MODEL, N_EXPERTS), D_MODEL ** -0.5),
        'b_router': nrm(ks[16], (DEPTH, N_EXPERTS), 0.01),
        'w_gate': nrm(ks[17], (DEPTH, N_EXPERTS, D_MODEL, D_FF), D_MODEL ** -0.5),
        'b_gate': nrm(ks[18], (DEPTH, N_EXPERTS, D_FF), 0.01),
        'w_up': nrm(ks[19], (DEPTH, N_EXPERTS, D_MODEL, D_FF), D_MODEL ** -0.5),
        'b_up': nrm(ks[20], (DEPTH, N_EXPERTS, D_FF), 0.01),
        'w_down': nrm(ks[21], (DEPTH, N_EXPERTS, D_FF, D_MODEL), D_FF ** -0.5),
        'b_down': nrm(ks[22], (DEPTH, N_EXPERTS, D_MODEL), 0.01),
        'final_g': 1.0 + nrm(ks[23], (D_MODEL,), 0.02),
    }


def reference(x, c, ctx, c_ctx, ada_w, ada_b, norm1_g, norm2_g, w_in, w_pa, w_pb, w_o, ret_decay_fwd, ret_decay_bwd, na_rpb, w_router, b_router, w_gate, b_gate, w_up, b_up, w_down, b_down, final_g):
    xc = ctx
    for l in range(DEPTH):
        last = l == DEPTH - 1
        mod = jax.nn.silu(c) @ ada_w[l] + ada_b[l]
        mod_c = jax.nn.silu(c_ctx) @ ada_w[l] + ada_b[l]
        sh1, sc1, g1, sh2, sc2, g2 = jnp.split(mod[:, None, :], 6, axis=-1)
        shc1, scc1, gc1, shc2, scc2, gc2 = jnp.split(mod_c, 6, axis=-1)
        h = modulate(rmsnorm(x, norm1_g[l]), sh1, sc1)
        hc = modulate(rmsnorm(xc, norm1_g[l]), shc1, scc1)
        y, yc = token_mixer(h, hc, w_in[l], w_pa[l], w_pb[l], w_o[l], ret_decay_fwd[l], ret_decay_bwd[l], na_rpb[l], not last)
        x = x + g1 * y.astype(x.dtype)
        h2 = modulate(rmsnorm(x, norm2_g[l]), sh2, sc2)
        x = x + g2 * moe_ffn(h2, w_router[l], b_router[l], w_gate[l], b_gate[l], w_up[l], b_up[l], w_down[l], b_down[l])
        if not last:
            xc = xc + gc1 * yc.astype(xc.dtype)
            hc2 = modulate(rmsnorm(xc, norm2_g[l]), shc2, scc2)
            xc = xc + gc2 * moe_ffn(hc2, w_router[l], b_router[l], w_gate[l], b_gate[l], w_up[l], b_up[l], w_down[l], b_down[l])
    return rmsnorm(x, final_g)
```

```cpp
#include <hip/hip_runtime.h>
#include <stdint.h>

namespace nv {
constexpr int D = 2048, B = 4, S = 4096, L = 256, NTOK = B * S, NCTX = B * L, MR = NTOK + NCTX;
constexpr int INW = 16384;
constexpr int RH = 8, RDK = 128, RDV = 256, NH = 16, NDH = 128;
constexpr int NE = 32, FF = 2048, NSLOT = 544 * 128;
constexpr int C_QR = 0, C_KR = 1024, C_VR = 2048, C_GR = 4096, C_QN = 6144, C_KN = 8192, C_VN = 10240, C_GA = 12288, C_GB = 14336;
constexpr size_t MiB = 1u << 20;
constexpr size_t WS_CNT = 0;
constexpr size_t WS_PSTART = 4096;
constexpr size_t WS_BLKE = 8192;
constexpr size_t WS_MOD = 1 * MiB;
constexpr size_t WS_ASG_E = 2 * MiB;
constexpr size_t WS_ASG_POS = 3 * MiB;
constexpr size_t WS_ASG_W = 4 * MiB;
constexpr size_t WS_ASG_SLOT = 5 * MiB;
constexpr size_t WS_SLOT_TOK = 6 * MiB;
constexpr size_t WS_H = 16 * MiB;
constexpr size_t WS_Y = 160 * MiB;
constexpr size_t WS_G = 160 * MiB, WS_ACT = 704 * MiB, WS_YS = 160 * MiB;
constexpr size_t WS_O = 1248 * MiB, WS_NAO = 1376 * MiB, WS_T1 = 1504 * MiB, WS_H2 = 1632 * MiB;

__device__ __forceinline__ float sigmoidf_(float x) { return 1.0f / (1.0f + expf(-x)); }
__device__ __forceinline__ float siluf_(float x) { return x * sigmoidf_(x); }

__device__ __forceinline__ float block_sum256(float v, float* red) {
#pragma unroll
    for (int o = 32; o >= 1; o >>= 1) v += __shfl_xor(v, o);
    __syncthreads();
    if ((threadIdx.x & 63) == 0) red[threadIdx.x >> 6] = v;
    __syncthreads();
    float r = 0.f;
    for (int i = 0; i < (int)(blockDim.x >> 6); ++i) r += red[i];
    return r;
}
__device__ __forceinline__ float block_max256(float v, float* red) {
#pragma unroll
    for (int o = 32; o >= 1; o >>= 1) v = fmaxf(v, __shfl_xor(v, o));
    __syncthreads();
    if ((threadIdx.x & 63) == 0) red[threadIdx.x >> 6] = v;
    __syncthreads();
    float r = red[0];
    for (int i = 1; i < (int)(blockDim.x >> 6); ++i) r = fmaxf(r, red[i]);
    return r;
}

__global__ __launch_bounds__(256) void k_mod(const float* c, const float* c_ctx, const float* W, const float* bias, float* mod) {
    __shared__ float sv[5][D];
    for (int i = threadIdx.x; i < 5 * D; i += 256) { int r = i / D, k = i % D; float v = r < 4 ? c[r * D + k] : c_ctx[k]; sv[r][k] = siluf_(v); }
    __syncthreads();
    const int j = blockIdx.x * 256 + threadIdx.x;
    float a0 = 0, a1 = 0, a2 = 0, a3 = 0, a4 = 0;
    for (int k = 0; k < D; ++k) { float w = W[(size_t)k * 12288 + j]; a0 += sv[0][k] * w; a1 += sv[1][k] * w; a2 += sv[2][k] * w; a3 += sv[3][k] * w; a4 += sv[4][k] * w; }
    float bb = bias[j];
    mod[0 * 12288 + j] = a0 + bb; mod[1 * 12288 + j] = a1 + bb; mod[2 * 12288 + j] = a2 + bb; mod[3 * 12288 + j] = a3 + bb; mod[4 * 12288 + j] = a4 + bb;
}

__global__ __launch_bounds__(256) void k_norm_mod(const float* x, const float* ctx, const float* g, const float* mod, float* H, int sh_off, int sc_off, int nrows_lat, int pad_) {
    __shared__ float red[8];
    const int m = blockIdx.x;
    const float* src = m < nrows_lat ? x + (size_t)m * D : ctx + (size_t)(m - nrows_lat) * D;
    const int mr = m < nrows_lat ? m / S : 4;
    float v[8]; float ss = 0.f;
#pragma unroll
    for (int i = 0; i < 8; ++i) { v[i] = src[threadIdx.x + 256 * i]; ss += v[i] * v[i]; }
    ss = block_sum256(ss, red);
    const float rstd = rsqrtf(ss * (1.0f / D) + 1e-6f);
#pragma unroll
    for (int i = 0; i < 8; ++i) { int k = threadIdx.x + 256 * i; float y = v[i] * rstd * g[k]; H[(size_t)m * D + k] = y * (1.0f + mod[mr * 12288 + sc_off + k]) + mod[mr * 12288 + sh_off + k]; }
}

template <class AF, class BF, class EF>
__global__ __launch_bounds__(256) void sgemm128(int N, int K, AF af, BF bf, EF ef) {
    __shared__ float As[16][132];
    __shared__ float Bs[16][132];
    const int tid = threadIdx.x, bm = blockIdx.y * 128, bn = blockIdx.x * 128;
    const float* Bbase = bf(blockIdx.y);
    if (!Bbase) return;
    const int ar = tid >> 1, ak = (tid & 1) * 8;
    const float* arow = af(bm + ar);
    const int bk = tid >> 4, bc = (tid & 15) * 8;
    const int ty = tid >> 4, tx = tid & 15;
    float acc[8][8];
#pragma unroll
    for (int i = 0; i < 8; ++i)
#pragma unroll
        for (int j = 0; j < 8; ++j) acc[i][j] = 0.f;
    for (int k0 = 0; k0 < K; k0 += 16) {
        float4 a0 = make_float4(0, 0, 0, 0), a1 = a0;
        if (arow) { a0 = *(const float4*)(arow + k0 + ak); a1 = *(const float4*)(arow + k0 + ak + 4); }
        const float4 b0 = *(const float4*)(Bbase + (size_t)(k0 + bk) * N + bn + bc);
        const float4 b1 = *(const float4*)(Bbase + (size_t)(k0 + bk) * N + bn + bc + 4);
        __syncthreads();
        As[ak + 0][ar] = a0.x; As[ak + 1][ar] = a0.y; As[ak + 2][ar] = a0.z; As[ak + 3][ar] = a0.w;
        As[ak + 4][ar] = a1.x; As[ak + 5][ar] = a1.y; As[ak + 6][ar] = a1.z; As[ak + 7][ar] = a1.w;
        *(float4*)&Bs[bk][bc] = b0; *(float4*)&Bs[bk][bc + 4] = b1;
        __syncthreads();
#pragma unroll
        for (int kk = 0; kk < 16; ++kk) {
            float a[8], b[8];
            const float4 x0 = *(const float4*)&As[kk][ty * 8], x1 = *(const float4*)&As[kk][ty * 8 + 4];
            const float4 y0 = *(const float4*)&Bs[kk][tx * 8], y1 = *(const float4*)&Bs[kk][tx * 8 + 4];
            a[0] = x0.x; a[1] = x0.y; a[2] = x0.z; a[3] = x0.w; a[4] = x1.x; a[5] = x1.y; a[6] = x1.z; a[7] = x1.w;
            b[0] = y0.x; b[1] = y0.y; b[2] = y0.z; b[3] = y0.w; b[4] = y1.x; b[5] = y1.y; b[6] = y1.z; b[7] = y1.w;
#pragma unroll
            for (int i = 0; i < 8; ++i)
#pragma unroll
                for (int j = 0; j < 8; ++j) acc[i][j] += a[i] * b[j];
        }
    }
#pragma unroll
    for (int i = 0; i < 8; ++i)
#pragma unroll
        for (int j = 0; j < 8; ++j) ef(bm + ty * 8 + i, bn + tx * 8 + j, acc[i][j]);
}

struct ARows { const float* A; long lda; __device__ const float* operator()(int m) const { return A + (size_t)m * lda; } };
struct AGather { const float* A; long lda; const int* idx; __device__ const float* operator()(int m) const { int t = idx[m]; return t >= 0 ? A + (size_t)t * lda : nullptr; } };
struct BOne { const float* Bp; __device__ const float* operator()(int) const { return Bp; } };
struct BExpert { const float* Bp; size_t stride; const int* blk_e; __device__ const float* operator()(int tm) const { int e = blk_e[tm]; return e >= 0 ? Bp + (size_t)e * stride : nullptr; } };
struct EStore { float* C; long ldc; __device__ void operator()(int m, int n, float v) const { C[(size_t)m * ldc + n] = v; } };
struct ERetGate { float* T; const float* Y; __device__ void operator()(int m, int n, float v) const { T[(size_t)m * D + n] = sigmoidf_(Y[(size_t)m * INW + C_GA + n]) * v; } };
struct ENaGate { float* T; const float* Y; __device__ void operator()(int m, int n, float v) const { T[(size_t)m * D + n] += sigmoidf_(Y[(size_t)m * INW + C_GB + n]) * v; } };
struct EResid { float* out; const float* x; const float* mod; __device__ void operator()(int m, int n, float v) const { out[(size_t)m * D + n] = x[(size_t)m * D + n] + mod[(m / S) * 12288 + 2 * D + n] * v; } };
struct EGate { float* G; const float* bias; const int* blk_e; __device__ void operator()(int m, int n, float v) const { int e = blk_e[m >> 7]; G[(size_t)m * FF + n] = v + bias[e * FF + n]; } };
struct EUp { float* ACT; const float* G; const float* bias; const int* blk_e; __device__ void operator()(int m, int n, float v) const { int e = blk_e[m >> 7];
    float gate = fminf(G[(size_t)m * FF + n], 7.0f), up = fminf(fmaxf(v + bias[e * FF + n], -7.0f), 7.0f);
    ACT[(size_t)m * FF + n] = gate * sigmoidf_(1.702f * gate) * (up + 1.0f); } };
struct EDown { float* YS; const float* bias; const int* blk_e; __device__ void operator()(int m, int n, float v) const { int e = blk_e[m >> 7]; YS[(size_t)m * D + n] = v + bias[e * D + n]; } };

__device__ __forceinline__ float rope_val(const float* hrow  , int t, int d) {
    const int axis = d >> 6, half = (d >> 5) & 1, f = d & 31;
    const float pos = (float)(axis == 0 ? (t >> 6) : (t & 63));
    const float inv = powf(10000.0f, -(float)(2 * f) / 64.0f);
    const float ang = pos * inv, cs = cosf(ang), sn = sinf(ang);
    const float x1 = hrow[axis * 64 + f], x2 = hrow[axis * 64 + 32 + f];
    return half == 0 ? x1 * cs - x2 * sn : x2 * cs + x1 * sn;
}

__global__ __launch_bounds__(256) void k_ret(const float* Y, const float* dec_f, const float* dec_b, float* O) {
    __shared__ float qs[16][128];
    __shared__ float ks[64][129];
    __shared__ float wsm[16][64];
    const int t0 = blockIdx.x * 16, h = blockIdx.y, b = blockIdx.z, tid = threadIdx.x;
    const float lgf = -log1pf(expf(-dec_f[h])), lgb = -log1pf(expf(-dec_b[h]));
    for (int idx = tid; idx < 16 * 128; idx += 256) { int qi = idx >> 7, d = idx & 127; qs[qi][d] = rope_val(Y + (size_t)(b * S + t0 + qi) * INW + C_QR + h * 128, t0 + qi, d); }
    float acc[16];
#pragma unroll
    for (int i = 0; i < 16; ++i) acc[i] = 0.f;
    for (int u0 = 0; u0 < L + S; u0 += 64) {
        __syncthreads();
        for (int idx = tid; idx < 64 * 128; idx += 256) { int kk = idx >> 7, d = idx & 127, u = u0 + kk; float val;
            if (u < L) val = Y[(size_t)(NTOK + b * L + u) * INW + C_KR + h * 128 + d];
            else val = rope_val(Y + (size_t)(b * S + (u - L)) * INW + C_KR + h * 128, u - L, d);
            ks[kk][d] = val * 0.08838834764831845f; }
        __syncthreads();
#pragma unroll
        for (int i = 0; i < 4; ++i) { int idx = tid + 256 * i, qi = idx >> 6, kk = idx & 63; float dot = 0.f;
            for (int d = 0; d < 128; ++d) dot += qs[qi][d] * ks[kk][d];
            const int t = t0 + qi, u = u0 + kk; float w;
            if (u < L) w = expf((float)(t + 1 + 255 - u) * lgf) + expf((float)(S - t + u) * lgb);
            else { const int s = u - L; w = (s <= t ? expf((float)(t - s) * lgf) : 0.f) + (s >= t ? expf((float)(s - t) * lgb) : 0.f); }
            wsm[qi][kk] = dot * w; }
        __syncthreads();
        for (int kk = 0; kk < 64; ++kk) { const int u = u0 + kk; const size_t row = u < L ? (size_t)(NTOK + b * L + u) : (size_t)(b * S + (u - L));
            const float v = Y[row * INW + C_VR + h * 256 + tid];
#pragma unroll
            for (int qi = 0; qi < 16; ++qi) acc[qi] += wsm[qi][kk] * v; }
    }
#pragma unroll
    for (int qi = 0; qi < 16; ++qi) O[(size_t)(b * S + t0 + qi) * D + h * 256 + tid] = acc[qi];
}

__global__ __launch_bounds__(256) void k_gn_gate(const float* O, const float* Y, float* A1) {
    __shared__ float red[8];
    const int m = blockIdx.x, tid = threadIdx.x;
    for (int h = 0; h < RH; ++h) {
        const float o = O[(size_t)m * D + h * 256 + tid];
        const float mu = block_sum256(o, red) * (1.0f / 256.0f);
        const float dlt = o - mu;
        const float var = block_sum256(dlt * dlt, red) * (1.0f / 256.0f);
        const float g = Y[(size_t)m * INW + C_GR + h * 256 + tid];
        A1[(size_t)m * D + h * 256 + tid] = siluf_(g) * dlt * rsqrtf(var + 1e-5f);
    }
}

__global__ __launch_bounds__(256) void k_na(const float* Y, const float* rpb, float* NAO) {
    __shared__ float qs[128];
    __shared__ float sc[384];
    __shared__ float red[8];
    __shared__ float part[128];
    const int t = blockIdx.x, h = blockIdx.y, b = blockIdx.z, tid = threadIdx.x, lane = tid & 63, w = tid >> 6;
    const int r = t >> 6, qc = t & 63;
    const int rs = min(max(r - 4, 0), 56), cs = min(max(qc - 8, 0), 48);
    if (tid < 128) qs[tid] = Y[(size_t)(b * S + t) * INW + C_QN + h * 128 + tid];
    __syncthreads();
    const float scale = 0.08838834764831845f;
    for (int key = w; key < 384; key += 4) {
        size_t row; float bias = 0.f;
        if (key < 128) { const int kr = key >> 4, kc = key & 15; row = (size_t)(b * S + (rs + kr) * 64 + cs + kc); bias = rpb[(h * 15 + (rs + kr - r + 7)) * 31 + (cs + kc - qc + 15)]; }
        else row = (size_t)(NTOK + b * L + (key - 128));
        const float* kp = Y + row * INW + C_KN + h * 128;
        float d = qs[lane] * kp[lane] + qs[lane + 64] * kp[lane + 64];
#pragma unroll
        for (int o = 32; o >= 1; o >>= 1) d += __shfl_xor(d, o);
        if (lane == 0) sc[key] = d * scale + bias;
    }
    __syncthreads();
    float mx = -1e30f;
    for (int i = tid; i < 384; i += 256) mx = fmaxf(mx, sc[i]);
    mx = block_max256(mx, red);
    float sm = 0.f;
    for (int i = tid; i < 384; i += 256) { float e = expf(sc[i] - mx); sc[i] = e; sm += e; }
    sm = block_sum256(sm, red);
    const int d = tid & 127, half = tid >> 7;
    float acc = 0.f;
    for (int key = half * 192; key < half * 192 + 192; ++key) {
        size_t row;
        if (key < 128) { const int kr = key >> 4, kc = key & 15; row = (size_t)(b * S + (rs + kr) * 64 + cs + kc); }
        else row = (size_t)(NTOK + b * L + (key - 128));
        acc += sc[key] * Y[row * INW + C_VN + h * 128 + d];
    }
    if (half == 1) part[d] = acc;
    __syncthreads();
    if (half == 0) NAO[(size_t)(b * S + t) * D + h * 128 + d] = (acc + part[d]) / sm;
}

__global__ __launch_bounds__(256) void k_route(const float* X1, const float* g, const float* mod, const float* Wr, const float* br, float* H2,
                                               int* counts, int* asg_e, int* asg_pos, float* asg_w) {
    __shared__ float red[8];
    __shared__ float hs[D];
    __shared__ float lg[32];
    const int m = blockIdx.x, tid = threadIdx.x, mr = m / S;
    float v[8]; float ss = 0.f;
#pragma unroll
    for (int i = 0; i < 8; ++i) { v[i] = X1[(size_t)m * D + tid + 256 * i]; ss += v[i] * v[i]; }
    ss = block_sum256(ss, red);
    const float rstd = rsqrtf(ss * (1.0f / D) + 1e-6f);
#pragma unroll
    for (int i = 0; i < 8; ++i) { int k = tid + 256 * i; float y = v[i] * rstd * g[k]; float hv = y * (1.0f + mod[mr * 12288 + 4 * D + k]) + mod[mr * 12288 + 3 * D + k]; hs[k] = hv; H2[(size_t)m * D + k] = hv; }
    __syncthreads();
    { const int e = tid >> 3, part = tid & 7; float d = 0.f;
      for (int k = part * 256; k < part * 256 + 256; ++k) d += hs[k] * Wr[k * 32 + e];
      d += __shfl_xor(d, 1); d += __shfl_xor(d, 2); d += __shfl_xor(d, 4);
      if (part == 0) lg[e] = d + br[e]; }
    __syncthreads();
    if (tid == 0) {
        int sel[4]; float val[4]; unsigned used = 0u;
#pragma unroll
        for (int k = 0; k < 4; ++k) { int bi = -1; float bv = 0.f;
            for (int e = 0; e < 32; ++e) { if ((used >> e) & 1u) continue; const float x = lg[e]; if (bi < 0 || x > bv) { bi = e; bv = x; } }
            used |= 1u << bi; sel[k] = bi; val[k] = bv; }
        float den = 0.f, ex[4];
#pragma unroll
        for (int k = 0; k < 4; ++k) { ex[k] = expf(val[k] - val[0]); den += ex[k]; }
#pragma unroll
        for (int k = 0; k < 4; ++k) { const int pos = atomicAdd(&counts[sel[k]], 1); asg_e[m * 4 + k] = sel[k]; asg_pos[m * 4 + k] = pos; asg_w[m * 4 + k] = ex[k] / den; }
    }
}
__global__ void k_route_prefix(const int* counts, int* pstart, int* blk_e) {
    __shared__ int ps[33];
    if (threadIdx.x == 0) { int a = 0; for (int e = 0; e < 32; ++e) { ps[e] = a; a += (counts[e] + 127) / 128 * 128; } ps[32] = a; }
    __syncthreads();
    if (threadIdx.x < 33) pstart[threadIdx.x] = ps[threadIdx.x];
    for (int blk = threadIdx.x; blk < 544; blk += blockDim.x) { int e = -1; for (int q = 0; q < 32; ++q) if (blk * 128 >= ps[q] && blk * 128 < ps[q + 1]) e = q; blk_e[blk] = e; }
}
__global__ void k_route_fill(const int* asg_e, const int* asg_pos, const int* pstart, int* asg_slot, int* slot_tok) {
    const int a = blockIdx.x * blockDim.x + threadIdx.x;
    if (a < NTOK * 4) { const int slot = pstart[asg_e[a]] + asg_pos[a]; asg_slot[a] = slot; slot_tok[slot] = a >> 2; }
}

__global__ __launch_bounds__(256) void k_final(float* out  , const float* YS, const int* asg_slot, const float* asg_w, const float* mod, const float* fg) {
    __shared__ float red[8];
    const int m = blockIdx.x, tid = threadIdx.x, mr = m / S;
    int sl[4]; float w[4];
#pragma unroll
    for (int k = 0; k < 4; ++k) { sl[k] = asg_slot[m * 4 + k]; w[k] = asg_w[m * 4 + k]; }
    float v[8]; float ss = 0.f;
#pragma unroll
    for (int i = 0; i < 8; ++i) { const int n = tid + 256 * i; float y = 0.f;
#pragma unroll
        for (int k = 0; k < 4; ++k) y += w[k] * YS[(size_t)sl[k] * D + n];
        v[i] = out[(size_t)m * D + n] + mod[mr * 12288 + 5 * D + n] * y; ss += v[i] * v[i]; }
    ss = block_sum256(ss, red);
    const float rstd = rsqrtf(ss * (1.0f / D) + 1e-6f);
#pragma unroll
    for (int i = 0; i < 8; ++i) { const int n = tid + 256 * i; out[(size_t)m * D + n] = v[i] * rstd * fg[n]; }
}
}

extern "C" void kernel_launch(void* const* d_in, const int* in_sizes, int n_in, void* d_out, int out_size, void* d_ws, size_t ws_size, hipStream_t stream) {
    using namespace nv;
    const float* x = (const float*)d_in[0]; const float* c = (const float*)d_in[1]; const float* ctx = (const float*)d_in[2]; const float* c_ctx = (const float*)d_in[3];
    const float* ada_w = (const float*)d_in[4]; const float* ada_b = (const float*)d_in[5]; const float* n1g = (const float*)d_in[6]; const float* n2g = (const float*)d_in[7];
    const float* w_in = (const float*)d_in[8]; const float* w_pa = (const float*)d_in[9]; const float* w_pb = (const float*)d_in[10]; const float* w_o = (const float*)d_in[11];
    const float* dec_f = (const float*)d_in[12]; const float* dec_b = (const float*)d_in[13]; const float* rpb = (const float*)d_in[14];
    const float* w_router = (const float*)d_in[15]; const float* b_router = (const float*)d_in[16];
    const float* w_gate = (const float*)d_in[17]; const float* b_gate = (const float*)d_in[18]; const float* w_up = (const float*)d_in[19]; const float* b_up = (const float*)d_in[20];
    const float* w_down = (const float*)d_in[21]; const float* b_down = (const float*)d_in[22]; const float* final_g = (const float*)d_in[23];
    float* out = (float*)d_out; char* ws = (char*)d_ws;
    int* counts = (int*)(ws + WS_CNT); int* pstart = (int*)(ws + WS_PSTART); int* blk_e = (int*)(ws + WS_BLKE);
    float* mod = (float*)(ws + WS_MOD);
    int* asg_e = (int*)(ws + WS_ASG_E); int* asg_pos = (int*)(ws + WS_ASG_POS); float* asg_w = (float*)(ws + WS_ASG_W); int* asg_slot = (int*)(ws + WS_ASG_SLOT); int* slot_tok = (int*)(ws + WS_SLOT_TOK);
    float* H = (float*)(ws + WS_H); float* Y = (float*)(ws + WS_Y); float* O = (float*)(ws + WS_O); float* NAO = (float*)(ws + WS_NAO); float* T1 = (float*)(ws + WS_T1); float* H2 = (float*)(ws + WS_H2);
    float* A1 = H; float* G = (float*)(ws + WS_G); float* ACT = (float*)(ws + WS_ACT); float* YS = (float*)(ws + WS_YS);
    (void)in_sizes; (void)n_in; (void)out_size; (void)ws_size;

    (void)hipMemsetAsync(counts, 0, 4096, stream);
    (void)hipMemsetAsync(slot_tok, 0xFF, (size_t)NSLOT * 4, stream);
    hipLaunchKernelGGL(k_mod, dim3(48), dim3(256), 0, stream, c, c_ctx, ada_w, ada_b, mod);
    hipLaunchKernelGGL(k_norm_mod, dim3(MR), dim3(256), 0, stream, x, ctx, n1g, mod, H, 0, D, NTOK, 0);
    hipLaunchKernelGGL((sgemm128<ARows, BOne, EStore>), dim3(INW / 128, MR / 128), dim3(256), 0, stream, INW, D, ARows{H, D}, BOne{w_in}, EStore{Y, INW});
    hipLaunchKernelGGL(k_ret, dim3(S / 16, RH, B), dim3(256), 0, stream, Y, dec_f, dec_b, O);
    hipLaunchKernelGGL(k_gn_gate, dim3(NTOK), dim3(256), 0, stream, O, Y, A1);
    hipLaunchKernelGGL((sgemm128<ARows, BOne, ERetGate>), dim3(D / 128, NTOK / 128), dim3(256), 0, stream, D, D, ARows{A1, D}, BOne{w_pa}, ERetGate{T1, Y});
    hipLaunchKernelGGL(k_na, dim3(S, NH, B), dim3(256), 0, stream, Y, rpb, NAO);
    hipLaunchKernelGGL((sgemm128<ARows, BOne, ENaGate>), dim3(D / 128, NTOK / 128), dim3(256), 0, stream, D, D, ARows{NAO, D}, BOne{w_pb}, ENaGate{T1, Y});
    hipLaunchKernelGGL((sgemm128<ARows, BOne, EResid>), dim3(D / 128, NTOK / 128), dim3(256), 0, stream, D, D, ARows{T1, D}, BOne{w_o}, EResid{out, x, mod});
    hipLaunchKernelGGL(k_route, dim3(NTOK), dim3(256), 0, stream, out, n2g, mod, w_router, b_router, H2, counts, asg_e, asg_pos, asg_w);
    hipLaunchKernelGGL(k_route_prefix, dim3(1), dim3(64), 0, stream, counts, pstart, blk_e);
    hipLaunchKernelGGL(k_route_fill, dim3(NTOK * 4 / 256), dim3(256), 0, stream, asg_e, asg_pos, pstart, asg_slot, slot_tok);
    hipLaunchKernelGGL((sgemm128<AGather, BExpert, EGate>), dim3(FF / 128, NSLOT / 128), dim3(256), 0, stream, FF, D, AGather{H2, D, slot_tok}, BExpert{w_gate, (size_t)D * FF, blk_e}, EGate{G, b_gate, blk_e});
    hipLaunchKernelGGL((sgemm128<AGather, BExpert, EUp>), dim3(FF / 128, NSLOT / 128), dim3(256), 0, stream, FF, D, AGather{H2, D, slot_tok}, BExpert{w_up, (size_t)D * FF, blk_e}, EUp{ACT, G, b_up, blk_e});
    hipLaunchKernelGGL((sgemm128<ARows, BExpert, EDown>), dim3(D / 128, NSLOT / 128), dim3(256), 0, stream, D, FF, ARows{ACT, FF}, BExpert{w_down, (size_t)FF * D, blk_e}, EDown{YS, b_down, blk_e});
    hipLaunchKernelGGL(k_final, dim3(NTOK), dim3(256), 0, stream, out, YS, asg_slot, asg_w, mod, final_g);
}
```

```cpp
#include <hip/hip_runtime.h>
#include <stdint.h>
#include <stdio.h>

#ifndef MK_STAGE
#define MK_STAGE 7
#endif

namespace pg8 {
#define PG8_LAS __attribute__((address_space(3)))
typedef unsigned short bf16_t;
typedef short bf16x8 __attribute__((ext_vector_type(8)));
typedef float f32x4 __attribute__((ext_vector_type(4)));
typedef unsigned u32x4 __attribute__((ext_vector_type(4)));
typedef unsigned u32x2 __attribute__((ext_vector_type(2)));
constexpr int BM = 256, BK = 64, HALF = 128, HTB = HALF * BK * 2, STAGE_BYTES = 8 * HTB, NXCD = 8, WGM = 8;

__host__ __device__ __forceinline__ int lds_byte(int r, int c) { const int st = (r >> 4) * 2 + (c >> 5), rr = r & 15, cc = c & 31, ob = rr * 64 + cc * 2; return st * 1024 + (ob ^ (((ob >> 9) & 1) << 5)); }
__host__ __device__ __forceinline__ void stage_rc(int b, int& R, int& C) { const int st = b / 1024, sb = b % 1024, swz = sb ^ (((sb >> 9) & 1) << 5); R = (st >> 1) * 16 + swz / 64; C = (st & 1) * 32 + (swz % 64) / 2; }
__host__ __device__ __forceinline__ int perm32(int rho) { const int n = rho >> 4, i = rho & 15; return 8 * (i >> 2) + 4 * n + (i & 3); }

struct Unit { int pm, pn, pb, e; };
struct Gemm { const bf16_t* A; const bf16_t* Bt; int K; };

struct StaticOrder {
    int nM, nN, nwg, G, c;
    __device__ void init(int M, int N, int G_, int c_) { nM = M / BM; nN = N / BM; nwg = nM * nN; G = G_; c = c_; }
    __device__ bool next(int i, Unit& u) const {
        const long L = (long)i * G + c; if (L >= nwg) return false;
        int wgid = (int)L; { const int q = nwg / NXCD, r = nwg % NXCD, xcd = wgid % NXCD, off = wgid / NXCD; wgid = (xcd < r ? xcd * (q + 1) : r * (q + 1) + (xcd - r) * q) + off; }
        const int nig = WGM * nN, gid = wgid / nig, fm = gid * WGM, gsz = (nM - fm) < WGM ? (nM - fm) : WGM;
        u.pm = fm + ((wgid % nig) % gsz); u.pn = (wgid % nig) / gsz; u.pb = u.pn; u.e = 0; return true;
    }
};
struct GroupedOrder {
    int NP, G, c, U; const PG8_LAS int* tp;
    __device__ void init(int NP_, int G_, int c_, const PG8_LAS int* tp_) { NP = NP_; G = G_; c = c_; tp = tp_; U = NP_ * tp_[32]; }
    __device__ bool next(int i, Unit& u) const {
        const int L = i * G + c; if (L >= U) return false;
        int w; { const int q = U / NXCD, r = U % NXCD, xcd = L % NXCD, off = L / NXCD; w = (xcd < r ? xcd * (q + 1) : r * (q + 1) + (xcd - r) * q) + off; }
        int e = 0; while (e < 31 && NP * tp[e + 1] <= w) ++e;
        const int local = w - NP * tp[e], nrt = tp[e + 1] - tp[e];
        const int pn = local / nrt, rt = tp[e] + (local - pn * nrt);
        u.pm = rt; u.pn = pn; u.pb = e * NP + pn; u.e = e; return true;
    }
};

__device__ __forceinline__ unsigned cvt_pk_bf16(float lo, float hi) { unsigned r; asm volatile("v_cvt_pk_bf16_f32 %0, %1, %2" : "=v"(r) : "v"(lo), "v"(hi)); return r; }
__device__ __forceinline__ float bf_lo(unsigned w) { return __uint_as_float(w << 16); }
__device__ __forceinline__ float bf_hi(unsigned w) { return __uint_as_float(w & 0xffff0000u); }
__device__ __forceinline__ float sigm(float x) { return __builtin_amdgcn_rcpf(1.0f + __expf(-x)); }

struct EpiBf16B {
    static constexpr bool PERM = true;
    bf16_t* O; int ldc; const float* bias; int bias_stride;
    __device__ __forceinline__ void operator()(const f32x4 (&acc)[2][2][4][2], const Unit& u, int wr, int wc, int fr, int fq) const {
        const int row0 = u.pm * BM + wr * 64 + fr, col0 = u.pn * BM + wc * 32 + 8 * fq;
        f32x4 bv[2][2];
#pragma unroll
        for (int bj = 0; bj < 2; ++bj)
#pragma unroll
            for (int n = 0; n < 2; ++n) bv[bj][n] = bias ? *(const f32x4*)(bias + (size_t)u.e * bias_stride + col0 + bj * HALF + 4 * n) : (f32x4){0.f, 0.f, 0.f, 0.f};
#pragma unroll
        for (int ai = 0; ai < 2; ++ai)
#pragma unroll
            for (int m = 0; m < 4; ++m) { bf16_t* rowp = O + (size_t)(row0 + ai * HALF + m * 16) * ldc + col0;
#pragma unroll
                for (int bj = 0; bj < 2; ++bj) { const f32x4 v0 = acc[ai][bj][m][0] + bv[bj][0], v1 = acc[ai][bj][m][1] + bv[bj][1];
                    u32x4 w; w.x = cvt_pk_bf16(v0[0], v0[1]); w.y = cvt_pk_bf16(v0[2], v0[3]); w.z = cvt_pk_bf16(v1[0], v1[1]); w.w = cvt_pk_bf16(v1[2], v1[3]);
                    *(u32x4*)(rowp + bj * HALF) = w; } }
    }
};
template <bool ADD> struct EpiGate {
    static constexpr bool PERM = true;
    bf16_t* T; int ldc; const bf16_t* gate; int gld;
    __device__ __forceinline__ void operator()(const f32x4 (&acc)[2][2][4][2], const Unit& u, int wr, int wc, int fr, int fq) const {
        const int row0 = u.pm * BM + wr * 64 + fr, col0 = u.pn * BM + wc * 32 + 8 * fq;
#pragma unroll
        for (int ai = 0; ai < 2; ++ai)
#pragma unroll
            for (int m = 0; m < 4; ++m) { const size_t r = (size_t)(row0 + ai * HALF + m * 16); bf16_t* rowp = T + r * ldc + col0; const bf16_t* gp = gate + r * gld + col0;
#pragma unroll
                for (int bj = 0; bj < 2; ++bj) { const u32x4 g = *(const u32x4*)(gp + bj * HALF); const f32x4 a0 = acc[ai][bj][m][0], a1 = acc[ai][bj][m][1];
                    float o[8];
                    o[0] = sigm(bf_lo(g.x)) * a0[0]; o[1] = sigm(bf_hi(g.x)) * a0[1]; o[2] = sigm(bf_lo(g.y)) * a0[2]; o[3] = sigm(bf_hi(g.y)) * a0[3];
                    o[4] = sigm(bf_lo(g.z)) * a1[0]; o[5] = sigm(bf_hi(g.z)) * a1[1]; o[6] = sigm(bf_lo(g.w)) * a1[2]; o[7] = sigm(bf_hi(g.w)) * a1[3];
                    if (ADD) { const u32x4 t = *(const u32x4*)(rowp + bj * HALF);
                        o[0] += bf_lo(t.x); o[1] += bf_hi(t.x); o[2] += bf_lo(t.y); o[3] += bf_hi(t.y); o[4] += bf_lo(t.z); o[5] += bf_hi(t.z); o[6] += bf_lo(t.w); o[7] += bf_hi(t.w); }
                    u32x4 w; w.x = cvt_pk_bf16(o[0], o[1]); w.y = cvt_pk_bf16(o[2], o[3]); w.z = cvt_pk_bf16(o[4], o[5]); w.w = cvt_pk_bf16(o[6], o[7]);
                    *(u32x4*)(rowp + bj * HALF) = w; } }
    }
};
struct EpiResid {
    static constexpr bool PERM = false;
    const float* x; float* out; int ldc; const float* gvec; int gstride; int rows_per_batch;
    __device__ __forceinline__ void operator()(const f32x4 (&acc)[2][2][4][2], const Unit& u, int wr, int wc, int fr, int fq) const {
        const int row0 = u.pm * BM + wr * 64 + fr, col0 = u.pn * BM + wc * 32 + 4 * fq;
        const float* gp = gvec + (size_t)((u.pm * BM) / rows_per_batch) * gstride + col0;
        f32x4 gv[2][2];
#pragma unroll
        for (int bj = 0; bj < 2; ++bj)
#pragma unroll
            for (int n = 0; n < 2; ++n) gv[bj][n] = *(const f32x4*)(gp + bj * HALF + n * 16);
#pragma unroll
        for (int ai = 0; ai < 2; ++ai)
#pragma unroll
            for (int m = 0; m < 4; ++m) { const size_t off = (size_t)(row0 + ai * HALF + m * 16) * ldc + col0;
#pragma unroll
                for (int bj = 0; bj < 2; ++bj)
#pragma unroll
                    for (int n = 0; n < 2; ++n) { const f32x4 xv = *(const f32x4*)(x + off + bj * HALF + n * 16); *(f32x4*)(out + off + bj * HALF + n * 16) = xv + gv[bj][n] * acc[ai][bj][m][n]; } }
    }
};
struct EpiSwiglu {
    static constexpr bool PERM = true;
    bf16_t* O; int ldc; const float* bgate; const float* bup; int bias_stride;
    __device__ __forceinline__ void operator()(const f32x4 (&acc)[2][2][4][2], const Unit& u, int wr, int wc, int fr, int fq) const {
        const int row0 = u.pm * BM + wr * 64 + fr, col0 = u.pn * HALF + wc * 32 + 8 * fq;
        f32x4 bg[2], bu[2];
#pragma unroll
        for (int n = 0; n < 2; ++n) { bg[n] = *(const f32x4*)(bgate + (size_t)u.e * bias_stride + col0 + 4 * n); bu[n] = *(const f32x4*)(bup + (size_t)u.e * bias_stride + col0 + 4 * n); }
#pragma unroll
        for (int ai = 0; ai < 2; ++ai)
#pragma unroll
            for (int m = 0; m < 4; ++m) { float o[8];
#pragma unroll
                for (int n = 0; n < 2; ++n)
#pragma unroll
                    for (int j = 0; j < 4; ++j) { const float gt = fminf(acc[ai][0][m][n][j] + bg[n][j], 7.0f), up = fminf(fmaxf(acc[ai][1][m][n][j] + bu[n][j], -7.0f), 7.0f);
                        o[4 * n + j] = gt * sigm(1.702f * gt) * (up + 1.0f); }
                u32x4 w; w.x = cvt_pk_bf16(o[0], o[1]); w.y = cvt_pk_bf16(o[2], o[3]); w.z = cvt_pk_bf16(o[4], o[5]); w.w = cvt_pk_bf16(o[6], o[7]);
                *(u32x4*)(O + (size_t)(row0 + ai * HALF + m * 16) * ldc + col0) = w; }
    }
};

template <class Epi, class Sched, bool ALIGN_EPI = false, bool SP2 = false>
__device__ __forceinline__ void gemm_phase(PG8_LAS unsigned char* lds, const Gemm g, const Sched& S, const Epi& E) {
    const int tid = threadIdx.x, wid = __builtin_amdgcn_readfirstlane(tid >> 6), lane = tid & 63, wr = wid >> 2, wc = wid & 3, fr = lane & 15, fq = lane >> 4;
    const int K = g.K, nt = K / BK;
    unsigned voffA[2], voffB[2];
#pragma unroll
    for (int i = 0; i < 2; ++i) { int R, C; stage_rc(tid * 16 + i * 8192, R, C); const int Rb = Epi::PERM ? ((R & ~31) + perm32(R & 31)) : R;
        voffA[i] = (unsigned)(R * K + C) * 2u; voffB[i] = (unsigned)(Rb * K + C) * 2u; }
    const size_t kstep = (size_t)(BK * 2);
    const size_t hstep = (size_t)HALF * K * 2;
    const size_t tstep = 2 * hstep;
    const unsigned ldsw = (unsigned)wid * 1024u;
    const int aoff = lds_byte(wr * 64 + fr, fq * 8), boff = lds_byte(wc * 32 + fr, fq * 8);
#define PG8_SA(b, h) (((b) * 2 + (h)) * HTB)
#define PG8_SB(b, h) ((4 + (b) * 2 + (h)) * HTB)
#define PG8_STAGE(bufoff, gbase, voff) do { _Pragma("unroll") for (int _i = 0; _i < 2; ++_i) \
        __builtin_amdgcn_global_load_lds((const unsigned*)((const char*)(gbase) + (voff)[_i]), (PG8_LAS unsigned*)(lds + (bufoff) + ldsw + _i * 8192), 16, 0, 0); } while (0)
#define PG8_LDA(dst, b, h) do { _Pragma("unroll") for (int m = 0; m < 4; ++m) _Pragma("unroll") for (int k = 0; k < 2; ++k) dst[m][k] = *(const PG8_LAS bf16x8*)(lds + PG8_SA(b, h) + aoff + m * 2048 + k * 1024); } while (0)
#define PG8_LDB(dst, b, h) do { _Pragma("unroll") for (int n = 0; n < 2; ++n) _Pragma("unroll") for (int k = 0; k < 2; ++k) dst[n][k] = *(const PG8_LAS bf16x8*)(lds + PG8_SB(b, h) + boff + n * 2048 + k * 1024); } while (0)
#define PG8_MMA(ai, bj, At, Bt) do { __builtin_amdgcn_s_setprio(1); _Pragma("unroll") for (int m = 0; m < 4; ++m) _Pragma("unroll") for (int n = 0; n < 2; ++n) _Pragma("unroll") for (int k = 0; k < 2; ++k) \
        acc[ai][bj][m][n] = __builtin_amdgcn_mfma_f32_16x16x32_bf16(Bt[n][k], At[m][k], acc[ai][bj][m][n], 0, 0, 0); __builtin_amdgcn_s_setprio(0); } while (0)
#define PG8_WAIT_V(n) asm volatile("s_waitcnt vmcnt(" #n ")" ::: "memory")
#define PG8_WAIT_L(n) asm volatile("s_waitcnt lgkmcnt(" #n ")" ::: "memory")
#define PG8_BAR __builtin_amdgcn_s_barrier()
#define PG8_SCHED __builtin_amdgcn_sched_barrier(0)
    Unit cur, nxt; int ui = 0;
    if (!S.next(0, cur)) return;
    f32x4 acc[2][2][4][2];
#pragma unroll
    for (int a = 0; a < 2; ++a)
#pragma unroll
        for (int b = 0; b < 2; ++b)
#pragma unroll
            for (int m = 0; m < 4; ++m)
#pragma unroll
                for (int n = 0; n < 2; ++n) acc[a][b][m][n] = (f32x4){0.f, 0.f, 0.f, 0.f};
    bf16x8 At[4][2], B0[2][2], B1[2][2];
    const char* cA = (const char*)g.A + (size_t)cur.pm * tstep; const char* cB = (const char*)g.Bt + (size_t)cur.pb * tstep;
    if constexpr (SP2) {
        PG8_STAGE(PG8_SB(0, 0), cB, voffB); PG8_STAGE(PG8_SB(0, 1), cB + hstep, voffB); PG8_STAGE(PG8_SA(0, 0), cA, voffA); PG8_STAGE(PG8_SA(0, 1), cA + hstep, voffA);
        if (wr == 1) PG8_BAR;
        PG8_WAIT_V(2); PG8_BAR;
        PG8_STAGE(PG8_SB(1, 0), cB + kstep, voffB); PG8_STAGE(PG8_SA(1, 0), cA + kstep, voffA); PG8_STAGE(PG8_SB(1, 1), cB + hstep + kstep, voffB);
        PG8_WAIT_V(6); PG8_BAR;
    } else {
        PG8_STAGE(PG8_SB(0, 0), cB, voffB); PG8_STAGE(PG8_SA(0, 0), cA, voffA); PG8_STAGE(PG8_SB(0, 1), cB + hstep, voffB); PG8_STAGE(PG8_SA(0, 1), cA + hstep, voffA);
        if (wr == 1) PG8_BAR;
        PG8_WAIT_V(4); PG8_BAR;
        PG8_STAGE(PG8_SB(1, 0), cB + kstep, voffB); PG8_STAGE(PG8_SA(1, 0), cA + kstep, voffA); PG8_STAGE(PG8_SB(1, 1), cB + hstep + kstep, voffB);
        PG8_WAIT_V(6); PG8_BAR;
    }
    for (;;) {
        const bool has_next = S.next(ui + 1, nxt);
        const char* nA = has_next ? (const char*)g.A + (size_t)nxt.pm * tstep : cA; const char* nB = has_next ? (const char*)g.Bt + (size_t)nxt.pb * tstep : cB;
        for (int t = 0; t < nt; t += 2) {
            const bool last = (t == nt - 2);
            const char* a1 = cA + (size_t)(t + 1) * kstep;
            const char* a2 = last ? nA : cA + (size_t)(t + 2) * kstep; const char* b2 = last ? nB : cB + (size_t)(t + 2) * kstep;
            const char* a3 = a2 + kstep; const char* b3 = b2 + kstep;
            if constexpr (SP2) {
            PG8_LDB(B0, 0, 0); PG8_LDB(B1, 0, 1); PG8_SCHED; PG8_LDA(At, 0, 0); PG8_STAGE(PG8_SA(1, 1), a1 + hstep, voffA);
            PG8_WAIT_V(8); PG8_WAIT_L(0); PG8_BAR; PG8_MMA(0, 0, At, B0); PG8_MMA(0, 1, At, B1); PG8_BAR; PG8_SCHED;
            PG8_LDA(At, 0, 1); PG8_STAGE(PG8_SB(0, 0), b2, voffB); PG8_STAGE(PG8_SB(0, 1), b2 + hstep, voffB); PG8_STAGE(PG8_SA(0, 0), a2, voffA);
            PG8_WAIT_V(8); PG8_WAIT_L(0); PG8_BAR; PG8_MMA(1, 0, At, B0); PG8_MMA(1, 1, At, B1); PG8_BAR; PG8_SCHED;
            PG8_LDB(B0, 1, 0); PG8_LDB(B1, 1, 1); PG8_SCHED; PG8_LDA(At, 1, 0); PG8_STAGE(PG8_SA(0, 1), a2 + hstep, voffA);
            PG8_WAIT_V(8); PG8_WAIT_L(0); PG8_BAR; PG8_MMA(0, 0, At, B0); PG8_MMA(0, 1, At, B1); PG8_BAR; PG8_SCHED;
            PG8_LDA(At, 1, 1); PG8_STAGE(PG8_SB(1, 0), b3, voffB); PG8_STAGE(PG8_SB(1, 1), b3 + hstep, voffB); PG8_STAGE(PG8_SA(1, 0), a3, voffA);
            PG8_WAIT_V(8); PG8_WAIT_L(0); PG8_BAR; PG8_MMA(1, 0, At, B0); PG8_MMA(1, 1, At, B1); PG8_BAR; PG8_SCHED;
            } else {
            PG8_LDB(B0, 0, 0); PG8_SCHED; PG8_LDA(At, 0, 0); PG8_STAGE(PG8_SA(1, 1), a1 + hstep, voffA);
            PG8_WAIT_L(8); PG8_BAR; PG8_WAIT_L(0); PG8_MMA(0, 0, At, B0); PG8_BAR; PG8_SCHED;
            PG8_LDB(B1, 0, 1); PG8_STAGE(PG8_SB(0, 0), b2, voffB);
            PG8_BAR; PG8_WAIT_L(0); PG8_MMA(0, 1, At, B1); PG8_BAR;
            PG8_LDA(At, 0, 1); PG8_STAGE(PG8_SA(0, 0), a2, voffA);
            PG8_BAR; PG8_WAIT_L(0); PG8_MMA(1, 0, At, B0); PG8_BAR; PG8_SCHED;
            PG8_STAGE(PG8_SB(0, 1), b2 + hstep, voffB);
            PG8_WAIT_V(6); PG8_BAR; PG8_MMA(1, 1, At, B1); PG8_BAR;
            PG8_LDB(B0, 1, 0); PG8_SCHED; PG8_LDA(At, 1, 0); PG8_STAGE(PG8_SA(0, 1), a2 + hstep, voffA);
            PG8_WAIT_L(8); PG8_BAR; PG8_WAIT_L(0); PG8_MMA(0, 0, At, B0); PG8_BAR; PG8_SCHED;
            PG8_LDB(B1, 1, 1); PG8_STAGE(PG8_SB(1, 0), b3, voffB);
            PG8_BAR; PG8_WAIT_L(0); PG8_MMA(0, 1, At, B1); PG8_BAR;
            PG8_LDA(At, 1, 1); PG8_STAGE(PG8_SA(1, 0), a3, voffA);
            PG8_BAR; PG8_WAIT_L(0); PG8_MMA(1, 0, At, B0); PG8_BAR; PG8_SCHED;
            PG8_STAGE(PG8_SB(1, 1), b3 + hstep, voffB);
            PG8_WAIT_V(6); PG8_BAR; PG8_MMA(1, 1, At, B1); PG8_BAR;
            }
        }
        if constexpr (ALIGN_EPI) { if (wr == 0) PG8_BAR; }
        E(acc, cur, wr, wc, fr, fq);
        if (!has_next) break;
#pragma unroll
        for (int a = 0; a < 2; ++a)
#pragma unroll
            for (int b = 0; b < 2; ++b)
#pragma unroll
                for (int m = 0; m < 4; ++m)
#pragma unroll
                    for (int n = 0; n < 2; ++n) acc[a][b][m][n] = (f32x4){0.f, 0.f, 0.f, 0.f};
        cur = nxt; cA = nA; cB = nB; ++ui;
        if constexpr (ALIGN_EPI) { if (wr == 1) PG8_BAR; }
    }
    PG8_WAIT_V(0);
    if constexpr (!ALIGN_EPI) { if (wr == 0) PG8_BAR; }
    PG8_BAR;
#undef PG8_SA
#undef PG8_SB
#undef PG8_STAGE
#undef PG8_LDA
#undef PG8_LDB
#undef PG8_MMA
#undef PG8_WAIT_V
#undef PG8_WAIT_L
#undef PG8_BAR
#undef PG8_SCHED
}
}

namespace mk {
using pg8::bf16_t; using pg8::bf16x8; using pg8::f32x4; using pg8::u32x4; using pg8::u32x2; using pg8::cvt_pk_bf16; using pg8::bf_lo; using pg8::bf_hi;
constexpr int D = 2048, NB = 4, S = 4096, L = 256, NTOK = NB * S, NCTX = NB * L, MR = NTOK + NCTX;
constexpr int INW = 16384, MODW = 12288;
constexpr int RH = 8, NH = 16;
constexpr int NE = 32, FF = 2048, NSLOT256 = 288 * 256;
constexpr int C_QR = 0, C_KR = 1024, C_VR = 2048, C_GR = 4096, C_QN = 6144, C_KN = 8192, C_VN = 10240, C_GA = 12288, C_GB = 14336;
constexpr float QK_SCALE = 0.08838834764831845f, LOG2E = 1.4426950408889634f;
constexpr size_t MiB = 1u << 20;
constexpr size_t WS_CTL = 0, CTL_ZERO_BYTES = 1 * MiB;
constexpr size_t WS_MOD = 1 * MiB;
constexpr size_t WS_ASG_E = 2 * MiB, WS_ASG_POS = 3 * MiB, WS_ASG_W = 4 * MiB;
constexpr size_t WS_WIN = 16 * MiB;
constexpr size_t WS_WPA = 80 * MiB, WS_WPB = 88 * MiB, WS_WO = 96 * MiB;
constexpr size_t WS_WGU = 104 * MiB;
constexpr size_t WS_WDN = 616 * MiB;
constexpr size_t WS_HB = 872 * MiB;
constexpr size_t WS_YB = 940 * MiB;
constexpr size_t WS_XB = 940 * MiB, WS_ACTB = 1228 * MiB;
constexpr size_t WS_OF = 1484 * MiB, WS_OB = 1548 * MiB, WS_NAOB = 1612 * MiB, WS_T1 = 1676 * MiB;
constexpr int CW_CNT = 64;
constexpr int CW_BAR = 4096;
constexpr int LDS_BYTES = 155648, MISC_OFF = 153600;

#define GAS __attribute__((address_space(1)))
#define LAS __attribute__((address_space(3)))
typedef GAS unsigned gu32;
#define RLX_AGENT __ATOMIC_RELAXED, __HIP_MEMORY_SCOPE_AGENT

__device__ __forceinline__ unsigned f2bf(float f) { unsigned u = __float_as_uint(f); return (u + 0x7fffu + ((u >> 16) & 1u)) >> 16; }
__device__ __forceinline__ unsigned pk2(float lo, float hi) { return f2bf(lo) | (f2bf(hi) << 16); }
__device__ __forceinline__ float wave_sum(float v) {
#pragma unroll
    for (int o = 1; o < 64; o <<= 1) v += __shfl_xor(v, o);
    return v;
}

#define XB_TMO      128
#define XB_XCNT(j)  (256  + 64 * (j))
#define XB_XSUB(j)  (1280 + 64 * (j))
#define XB_XGEN(j)  (2304 + 64 * (j))
#define XB_TOP      3328
#define XB_TOPGEN   3392
#define XCD_BAR_WORDS 3456
#define XB_SPIN_CAP (1u << 18)
__device__ __forceinline__ unsigned xb_ld(unsigned* p)              { return __hip_atomic_load(p, __ATOMIC_RELAXED, __HIP_MEMORY_SCOPE_AGENT); }
__device__ __forceinline__ unsigned xb_add(unsigned* p, unsigned v) { return __hip_atomic_fetch_add(p, v, __ATOMIC_RELAXED, __HIP_MEMORY_SCOPE_AGENT); }
__device__ __forceinline__ unsigned xb_xcc_id() { return (unsigned)__builtin_amdgcn_s_getreg((3 << 11) | 20) & 0xFu; }
#define XB_SPIN(cond, bar) do { unsigned _sp = 0; while (cond) { __builtin_amdgcn_s_sleep(1); \
    if ((++_sp & 255u) == 0u) { if (xb_ld(&(bar)[XB_TMO])) break; if (_sp > XB_SPIN_CAP) { atomicAdd(&(bar)[XB_TMO], 1u); break; } } } } while (0)
struct XcdBarrier { unsigned* bar; unsigned x; volatile LAS unsigned* st; };
__device__ __forceinline__ XcdBarrier xcd_barrier_post(unsigned* bar, volatile LAS unsigned* st) {
    XcdBarrier b; b.bar = bar; b.x = xb_xcc_id(); b.st = st;
    if (threadIdx.x == 0) (void)xb_add(&bar[XB_XCNT(b.x)], 1u);
    return b;
}
__device__ __forceinline__ void xcd_barrier_complete(unsigned* bar, unsigned x, unsigned& nloc, unsigned& nx) {
    const unsigned G = gridDim.x * gridDim.y * gridDim.z;
    unsigned sum, cnt, mine, sp = 0u;
    for (;;) {
        sum = 0u; cnt = 0u; mine = 0u;
#pragma unroll
        for (unsigned j = 0; j < 16; ++j) { const unsigned c = xb_ld(&bar[XB_XCNT(j)]); sum += c; cnt += (c > 0u) ? 1u : 0u; mine = (j == x) ? c : mine; }
        if (sum == G) break;
        __builtin_amdgcn_s_sleep(1);
        if ((++sp & 255u) == 0u) { if (xb_ld(&bar[XB_TMO])) break; if (sp > XB_SPIN_CAP) { atomicAdd(&bar[XB_TMO], 1u); break; } }
    }
    nloc = mine > 0u ? mine : 1u; nx = cnt > 0u ? cnt : 1u;
}
__device__ __forceinline__ void xcd_barrier(const XcdBarrier& b) {
    asm volatile("s_waitcnt vmcnt(0)" ::: "memory");
    __syncthreads();
    if (threadIdx.x == 0) {
        unsigned* bar = b.bar;
        __builtin_amdgcn_s_waitcnt(0);
        unsigned nloc = b.st[0], nx = b.st[1];
        if (nloc == 0u) { xcd_barrier_complete(bar, b.x, nloc, nx); b.st[0] = nloc; b.st[1] = nx; }
        const unsigned old = xb_add(&bar[XB_XSUB(b.x)], 1u);
        const unsigned gen = old / nloc;
        if (old + 1u == (gen + 1u) * nloc) {
            __builtin_amdgcn_fence(__ATOMIC_RELEASE, "agent");
            asm volatile("s_waitcnt vmcnt(0)" ::: "memory");
            const unsigned og = xb_add(&bar[XB_TOP], 1u);
            const unsigned tg = og / nx;
            if (og + 1u == (tg + 1u) * nx) xb_add(&bar[XB_TOPGEN], 1u);
            else XB_SPIN(xb_ld(&bar[XB_TOPGEN]) == tg, bar);
            __builtin_amdgcn_fence(__ATOMIC_ACQUIRE, "agent");
            xb_add(&bar[XB_XGEN(b.x)], 1u);
            asm volatile("s_waitcnt vmcnt(0)" ::: "memory");
        } else {
            XB_SPIN(xb_ld(&bar[XB_XGEN(b.x)]) == gen, bar);
            __builtin_amdgcn_fence(__ATOMIC_ACQUIRE, "agent");
            asm volatile("s_waitcnt vmcnt(0)" ::: "memory");
        }
    }
    __syncthreads();
}

typedef const float* fptr_t;
struct Frame {
    LAS unsigned char* lds;
    volatile LAS unsigned* MISC;
    unsigned* ctl;
    unsigned char* ws;
    int tid, lane, wave, G, bx;
    const __attribute__((address_space(4))) fptr_t* in;
    float* out;
};
#define LDS_WAIT() asm volatile("s_waitcnt lgkmcnt(0)" ::: "memory")

__device__ __forceinline__ void p0_transpose_item(const float* W, int K, int N, bf16_t* WT, int k0, int n0, size_t drow0, float scale, LAS float* scr, int lane) {
#pragma unroll 8
    for (int i = 0; i < 32; ++i) { const int kk = 2 * i + (lane >> 5); scr[kk * 33 + (lane & 31)] = W[(size_t)(k0 + kk) * N + n0 + (lane & 31)]; }
    LDS_WAIT(); asm volatile("" ::: "memory");
    const int c = lane & 7;
#pragma unroll
    for (int j = 0; j < 4; ++j) { const int n = (lane >> 3) + 8 * j; const LAS float* s = scr + (8 * c) * 33 + n;
        u32x4 o; o.x = pk2(s[0 * 33] * scale, s[1 * 33] * scale); o.y = pk2(s[2 * 33] * scale, s[3 * 33] * scale); o.z = pk2(s[4 * 33] * scale, s[5 * 33] * scale); o.w = pk2(s[6 * 33] * scale, s[7 * 33] * scale);
        *(u32x4*)(WT + (drow0 + n) * (size_t)K + k0 + 8 * c) = o; }
    LDS_WAIT(); asm volatile("" ::: "memory");
}

__device__ __forceinline__ void p0_mod_slab(Frame& F, int slab) {
    LAS float* sv = (LAS float*)F.lds;
    LAS float* red = (LAS float*)(F.lds + 40960);
    const float* c = F.in[1]; const float* cc = F.in[3]; const float* W = F.in[4]; const float* bias = F.in[5];
    for (int i = F.tid; i < 5 * D; i += 512) { const int r = i / D, k = i % D; const float v = r < 4 ? c[r * D + k] : cc[k]; sv[i] = v / (1.0f + __expf(-v)); }
    __syncthreads();
    const int rr = F.tid >> 4, cq = F.tid & 15, col0 = slab * 64 + 4 * cq;
    f32x4 a[5];
#pragma unroll
    for (int r = 0; r < 5; ++r) a[r] = (f32x4){0.f, 0.f, 0.f, 0.f};
#pragma unroll 4
    for (int it = 0; it < 64; ++it) { const int k = rr + 32 * it; const f32x4 w = *(const f32x4*)(W + (size_t)k * MODW + col0);
#pragma unroll
        for (int r = 0; r < 5; ++r) a[r] += w * sv[r * D + k]; }
#pragma unroll
    for (int r = 0; r < 5; ++r) *(LAS f32x4*)(red + (rr * 5 + r) * 64 + 4 * cq) = a[r];
    __syncthreads();
    if (F.tid < 320) { const int r = F.tid >> 6, cl = F.tid & 63; float s = 0.f;
        for (int q = 0; q < 32; ++q) s += red[(q * 5 + r) * 64 + cl];
        ((float*)(F.ws + WS_MOD))[r * MODW + slab * 64 + cl] = s + bias[slab * 64 + cl]; }
    __syncthreads();
}

__device__ __forceinline__ void p0_prologue(Frame& F, bool conv_moe) {
    if (F.bx < 192) p0_mod_slab(F, F.bx);
    LAS float* scr = (LAS float*)(F.lds + F.wave * 16384);
    const int gw = F.bx * 8 + F.wave, NGW = F.G * 8;
    constexpr int I_IN = (D / 64) * (INW / 32), I_SQ = (D / 64) * (D / 32);
    const int NIT = I_IN + 3 * I_SQ + (conv_moe ? 96 * I_SQ : 0);
    for (int it = gw; it < NIT; it += NGW) {
        int r = it;
        if (r < I_IN) { const int kb = r / (INW / 32), nb = r % (INW / 32), n0 = nb * 32; const bool sc = (n0 >= C_KR && n0 < C_VR) || (n0 >= C_QN && n0 < C_KN);
            p0_transpose_item(F.in[8], D, INW, (bf16_t*)(F.ws + WS_WIN), kb * 64, n0, (size_t)n0, sc ? QK_SCALE : 1.0f, scr, F.lane); continue; }
        r -= I_IN;
        if (r < 3 * I_SQ) { const int mtx = r / I_SQ, q = r % I_SQ, kb = q / 64, nb = q % 64;
            p0_transpose_item(mtx == 0 ? F.in[9] : (mtx == 1 ? F.in[10] : F.in[11]), D, D, (bf16_t*)(F.ws + WS_WPA + (size_t)mtx * 8 * MiB), kb * 64, nb * 32, (size_t)nb * 32, 1.0f, scr, F.lane); continue; }
        r -= 3 * I_SQ;
        { const int mtx = r / (32 * I_SQ), q = r % (32 * I_SQ), e = q / I_SQ, q2 = q % I_SQ, kb = q2 / 64, nb = q2 % 64, n0 = nb * 32;
          if (mtx < 2) { const float* src = (mtx == 0 ? F.in[17] : F.in[19]) + (size_t)e * D * FF;
              const size_t drow0 = (size_t)e * 4096 + (size_t)(n0 >> 7) * 256 + (size_t)(mtx * 128) + (size_t)(n0 & 127) - (size_t)n0;
              p0_transpose_item(src, D, FF, (bf16_t*)(F.ws + WS_WGU), kb * 64, n0, drow0 + n0, 1.0f, scr, F.lane); }
          else { const float* src = F.in[21] + (size_t)e * FF * D;
              p0_transpose_item(src, FF, D, (bf16_t*)(F.ws + WS_WDN), kb * 64, n0, (size_t)e * 2048 + n0, 1.0f, scr, F.lane); } }
    }
}

__device__ __forceinline__ void p1_rows(Frame& F) {
    const int gw = F.bx * 8 + F.wave, NGW = F.G * 8;
    const float* mod = (const float*)(F.ws + WS_MOD); const float* g = F.in[6];
    bf16_t* HB = (bf16_t*)(F.ws + WS_HB);
    for (int m = gw; m < MR; m += NGW) {
        const float* src = m < NTOK ? F.in[0] + (size_t)m * D : F.in[2] + (size_t)(m - NTOK) * D;
        const float* md = mod + (size_t)(m < NTOK ? m / S : 4) * MODW;
        f32x4 v[8]; float ss = 0.f;
#pragma unroll
        for (int j = 0; j < 8; ++j) { v[j] = *(const f32x4*)(src + 4 * F.lane + 256 * j); ss += (v[j][0] * v[j][0] + v[j][1] * v[j][1]) + (v[j][2] * v[j][2] + v[j][3] * v[j][3]); }
        const float rstd = rsqrtf(wave_sum(ss) * (1.0f / D) + 1e-6f);
#pragma unroll
        for (int j = 0; j < 8; ++j) { const int k = 4 * F.lane + 256 * j; const f32x4 gg = *(const f32x4*)(g + k), sh = *(const f32x4*)(md + k), sc = *(const f32x4*)(md + D + k);
            const f32x4 y = v[j] * rstd * gg * (sc + 1.0f) + sh; u32x2 o; o.x = pk2(y[0], y[1]); o.y = pk2(y[2], y[3]);
            *(u32x2*)(HB + (size_t)m * D + k) = o; }
    }
}

typedef short v4i16_t __attribute__((ext_vector_type(4)));
__device__ __forceinline__ v4i16_t ds_tr(const LAS unsigned char* p) { return __builtin_amdgcn_ds_read_tr16_b64_v4i16((LAS v4i16_t*)p); }
__device__ __forceinline__ bf16x8 cat8(v4i16_t a, v4i16_t b) { bf16x8 r; r[0] = a[0]; r[1] = a[1]; r[2] = a[2]; r[3] = a[3]; r[4] = b[0]; r[5] = b[1]; r[6] = b[2]; r[7] = b[3]; return r; }
#define MFMA16(a, b, c) __builtin_amdgcn_mfma_f32_16x16x32_bf16((a), (b), (c), 0, 0, 0)

constexpr int R_QS = 0, R_KS = 34816, R_KZ = 69632, R_VS = 106496, R_RT = 126976;
constexpr int PQ = 272, PK = 272, PZ = 288, PV = 160, PR = 272;

__device__ __forceinline__ void ret_unit(Frame& F, int b, int h, int dir, int dvs) {
    LAS unsigned char* lds = F.lds;
    __syncthreads();
    const int tid = F.tid, w = F.wave;
    const bf16_t* YB = (const bf16_t*)(F.ws + WS_YB);
    bf16_t* OUT = (bf16_t*)(F.ws + (dir ? WS_OB : WS_OF));
    const float dec = (dir ? F.in[13] : F.in[12])[h];
    const float l2g = -log1pf(expf(-dec)) * LOG2E;
    const float gC = exp2f(128.0f * l2g);
    u32x4 rq[2][2], rk[2][2], rv[2];
    f32x4 Racc[2][2];
#pragma unroll
    for (int a = 0; a < 2; ++a)
#pragma unroll
        for (int c = 0; c < 2; ++c) Racc[a][c] = (f32x4){0.f, 0.f, 0.f, 0.f};
    for (int i = tid; i < 64 * PR / 16; i += 512) *(LAS u32x4*)(lds + R_RT + i * 16) = (u32x4){0u, 0u, 0u, 0u};

    auto base_row = [&](int it) -> int { if (it < 2) { const int ci = dir ? 1 - it : it; return NTOK + b * L + ci * 128; } const int ci = dir ? 31 - (it - 2) : (it - 2); return b * S + ci * 128; };
    auto issue = [&](int it, int tz) {
        const int br = base_row(it); const int aj = tz & 7, colq = (aj >> 2) * 64 + 8 * (aj & 3);
#pragma unroll
        for (int i = 0; i < 2; ++i) { const int p = (tz >> 3) + 64 * i; const size_t row = (size_t)(br + (dir ? 127 - p : p));
            const bf16_t* rp = YB + row * INW;
            if (it >= 2) { rq[i][0] = *(const u32x4*)(rp + C_QR + h * 128 + colq); rq[i][1] = *(const u32x4*)(rp + C_QR + h * 128 + colq + 32); }
            rk[i][0] = *(const u32x4*)(rp + C_KR + h * 128 + colq); rk[i][1] = *(const u32x4*)(rp + C_KR + h * 128 + colq + 32);
            rv[i] = *(const u32x4*)(rp + C_VR + h * 256 + dvs * 64 + 8 * aj); }
    };
    auto commit = [&](int it, int tz, float l2z) {
        const int br = base_row(it); const bool lat = it >= 2; const int aj = tz & 7, axis = aj >> 2, jj = aj & 3, colq = axis * 64 + 8 * jj;
        float invrev[8];
#pragma unroll
        for (int e = 0; e < 8; ++e) invrev[e] = exp2f(-(float)(2 * (8 * jj + e)) * (13.287712379549449f / 64.0f)) * 0.15915494309189535f;
#pragma unroll
        for (int i = 0; i < 2; ++i) { const int p = (tz >> 3) + 64 * i; const int t = (br - b * S) + (dir ? 127 - p : p);
            float cs[8], sn[8];
            if (lat) { const float pos = (float)(axis == 0 ? (t >> 6) : (t & 63));
#pragma unroll
                for (int e = 0; e < 8; ++e) { const float rev = pos * invrev[e]; cs[e] = __builtin_amdgcn_cosf(rev); sn[e] = __builtin_amdgcn_sinf(rev); } }
            else {
#pragma unroll
                for (int e = 0; e < 8; ++e) { cs[e] = 1.0f; sn[e] = 0.0f; } }
            const float zeta = exp2f((float)(127 - p) * l2z);
            const unsigned a1[4] = {rk[i][0].x, rk[i][0].y, rk[i][0].z, rk[i][0].w}, a2[4] = {rk[i][1].x, rk[i][1].y, rk[i][1].z, rk[i][1].w};
            u32x4 k1, k2, z1, z2; unsigned* k1p = (unsigned*)&k1; unsigned* k2p = (unsigned*)&k2; unsigned* z1p = (unsigned*)&z1; unsigned* z2p = (unsigned*)&z2;
#pragma unroll
            for (int q = 0; q < 4; ++q) { const float x1a = bf_lo(a1[q]), x1b = bf_hi(a1[q]), x2a = bf_lo(a2[q]), x2b = bf_hi(a2[q]);
                const float o1a = x1a * cs[2 * q] - x2a * sn[2 * q], o1b = x1b * cs[2 * q + 1] - x2b * sn[2 * q + 1];
                const float o2a = x2a * cs[2 * q] + x1a * sn[2 * q], o2b = x2b * cs[2 * q + 1] + x1b * sn[2 * q + 1];
                k1p[q] = pk2(o1a, o1b); k2p[q] = pk2(o2a, o2b); z1p[q] = pk2(o1a * zeta, o1b * zeta); z2p[q] = pk2(o2a * zeta, o2b * zeta); }
            *(LAS u32x4*)(lds + R_KS + p * PK + colq * 2) = k1; *(LAS u32x4*)(lds + R_KS + p * PK + (colq + 32) * 2) = k2;
            *(LAS u32x4*)(lds + R_KZ + p * PZ + colq * 2) = z1; *(LAS u32x4*)(lds + R_KZ + p * PZ + (colq + 32) * 2) = z2;
            if (lat) { const unsigned b1[4] = {rq[i][0].x, rq[i][0].y, rq[i][0].z, rq[i][0].w}, b2[4] = {rq[i][1].x, rq[i][1].y, rq[i][1].z, rq[i][1].w};
                u32x4 q1, q2; unsigned* q1p = (unsigned*)&q1; unsigned* q2p = (unsigned*)&q2;
#pragma unroll
                for (int q = 0; q < 4; ++q) { const float x1a = bf_lo(b1[q]), x1b = bf_hi(b1[q]), x2a = bf_lo(b2[q]), x2b = bf_hi(b2[q]);
                    q1p[q] = pk2(x1a * cs[2 * q] - x2a * sn[2 * q], x1b * cs[2 * q + 1] - x2b * sn[2 * q + 1]);
                    q2p[q] = pk2(x2a * cs[2 * q] + x1a * sn[2 * q], x2b * cs[2 * q + 1] + x1b * sn[2 * q + 1]); }
                *(LAS u32x4*)(lds + R_QS + p * PQ + colq * 2) = q1; *(LAS u32x4*)(lds + R_QS + p * PQ + (colq + 32) * 2) = q2; }
            *(LAS u32x4*)(lds + R_VS + p * PV + aj * 16) = rv[i]; }
    };

    issue(0, tid);
    commit(0, tid, l2g);
    __syncthreads();
    const int wr4 = w >> 1, wc2 = w & 1;
    const int wr2 = w >> 2, wc4 = w & 3;
    for (int it = 0; it < 34; ++it) {
        const bool lat = it >= 2;
        float l2i = l2g; int tz = tid; asm volatile("" : "+v"(l2i), "+v"(tz));
        const int fr = tz & 15, fq = (tz & 63) >> 4;
        f32x4 Sacc[2][4], Oacc[2][2];
        if (lat) {
#pragma unroll
            for (int a = 0; a < 2; ++a) {
#pragma unroll
                for (int c = 0; c < 4; ++c) Sacc[a][c] = (f32x4){0.f, 0.f, 0.f, 0.f};
#pragma unroll
                for (int c = 0; c < 2; ++c) Oacc[a][c] = (f32x4){0.f, 0.f, 0.f, 0.f}; }
#pragma unroll
            for (int ks = 0; ks < 4; ++ks) {
                bf16x8 qa[2], kb[4], rb[2];
#pragma unroll
                for (int a = 0; a < 2; ++a) qa[a] = *(const LAS bf16x8*)(lds + R_QS + (32 * wr4 + 16 * a + fr) * PQ + (32 * ks + 8 * fq) * 2);
#pragma unroll
                for (int c = 0; c < 4; ++c) kb[c] = *(const LAS bf16x8*)(lds + R_KS + (64 * wc2 + 16 * c + fr) * PK + (32 * ks + 8 * fq) * 2);
#pragma unroll
                for (int c = 0; c < 2; ++c) rb[c] = *(const LAS bf16x8*)(lds + R_RT + (32 * wc2 + 16 * c + fr) * PR + (32 * ks + 8 * fq) * 2);
#pragma unroll
                for (int a = 0; a < 2; ++a) {
#pragma unroll
                    for (int c = 0; c < 4; ++c) Sacc[a][c] = MFMA16(kb[c], qa[a], Sacc[a][c]);
#pragma unroll
                    for (int c = 0; c < 2; ++c) Oacc[a][c] = MFMA16(rb[c], qa[a], Oacc[a][c]); }
            }
        }
        __syncthreads();
        if (lat) {
#pragma unroll
            for (int a = 0; a < 2; ++a)
#pragma unroll
                for (int c = 0; c < 4; ++c) { const int cr = 32 * wr4 + 16 * a + fr, m0 = 64 * wc2 + 16 * c + 4 * fq; float o[4];
#pragma unroll
                    for (int j = 0; j < 4; ++j) { const int dlt = cr - (m0 + j); o[j] = dlt >= 0 ? Sacc[a][c][j] * exp2f((float)dlt * l2i) : 0.0f; }
                    u32x2 wv; wv.x = pk2(o[0], o[1]); wv.y = pk2(o[2], o[3]);
                    *(LAS u32x2*)(lds + R_KS + cr * PK + m0 * 2) = wv; }
        }
        if (it + 1 < 34) issue(it + 1, tz);
        {
#pragma unroll
            for (int a = 0; a < 2; ++a)
#pragma unroll
                for (int c = 0; c < 2; ++c) Racc[a][c] *= gC;
#pragma unroll
            for (int ks = 0; ks < 4; ++ks) {
                bf16x8 va[2], zb[2];
                const int c0 = 32 * ks + 8 * fq + (fr >> 2);
#pragma unroll
                for (int a = 0; a < 2; ++a) va[a] = cat8(ds_tr(lds + R_VS + c0 * PV + (32 * wr2 + 16 * a + 4 * (fr & 3)) * 2), ds_tr(lds + R_VS + (c0 + 4) * PV + (32 * wr2 + 16 * a + 4 * (fr & 3)) * 2));
#pragma unroll
                for (int c = 0; c < 2; ++c) zb[c] = cat8(ds_tr(lds + R_KZ + c0 * PZ + (32 * wc4 + 16 * c + 4 * (fr & 3)) * 2), ds_tr(lds + R_KZ + (c0 + 4) * PZ + (32 * wc4 + 16 * c + 4 * (fr & 3)) * 2));
#pragma unroll
                for (int a = 0; a < 2; ++a)
#pragma unroll
                    for (int c = 0; c < 2; ++c) Racc[a][c] = MFMA16(zb[c], va[a], Racc[a][c]);
            }
        }
        __syncthreads();
        if (lat) {
#pragma unroll
            for (int a = 0; a < 2; ++a) { const float xi = exp2f((float)(32 * wr4 + 16 * a + fr + 1) * l2i);
#pragma unroll
                for (int c = 0; c < 2; ++c) Oacc[a][c] *= xi; }
#pragma unroll
            for (int ks = 0; ks < 4; ++ks) {
                bf16x8 sa[2], vb[2];
                const int c0 = 32 * ks + 8 * fq + (fr >> 2);
#pragma unroll
                for (int a = 0; a < 2; ++a) sa[a] = *(const LAS bf16x8*)(lds + R_KS + (32 * wr4 + 16 * a + fr) * PK + (32 * ks + 8 * fq) * 2);
#pragma unroll
                for (int c = 0; c < 2; ++c) vb[c] = cat8(ds_tr(lds + R_VS + c0 * PV + (32 * wc2 + 16 * c + 4 * (fr & 3)) * 2), ds_tr(lds + R_VS + (c0 + 4) * PV + (32 * wc2 + 16 * c + 4 * (fr & 3)) * 2));
#pragma unroll
                for (int a = 0; a < 2; ++a)
#pragma unroll
                    for (int c = 0; c < 2; ++c) Oacc[a][c] = MFMA16(vb[c], sa[a], Oacc[a][c]);
            }
            const int br = base_row(it);
#pragma unroll
            for (int a = 0; a < 2; ++a) { const int p = 32 * wr4 + 16 * a + fr; const size_t row = (size_t)(br + (dir ? 127 - p : p));
#pragma unroll
                for (int c = 0; c < 2; ++c) { u32x2 wv; wv.x = pk2(Oacc[a][c][0], Oacc[a][c][1]); wv.y = pk2(Oacc[a][c][2], Oacc[a][c][3]);
                    *(u32x2*)(OUT + row * D + h * 256 + dvs * 64 + 32 * wc2 + 16 * c + 4 * fq) = wv; } }
        }
#pragma unroll
        for (int a = 0; a < 2; ++a)
#pragma unroll
            for (int c = 0; c < 2; ++c) { u32x2 wv; wv.x = pk2(Racc[a][c][0], Racc[a][c][1]); wv.y = pk2(Racc[a][c][2], Racc[a][c][3]);
                *(LAS u32x2*)(lds + R_RT + (32 * wr2 + 16 * a + fr) * PR + (32 * wc4 + 16 * c + 4 * fq) * 2) = wv; }
        __syncthreads();
        if (it + 1 < 34) commit(it + 1, tz, l2i);
        __syncthreads();
    }
}

constexpr int N_K = 0, N_V = 18432, N_RPB = 36864, NP_ = 288;
__device__ __forceinline__ void na_unit(Frame& F, int b, int h, int rp) {
    LAS unsigned char* lds = F.lds;
    const int tid = F.tid, lane = F.lane, w = F.wave, fr = lane & 15, fq = lane >> 4;
    const bf16_t* YB = (const bf16_t*)(F.ws + WS_YB);
    bf16_t* NAOB = (bf16_t*)(F.ws + WS_NAOB);
    const int r0 = 2 * rp, qrow = r0 + (w >> 2), j = w & 3;
    const int kstart = j == 0 ? 0 : (j == 1 ? 8 : (j == 2 ? 24 : 32));
    const int rs_w = min(max(qrow - 4, 0), 56);
    const int lo = min(max(r0 - 4, 0), 56), hi = min(max(r0 + 1 - 4, 0), 56) + 7, nloc = hi - lo + 1, ns = nloc + 4;
    const int qc = 16 * j + fr, cs = min(max(qc - 8, 0), 48);
    bf16x8 Qf[4];
    { const bf16_t* qp = YB + (size_t)(b * S + qrow * 64 + 16 * j + fr) * INW + C_QN + h * 128 + 8 * fq;
#pragma unroll
      for (int ks = 0; ks < 4; ++ks) Qf[ks] = *(const bf16x8*)(qp + 32 * ks); }
    f32x4 O[8];
#pragma unroll
    for (int d = 0; d < 8; ++d) O[d] = (f32x4){0.f, 0.f, 0.f, 0.f};
    float m_run = -1e30f, l_part = 0.f;
    u32x4 rk[2], rv[2];
    auto issue = [&](int st) {
#pragma unroll
        for (int i = 0; i < 2; ++i) { const int T = tid + 512 * i, key = T >> 4, ch = T & 15;
            const size_t row = st < nloc ? (size_t)(b * S + (lo + st) * 64 + key) : (size_t)(NTOK + b * L + (st - nloc) * 64 + key);
            rk[i] = *(const u32x4*)(YB + row * INW + C_KN + h * 128 + 8 * ch); rv[i] = *(const u32x4*)(YB + row * INW + C_VN + h * 128 + 8 * ch); }
    };
    auto block32 = [&](int kb0, bool local, int kr) {
        f32x4 Sx[2];
#pragma unroll
        for (int t = 0; t < 2; ++t) { Sx[t] = (f32x4){0.f, 0.f, 0.f, 0.f};
#pragma unroll
            for (int ks = 0; ks < 4; ++ks) { const bf16x8 kf = *(const LAS bf16x8*)(lds + N_K + (kb0 + 16 * t + fr) * NP_ + (32 * ks + 8 * fq) * 2); Sx[t] = MFMA16(kf, Qf[ks], Sx[t]); } }
        float s[8]; float mx = -1e30f;
#pragma unroll
        for (int t = 0; t < 2; ++t)
#pragma unroll
            for (int e = 0; e < 4; ++e) { float v = Sx[t][e] * LOG2E;
                if (local) { const int kc = kb0 + 16 * t + 4 * fq + e; const bool ok = kc >= cs && kc < cs + 16;
                    const int bi = min(max(kc - qc + 15, 0), 30);
                    v = ok ? v + ((const LAS float*)(lds + N_RPB))[(kr - qrow + 7) * 31 + bi] : -1e30f; }
                s[4 * t + e] = v; mx = fmaxf(mx, v); }
        mx = fmaxf(mx, __shfl_xor(mx, 16)); mx = fmaxf(mx, __shfl_xor(mx, 32));
        const float m_new = fmaxf(m_run, mx), alpha = exp2f(m_run - m_new);
        float ps = 0.f; float p[8];
#pragma unroll
        for (int e = 0; e < 8; ++e) { p[e] = exp2f(s[e] - m_new); ps += p[e]; }
        l_part = l_part * alpha + ps; m_run = m_new;
#pragma unroll
        for (int d = 0; d < 8; ++d) O[d] *= alpha;
        u32x4 pw; pw.x = pk2(p[0], p[1]); pw.y = pk2(p[2], p[3]); pw.z = pk2(p[4], p[5]); pw.w = pk2(p[6], p[7]);
        const bf16x8 pf = __builtin_bit_cast(bf16x8, pw);
        const int k0 = kb0 + 4 * fq + (fr >> 2);
#pragma unroll
        for (int d = 0; d < 8; ++d) { const bf16x8 vf = cat8(ds_tr(lds + N_V + k0 * NP_ + (16 * d + 4 * (fr & 3)) * 2), ds_tr(lds + N_V + (k0 + 16) * NP_ + (16 * d + 4 * (fr & 3)) * 2));
            O[d] = MFMA16(vf, pf, O[d]); }
    };
    issue(0);
    for (int st = 0; st < ns; ++st) {
        __syncthreads();
#pragma unroll
        for (int i = 0; i < 2; ++i) { const int T = tid + 512 * i, key = T >> 4, ch = T & 15;
            *(LAS u32x4*)(lds + N_K + key * NP_ + ch * 16) = rk[i]; *(LAS u32x4*)(lds + N_V + key * NP_ + ch * 16) = rv[i]; }
        if (st == 0 && tid < 465) ((LAS float*)(lds + N_RPB))[tid] = F.in[14][h * 465 + tid] * LOG2E;
        __syncthreads();
        if (st + 1 < ns) issue(st + 1);
        if (st < nloc) { const int kr = lo + st; if (kr >= rs_w && kr < rs_w + 8) block32(kstart, true, kr); }
        else { block32(0, false, 0); block32(32, false, 0); }
    }
    float l = l_part; l += __shfl_xor(l, 16); l += __shfl_xor(l, 32);
    const float inv = 1.0f / l;
    bf16_t* op = NAOB + (size_t)(b * S + qrow * 64 + 16 * j + fr) * D + h * 128 + 4 * fq;
#pragma unroll
    for (int d = 0; d < 8; ++d) { u32x2 wv; wv.x = pk2(O[d][0] * inv, O[d][1] * inv); wv.y = pk2(O[d][2] * inv, O[d][3] * inv); *(u32x2*)(op + 16 * d) = wv; }
}

__device__ __forceinline__ void p4_rows(Frame& F) {
    const int gw = F.bx * 8 + F.wave, NGW = F.G * 8;
    const bf16_t* OF = (const bf16_t*)(F.ws + WS_OF); const bf16_t* OB = (const bf16_t*)(F.ws + WS_OB); const bf16_t* YB = (const bf16_t*)(F.ws + WS_YB);
    bf16_t* A1B = (bf16_t*)(F.ws + WS_HB);
    for (int m = gw; m < NTOK; m += NGW) {
#pragma unroll
        for (int hh = 0; hh < RH; ++hh) { const size_t o = (size_t)m * D + hh * 256 + 4 * F.lane;
            const u32x2 a = *(const u32x2*)(OF + o), c = *(const u32x2*)(OB + o), g = *(const u32x2*)(YB + (size_t)m * INW + C_GR + hh * 256 + 4 * F.lane);
            float v[4] = {bf_lo(a.x) + bf_lo(c.x), bf_hi(a.x) + bf_hi(c.x), bf_lo(a.y) + bf_lo(c.y), bf_hi(a.y) + bf_hi(c.y)};
            const float mu = wave_sum((v[0] + v[1]) + (v[2] + v[3])) * (1.0f / 256.0f);
#pragma unroll
            for (int q = 0; q < 4; ++q) v[q] -= mu;
            const float rstd = rsqrtf(wave_sum((v[0] * v[0] + v[1] * v[1]) + (v[2] * v[2] + v[3] * v[3])) * (1.0f / 256.0f) + 1e-5f);
            const float gg[4] = {bf_lo(g.x), bf_hi(g.x), bf_lo(g.y), bf_hi(g.y)};
#pragma unroll
            for (int q = 0; q < 4; ++q) v[q] = v[q] * rstd * gg[q] * pg8::sigm(gg[q]);
            u32x2 wv; wv.x = pk2(v[0], v[1]); wv.y = pk2(v[2], v[3]); *(u32x2*)(A1B + o) = wv; }
    }
}

__device__ __forceinline__ void p7_route(Frame& F) {
    LAS float* gs = (LAS float*)(F.lds);
    LAS float* shv = (LAS float*)(F.lds + 8192);
    LAS float* part = (LAS float*)(F.lds + 16384);
    LAS float* ssq = (LAS float*)(F.lds + 32768);
    LAS float* qc = (LAS float*)(F.lds + 33280);
    LAS float* lgt = (LAS float*)(F.lds + 35328);
    LAS float* rsd = (LAS float*)(F.lds + 37376);
    const int tid = F.tid, lane = F.lane, w = F.wave, ri = lane & 15, kq = lane >> 4;
    const float* X1 = F.out; const float* g2 = F.in[7]; const float* Wr = F.in[15]; const float* br = F.in[16];
    const float* mod = (const float*)(F.ws + WS_MOD);
    bf16_t* H2B = (bf16_t*)(F.ws + WS_HB);
    int* asg_e = (int*)(F.ws + WS_ASG_E); int* asg_pos = (int*)(F.ws + WS_ASG_POS); float* asg_w = (float*)(F.ws + WS_ASG_W);
    unsigned* counts = F.ctl + CW_CNT;
    for (int grp = F.bx; grp < NTOK / 16; grp += F.G) {
        const int row0 = grp * 16, bb = row0 / S; const float* md = mod + (size_t)bb * MODW;
        __syncthreads();
        for (int k = tid; k < D; k += 512) { gs[k] = g2[k] * (1.0f + md[4 * D + k]); shv[k] = md[3 * D + k]; }
        __syncthreads();
        { const int e = tid & 31, pt = tid >> 5; float s = 0.f;
          for (int k = pt * 128; k < pt * 128 + 128; ++k) s += shv[k] * Wr[k * 32 + e];
          qc[pt * 32 + e] = s; }
        f32x4 acc0 = (f32x4){0.f, 0.f, 0.f, 0.f}, acc1 = acc0; float ss = 0.f;
        const float* xr = X1 + (size_t)(row0 + ri) * D + 256 * w + 4 * kq;
#pragma unroll 4
        for (int s = 0; s < 16; ++s) { const int k0 = 256 * w + 16 * s + 4 * kq; const f32x4 xv = *(const f32x4*)(xr + 16 * s);
            ss += (xv[0] * xv[0] + xv[1] * xv[1]) + (xv[2] * xv[2] + xv[3] * xv[3]);
#pragma unroll
            for (int q = 0; q < 4; ++q) { const float a = xv[q] * gs[k0 + q]; const float b0 = Wr[(k0 + q) * 32 + ri], b1 = Wr[(k0 + q) * 32 + 16 + ri];
                acc0 = __builtin_amdgcn_mfma_f32_16x16x4f32(a, b0, acc0, 0, 0, 0); acc1 = __builtin_amdgcn_mfma_f32_16x16x4f32(a, b1, acc1, 0, 0, 0); } }
        ss += __shfl_xor(ss, 16); ss += __shfl_xor(ss, 32);
#pragma unroll
        for (int q = 0; q < 4; ++q) { part[(w * 16 + 4 * kq + q) * 32 + ri] = acc0[q]; part[(w * 16 + 4 * kq + q) * 32 + 16 + ri] = acc1[q]; }
        if (kq == 0) ssq[w * 16 + ri] = ss;
        __syncthreads();
        { const int row = tid >> 5, e = tid & 31; float sq = 0.f, pp = 0.f, qq = 0.f;
#pragma unroll
          for (int q = 0; q < 8; ++q) { sq += ssq[q * 16 + row]; pp += part[(q * 16 + row) * 32 + e]; }
#pragma unroll
          for (int q = 0; q < 16; ++q) qq += qc[q * 32 + e];
          const float rstd = rsqrtf(sq * (1.0f / D) + 1e-6f);
          lgt[row * 32 + e] = rstd * pp + qq + br[e]; if (e == 0) rsd[row] = rstd; }
        __syncthreads();
        if (tid < 16) { const int m = row0 + tid; int sel[4]; float val[4]; unsigned used = 0u;
#pragma unroll
            for (int k = 0; k < 4; ++k) { int bi = -1; float bv = 0.f;
                for (int e = 0; e < 32; ++e) { const float x = lgt[tid * 32 + e]; if (!((used >> e) & 1u) && (bi < 0 || x > bv)) { bi = e; bv = x; } }
                used |= 1u << bi; sel[k] = bi; val[k] = bv; }
            float den = 0.f, ex[4];
#pragma unroll
            for (int k = 0; k < 4; ++k) { ex[k] = __expf(val[k] - val[0]); den += ex[k]; }
#pragma unroll
            for (int k = 0; k < 4; ++k) { const unsigned pos = atomicAdd(&counts[sel[k]], 1u); asg_e[m * 4 + k] = sel[k]; asg_pos[m * 4 + k] = (int)pos; asg_w[m * 4 + k] = ex[k] / den; } }
        for (int i = tid; i < 16 * (D / 4); i += 512) { const int row = i >> 9, k = (i & 511) * 4; const float rstd = rsd[row];
            const f32x4 xv = *(const f32x4*)(X1 + (size_t)(row0 + row) * D + k);
            const float y0 = xv[0] * rstd * gs[k] + shv[k], y1 = xv[1] * rstd * gs[k + 1] + shv[k + 1], y2 = xv[2] * rstd * gs[k + 2] + shv[k + 2], y3 = xv[3] * rstd * gs[k + 3] + shv[k + 3];
            u32x2 wv; wv.x = pk2(y0, y1); wv.y = pk2(y2, y3); *(u32x2*)(H2B + (size_t)(row0 + row) * D + k) = wv; }
    }
}

__device__ __forceinline__ void load_tp(Frame& F, LAS int* tp) {
    __syncthreads();
    if (F.tid == 0) { int a = 0; for (int e = 0; e < 32; ++e) { tp[e] = a; a += ((int)__hip_atomic_load(F.ctl + CW_CNT + e, RLX_AGENT) + 255) >> 8; } tp[32] = a; }
    __syncthreads();
}
__device__ __forceinline__ void p8_gather(Frame& F, LAS int* tp) {
    const int gw = F.bx * 8 + F.wave, NGW = F.G * 8;
    const bf16_t* H2B = (const bf16_t*)(F.ws + WS_HB); bf16_t* XB = (bf16_t*)(F.ws + WS_XB);
    const int* asg_e = (const int*)(F.ws + WS_ASG_E); const int* asg_pos = (const int*)(F.ws + WS_ASG_POS);
    for (int a = gw; a < NTOK * 4; a += NGW) { const int e = asg_e[a], slot = 256 * tp[e] + asg_pos[a];
        const u32x4* src = (const u32x4*)(H2B + (size_t)(a >> 2) * D) + F.lane; u32x4* dst = (u32x4*)(XB + (size_t)slot * D) + F.lane;
        const u32x4 v0 = src[0], v1 = src[64], v2 = src[128], v3 = src[192]; dst[0] = v0; dst[64] = v1; dst[128] = v2; dst[192] = v3; }
}
__device__ __forceinline__ void p11_final(Frame& F, LAS int* tp) {
    const int gw = F.bx * 8 + F.wave, NGW = F.G * 8;
    const bf16_t* YSB = (const bf16_t*)(F.ws + WS_XB);
    const int* asg_e = (const int*)(F.ws + WS_ASG_E); const int* asg_pos = (const int*)(F.ws + WS_ASG_POS); const float* asg_w = (const float*)(F.ws + WS_ASG_W);
    const float* mod = (const float*)(F.ws + WS_MOD); const float* fg = F.in[23];
    for (int m = gw; m < NTOK; m += NGW) {
        const float* g2v = mod + (size_t)(m / S) * MODW + 5 * D;
        size_t so[4]; float wk[4];
#pragma unroll
        for (int k = 0; k < 4; ++k) { so[k] = (size_t)(256 * tp[asg_e[m * 4 + k]] + asg_pos[m * 4 + k]) * D; wk[k] = asg_w[m * 4 + k]; }
        f32x4 v[8]; float ss = 0.f;
#pragma unroll
        for (int j = 0; j < 8; ++j) { const int n = 4 * F.lane + 256 * j; f32x4 y = (f32x4){0.f, 0.f, 0.f, 0.f};
#pragma unroll
            for (int k = 0; k < 4; ++k) { const u32x2 t = *(const u32x2*)(YSB + so[k] + n); y += (f32x4){bf_lo(t.x), bf_hi(t.x), bf_lo(t.y), bf_hi(t.y)} * wk[k]; }
            v[j] = *(const f32x4*)(F.out + (size_t)m * D + n) + *(const f32x4*)(g2v + n) * y;
            ss += (v[j][0] * v[j][0] + v[j][1] * v[j][1]) + (v[j][2] * v[j][2] + v[j][3] * v[j][3]); }
        const float rstd = rsqrtf(wave_sum(ss) * (1.0f / D) + 1e-6f);
#pragma unroll
        for (int j = 0; j < 8; ++j) { const int n = 4 * F.lane + 256 * j; *(f32x4*)(F.out + (size_t)m * D + n) = v[j] * rstd * *(const f32x4*)(fg + n); }
    }
}

struct Args { const float* in[24]; float* out; unsigned char* ws; int ph_lo, ph_hi; };
constexpr int NPH = 12;
__global__ void __launch_bounds__(512, 2) mk_fwd(Args args) {
    extern __shared__ __attribute__((aligned(16))) unsigned char lds[];
    Frame F;
    F.lds = (LAS unsigned char*)lds; F.MISC = (volatile LAS unsigned*)(F.lds + MISC_OFF);
    F.tid = threadIdx.x; F.lane = F.tid & 63; F.wave = __builtin_amdgcn_readfirstlane(F.tid >> 6); F.G = gridDim.x; F.bx = blockIdx.x;
    F.ws = args.ws; F.ctl = (unsigned*)(args.ws + WS_CTL); F.out = args.out;
    F.in = (const __attribute__((address_space(4))) fptr_t*)__builtin_amdgcn_kernarg_segment_ptr();
    for (int u = F.tid; u < (LDS_BYTES - MISC_OFF) / 4; u += 512) ((LAS unsigned*)(F.lds + MISC_OFF))[u] = 0u;
    __syncthreads();
    const int lo = args.ph_lo, hi = args.ph_hi;
    const bool multi = (hi - lo) > 1;
    XcdBarrier bar; bar.bar = F.ctl + CW_BAR; bar.x = 0; bar.st = nullptr;
    if (multi) bar = xcd_barrier_post(F.ctl + CW_BAR, F.MISC + 8);
#ifndef MK_PHMASK
#define MK_PHMASK 0xfff
#endif
#define IN(k) (((MK_PHMASK >> (k)) & 1) && lo <= (k) && (k) < hi)
#define SEAM(k) do { if (IN(k) && IN((k) + 1)) xcd_barrier(bar); } while (0)
    LAS int* tp = (LAS int*)(F.lds + MISC_OFF + 256);

    if (IN(0)) { p0_prologue(F, MK_STAGE >= 5); } SEAM(0);
    if (IN(1)) { p1_rows(F); } SEAM(1);
    if (IN(2)) {
        pg8::Gemm g{(const bf16_t*)(F.ws + WS_HB), (const bf16_t*)(F.ws + WS_WIN), D}; pg8::StaticOrder So; So.init(MR, INW, F.G, F.bx);
        pg8::EpiBf16B E{(bf16_t*)(F.ws + WS_YB), INW, nullptr, 0};
        pg8::gemm_phase<pg8::EpiBf16B, pg8::StaticOrder, true, true>(F.lds, g, So, E);
    } SEAM(2);
    if (IN(3)) {
        for (int u = F.bx; u < 256; u += F.G) { const int x = u & 7, jj = u >> 3; ret_unit(F, (x + 8 * (jj >> 3)) >> 3, (x + 8 * (jj >> 3)) & 7, (jj & 7) >> 2, jj & 3); }
        for (int i = 0; ; ++i) { const int L_ = i * F.G + F.bx; if (L_ >= 2048) break; const int c = L_ % 256, ii = L_ / 256; const int bh = 8 * ii + (c & 7), rp = c >> 3; na_unit(F, bh >> 4, bh & 15, rp); }
        __syncthreads();
    } SEAM(3);
    if (IN(4)) { p4_rows(F); } SEAM(4);
    if (IN(5)) {
        pg8::StaticOrder So; So.init(NTOK, D, F.G, F.bx);
        { pg8::Gemm g{(const bf16_t*)(F.ws + WS_HB), (const bf16_t*)(F.ws + WS_WPA), D}; pg8::EpiGate<false> E{(bf16_t*)(F.ws + WS_T1), D, (const bf16_t*)(F.ws + WS_YB) + C_GA, INW};
          pg8::gemm_phase<pg8::EpiGate<false>, pg8::StaticOrder, true, true>(F.lds, g, So, E); }
        { pg8::Gemm g{(const bf16_t*)(F.ws + WS_NAOB), (const bf16_t*)(F.ws + WS_WPB), D}; pg8::EpiGate<true> E{(bf16_t*)(F.ws + WS_T1), D, (const bf16_t*)(F.ws + WS_YB) + C_GB, INW};
          pg8::gemm_phase<pg8::EpiGate<true>, pg8::StaticOrder, true, true>(F.lds, g, So, E); }
    } SEAM(5);
    if (IN(6)) {
        pg8::Gemm g{(const bf16_t*)(F.ws + WS_T1), (const bf16_t*)(F.ws + WS_WO), D}; pg8::StaticOrder So; So.init(NTOK, D, F.G, F.bx);
        pg8::EpiResid E{F.in[0], F.out, D, (const float*)(F.ws + WS_MOD) + 2 * D, MODW, S};
        pg8::gemm_phase<pg8::EpiResid, pg8::StaticOrder, true, true>(F.lds, g, So, E);
    } SEAM(6);
    if (IN(7)) { p7_route(F); } SEAM(7);
    if (IN(8)) { load_tp(F, tp); p8_gather(F, tp); } SEAM(8);
    if (IN(9)) {
        load_tp(F, tp);
        pg8::Gemm g{(const bf16_t*)(F.ws + WS_XB), (const bf16_t*)(F.ws + WS_WGU), D}; pg8::GroupedOrder So; So.init(16, F.G, F.bx, tp);
        pg8::EpiSwiglu E{(bf16_t*)(F.ws + WS_ACTB), FF, F.in[18], F.in[20], FF};
        pg8::gemm_phase<pg8::EpiSwiglu, pg8::GroupedOrder, true, true>(F.lds, g, So, E);
    } SEAM(9);
    if (IN(10)) {
        load_tp(F, tp);
        pg8::Gemm g{(const bf16_t*)(F.ws + WS_ACTB), (const bf16_t*)(F.ws + WS_WDN), FF}; pg8::GroupedOrder So; So.init(8, F.G, F.bx, tp);
        pg8::EpiBf16B E{(bf16_t*)(F.ws + WS_XB), D, F.in[22], D};
        pg8::gemm_phase<pg8::EpiBf16B, pg8::GroupedOrder, true, true>(F.lds, g, So, E);
    } SEAM(10);
    if (IN(11)) { load_tp(F, tp); p11_final(F, tp); }
#undef IN
#undef SEAM
}
}

namespace nv {
using namespace mk;
constexpr int NSLOT = 544 * 128;
__device__ __forceinline__ float sigmoidf_(float x) { return 1.0f / (1.0f + expf(-x)); }
__device__ __forceinline__ float siluf_(float x) { return x * sigmoidf_(x); }
__device__ __forceinline__ float ldf(const float* p) { return *p; }
__device__ __forceinline__ float ldf(const bf16_t* p) { return __uint_as_float(((unsigned)*p) << 16); }
__device__ __forceinline__ float block_sum256(float v, float* red) {
#pragma unroll
    for (int o = 32; o >= 1; o >>= 1) v += __shfl_xor(v, o);
    __syncthreads();
    if ((threadIdx.x & 63) == 0) red[threadIdx.x >> 6] = v;
    __syncthreads();
    float r = 0.f;
    for (int i = 0; i < (int)(blockDim.x >> 6); ++i) r += red[i];
    return r;
}
__device__ __forceinline__ float block_max256(float v, float* red) {
#pragma unroll
    for (int o = 32; o >= 1; o >>= 1) v = fmaxf(v, __shfl_xor(v, o));
    __syncthreads();
    if ((threadIdx.x & 63) == 0) red[threadIdx.x >> 6] = v;
    __syncthreads();
    float r = red[0];
    for (int i = 1; i < (int)(blockDim.x >> 6); ++i) r = fmaxf(r, red[i]);
    return r;
}
template <class AF, class BF, class EF>
__global__ __launch_bounds__(256) void sgemm128(int N, int K, AF af, BF bf, EF ef) {
    __shared__ float As[16][132];
    __shared__ float Bs[16][132];
    const int tid = threadIdx.x, bm = blockIdx.y * 128, bn = blockIdx.x * 128;
    const float* Bbase = bf(blockIdx.y);
    if (!Bbase) return;
    const int ar = tid >> 1, ak = (tid & 1) * 8;
    const int bk = tid >> 4, bc = (tid & 15) * 8;
    const int ty = tid >> 4, tx = tid & 15;
    float acc[8][8];
#pragma unroll
    for (int i = 0; i < 8; ++i)
#pragma unroll
        for (int j = 0; j < 8; ++j) acc[i][j] = 0.f;
    for (int k0 = 0; k0 < K; k0 += 16) {
        float a8[8]; af.load8(bm + ar, k0 + ak, a8);
        const float4 b0 = *(const float4*)(Bbase + (size_t)(k0 + bk) * N + bn + bc);
        const float4 b1 = *(const float4*)(Bbase + (size_t)(k0 + bk) * N + bn + bc + 4);
        __syncthreads();
#pragma unroll
        for (int q = 0; q < 8; ++q) As[ak + q][ar] = a8[q];
        *(float4*)&Bs[bk][bc] = b0; *(float4*)&Bs[bk][bc + 4] = b1;
        __syncthreads();
#pragma unroll
        for (int kk = 0; kk < 16; ++kk) {
            float a[8], b[8];
            const float4 x0 = *(const float4*)&As[kk][ty * 8], x1 = *(const float4*)&As[kk][ty * 8 + 4];
            const float4 y0 = *(const float4*)&Bs[kk][tx * 8], y1 = *(const float4*)&Bs[kk][tx * 8 + 4];
            a[0] = x0.x; a[1] = x0.y; a[2] = x0.z; a[3] = x0.w; a[4] = x1.x; a[5] = x1.y; a[6] = x1.z; a[7] = x1.w;
            b[0] = y0.x; b[1] = y0.y; b[2] = y0.z; b[3] = y0.w; b[4] = y1.x; b[5] = y1.y; b[6] = y1.z; b[7] = y1.w;
#pragma unroll
            for (int i = 0; i < 8; ++i)
#pragma unroll
                for (int j = 0; j < 8; ++j) acc[i][j] += a[i] * b[j];
        }
    }
#pragma unroll
    for (int i = 0; i < 8; ++i)
#pragma unroll
        for (int j = 0; j < 8; ++j) ef(bm + ty * 8 + i, bn + tx * 8 + j, acc[i][j]);
}
template <class T> struct ARows { const T* A; long lda; __device__ void load8(int m, int k, float (&o)[8]) const {
#pragma unroll
    for (int q = 0; q < 8; ++q) o[q] = ldf(A + (size_t)m * lda + k + q); } };
template <class T> struct AGather { const T* A; long lda; const int* idx; __device__ void load8(int m, int k, float (&o)[8]) const { const int t = idx[m];
#pragma unroll
    for (int q = 0; q < 8; ++q) o[q] = t >= 0 ? ldf(A + (size_t)t * lda + k + q) : 0.f; } };
struct BOne { const float* Bp; __device__ const float* operator()(int) const { return Bp; } };
struct BExpert { const float* Bp; size_t stride; const int* blk_e; __device__ const float* operator()(int tm) const { int e = blk_e[tm]; return e >= 0 ? Bp + (size_t)e * stride : nullptr; } };
template <class TY> struct ERetGate { float* T; const TY* Y; __device__ void operator()(int m, int n, float v) const { T[(size_t)m * D + n] = sigmoidf_(ldf(Y + (size_t)m * INW + C_GA + n)) * v; } };
template <class TY> struct ENaGate { float* T; const TY* Y; __device__ void operator()(int m, int n, float v) const { T[(size_t)m * D + n] += sigmoidf_(ldf(Y + (size_t)m * INW + C_GB + n)) * v; } };
struct EResid { float* out; const float* x; const float* mod; __device__ void operator()(int m, int n, float v) const { out[(size_t)m * D + n] = x[(size_t)m * D + n] + mod[(m / S) * MODW + 2 * D + n] * v; } };
struct EGate { float* G; const float* bias; const int* blk_e; __device__ void operator()(int m, int n, float v) const { int e = blk_e[m >> 7]; G[(size_t)m * FF + n] = v + bias[e * FF + n]; } };
struct EUp { float* ACT; const float* G; const float* bias; const int* blk_e; __device__ void operator()(int m, int n, float v) const { int e = blk_e[m >> 7];
    float gate = fminf(G[(size_t)m * FF + n], 7.0f), up = fminf(fmaxf(v + bias[e * FF + n], -7.0f), 7.0f);
    ACT[(size_t)m * FF + n] = gate * sigmoidf_(1.702f * gate) * (up + 1.0f); } };
struct EDown { float* YS; const float* bias; const int* blk_e; __device__ void operator()(int m, int n, float v) const { int e = blk_e[m >> 7]; YS[(size_t)m * D + n] = v + bias[e * D + n]; } };

__device__ __forceinline__ float rope_val(const bf16_t* hrow, int t, int d) {
    const int axis = d >> 6, half = (d >> 5) & 1, f = d & 31;
    const float pos = (float)(axis == 0 ? (t >> 6) : (t & 63));
    const float inv = powf(10000.0f, -(float)(2 * f) / 64.0f);
    const float ang = pos * inv, cs = cosf(ang), sn = sinf(ang);
    const float x1 = ldf(hrow + axis * 64 + f), x2 = ldf(hrow + axis * 64 + 32 + f);
    return half == 0 ? x1 * cs - x2 * sn : x2 * cs + x1 * sn;
}
__global__ __launch_bounds__(256) void k_ret(const bf16_t* Y, const float* dec_f, const float* dec_b, float* O) {
    __shared__ float qs[16][128];
    __shared__ float ks[64][129];
    __shared__ float wsm[16][64];
    const int t0 = blockIdx.x * 16, h = blockIdx.y, b = blockIdx.z, tid = threadIdx.x;
    const float lgf = -log1pf(expf(-dec_f[h])), lgb = -log1pf(expf(-dec_b[h]));
    for (int idx = tid; idx < 16 * 128; idx += 256) { int qi = idx >> 7, d = idx & 127; qs[qi][d] = rope_val(Y + (size_t)(b * S + t0 + qi) * INW + C_QR + h * 128, t0 + qi, d); }
    float acc[16];
#pragma unroll
    for (int i = 0; i < 16; ++i) acc[i] = 0.f;
    for (int u0 = 0; u0 < L + S; u0 += 64) {
        __syncthreads();
        for (int idx = tid; idx < 64 * 128; idx += 256) { int kk = idx >> 7, d = idx & 127, u = u0 + kk; float val;
            if (u < L) val = ldf(Y + (size_t)(NTOK + b * L + u) * INW + C_KR + h * 128 + d);
            else val = rope_val(Y + (size_t)(b * S + (u - L)) * INW + C_KR + h * 128, u - L, d);
            ks[kk][d] = val; }
        __syncthreads();
#pragma unroll
        for (int i = 0; i < 4; ++i) { int idx = tid + 256 * i, qi = idx >> 6, kk = idx & 63; float dot = 0.f;
            for (int d = 0; d < 128; ++d) dot += qs[qi][d] * ks[kk][d];
            const int t = t0 + qi, u = u0 + kk; float w;
            if (u < L) w = expf((float)(t + 1 + 255 - u) * lgf) + expf((float)(S - t + u) * lgb);
            else { const int s = u - L; w = (s <= t ? expf((float)(t - s) * lgf) : 0.f) + (s >= t ? expf((float)(s - t) * lgb) : 0.f); }
            wsm[qi][kk] = dot * w; }
        __syncthreads();
        for (int kk = 0; kk < 64; ++kk) { const int u = u0 + kk; const size_t row = u < L ? (size_t)(NTOK + b * L + u) : (size_t)(b * S + (u - L));
            const float v = ldf(Y + row * INW + C_VR + h * 256 + tid);
#pragma unroll
            for (int qi = 0; qi < 16; ++qi) acc[qi] += wsm[qi][kk] * v; }
    }
#pragma unroll
    for (int qi = 0; qi < 16; ++qi) O[(size_t)(b * S + t0 + qi) * D + h * 256 + tid] = acc[qi];
}
__global__ __launch_bounds__(256) void k_gn_gate(const float* O, const bf16_t* Y, float* A1) {
    __shared__ float red[8];
    const int m = blockIdx.x, tid = threadIdx.x;
    for (int h = 0; h < RH; ++h) {
        const float o = O[(size_t)m * D + h * 256 + tid];
        const float mu = block_sum256(o, red) * (1.0f / 256.0f);
        const float dlt = o - mu;
        const float var = block_sum256(dlt * dlt, red) * (1.0f / 256.0f);
        const float g = ldf(Y + (size_t)m * INW + C_GR + h * 256 + tid);
        A1[(size_t)m * D + h * 256 + tid] = siluf_(g) * dlt * rsqrtf(var + 1e-5f);
    }
}
__global__ __launch_bounds__(256) void k_na(const bf16_t* Y, const float* rpb, float* NAO) {
    __shared__ float qs[128];
    __shared__ float sc[384];
    __shared__ float red[8];
    __shared__ float part[128];
    const int t = blockIdx.x, h = blockIdx.y, b = blockIdx.z, tid = threadIdx.x, lane = tid & 63, w = tid >> 6;
    const int r = t >> 6, qc = t & 63;
    const int rs = min(max(r - 4, 0), 56), cs = min(max(qc - 8, 0), 48);
    if (tid < 128) qs[tid] = ldf(Y + (size_t)(b * S + t) * INW + C_QN + h * 128 + tid);
    __syncthreads();
    for (int key = w; key < 384; key += 4) {
        size_t row; float bias = 0.f;
        if (key < 128) { const int kr = key >> 4, kc = key & 15; row = (size_t)(b * S + (rs + kr) * 64 + cs + kc); bias = rpb[(h * 15 + (rs + kr - r + 7)) * 31 + (cs + kc - qc + 15)]; }
        else row = (size_t)(NTOK + b * L + (key - 128));
        const bf16_t* kp = Y + row * INW + C_KN + h * 128;
        float d = qs[lane] * ldf(kp + lane) + qs[lane + 64] * ldf(kp + lane + 64);
#pragma unroll
        for (int o = 32; o >= 1; o >>= 1) d += __shfl_xor(d, o);
        if (lane == 0) sc[key] = d + bias;
    }
    __syncthreads();
    float mx = -1e30f;
    for (int i = tid; i < 384; i += 256) mx = fmaxf(mx, sc[i]);
    mx = block_max256(mx, red);
    float sm = 0.f;
    for (int i = tid; i < 384; i += 256) { float e = expf(sc[i] - mx); sc[i] = e; sm += e; }
    sm = block_sum256(sm, red);
    const int d = tid & 127, half = tid >> 7;
    float acc = 0.f;
    for (int key = half * 192; key < half * 192 + 192; ++key) {
        size_t row;
        if (key < 128) { const int kr = key >> 4, kc = key & 15; row = (size_t)(b * S + (rs + kr) * 64 + cs + kc); }
        else row = (size_t)(NTOK + b * L + (key - 128));
        acc += sc[key] * ldf(Y + row * INW + C_VN + h * 128 + d);
    }
    if (half == 1) part[d] = acc;
    __syncthreads();
    if (half == 0) NAO[(size_t)(b * S + t) * D + h * 128 + d] = (acc + part[d]) / sm;
}
__global__ __launch_bounds__(256) void k_route(const float* X1, const float* g, const float* mod, const float* Wr, const float* br, float* H2,
                                               unsigned* counts, int* asg_e, int* asg_pos, float* asg_w) {
    __shared__ float red[8];
    __shared__ float hs[D];
    __shared__ float lg[32];
    const int m = blockIdx.x, tid = threadIdx.x, mr = m / S;
    float v[8]; float ss = 0.f;
#pragma unroll
    for (int i = 0; i < 8; ++i) { v[i] = X1[(size_t)m * D + tid + 256 * i]; ss += v[i] * v[i]; }
    ss = block_sum256(ss, red);
    const float rstd = rsqrtf(ss * (1.0f / D) + 1e-6f);
#pragma unroll
    for (int i = 0; i < 8; ++i) { int k = tid + 256 * i; float y = v[i] * rstd * g[k]; float hv = y * (1.0f + mod[mr * MODW + 4 * D + k]) + mod[mr * MODW + 3 * D + k]; hs[k] = hv; H2[(size_t)m * D + k] = hv; }
    __syncthreads();
    { const int e = tid >> 3, part = tid & 7; float d = 0.f;
      for (int k = part * 256; k < part * 256 + 256; ++k) d += hs[k] * Wr[k * 32 + e];
      d += __shfl_xor(d, 1); d += __shfl_xor(d, 2); d += __shfl_xor(d, 4);
      if (part == 0) lg[e] = d + br[e]; }
    __syncthreads();
    if (tid == 0) {
        int sel[4]; float val[4]; unsigned used = 0u;
#pragma unroll
        for (int k = 0; k < 4; ++k) { int bi = -1; float bv = 0.f;
            for (int e = 0; e < 32; ++e) { if ((used >> e) & 1u) continue; const float x = lg[e]; if (bi < 0 || x > bv) { bi = e; bv = x; } }
            used |= 1u << bi; sel[k] = bi; val[k] = bv; }
        float den = 0.f, ex[4];
#pragma unroll
        for (int k = 0; k < 4; ++k) { ex[k] = expf(val[k] - val[0]); den += ex[k]; }
#pragma unroll
        for (int k = 0; k < 4; ++k) { const unsigned pos = atomicAdd(&counts[sel[k]], 1u); asg_e[m * 4 + k] = sel[k]; asg_pos[m * 4 + k] = (int)pos; asg_w[m * 4 + k] = ex[k] / den; }
    }
}
__global__ void k_route_prefix(const unsigned* counts, int* pstart, int* blk_e, int pad) {
    __shared__ int ps[33];
    if (threadIdx.x == 0) { int a = 0; for (int e = 0; e < 32; ++e) { ps[e] = a; a += ((int)counts[e] + pad - 1) / pad * pad; } ps[32] = a; }
    __syncthreads();
    if (threadIdx.x < 33) pstart[threadIdx.x] = ps[threadIdx.x];
    for (int blk = threadIdx.x; blk < 544; blk += blockDim.x) { int e = -1; for (int q = 0; q < 32; ++q) if (blk * 128 >= ps[q] && blk * 128 < ps[q + 1]) e = q; blk_e[blk] = e; }
}
__global__ void k_route_fill(const int* asg_e, const int* asg_pos, const int* pstart, int* asg_slot, int* slot_tok) {
    const int a = blockIdx.x * blockDim.x + threadIdx.x;
    if (a < NTOK * 4) { const int slot = pstart[asg_e[a]] + asg_pos[a]; asg_slot[a] = slot; if (slot_tok) slot_tok[slot] = a >> 2; }
}
template <class T> __global__ __launch_bounds__(256) void k_final(float* out, const T* YS, const int* asg_slot, const float* asg_w, const float* mod, const float* fg) {
    __shared__ float red[8];
    const int m = blockIdx.x, tid = threadIdx.x, mr = m / S;
    int sl[4]; float w[4];
#pragma unroll
    for (int k = 0; k < 4; ++k) { sl[k] = asg_slot[m * 4 + k]; w[k] = asg_w[m * 4 + k]; }
    float v[8]; float ss = 0.f;
#pragma unroll
    for (int i = 0; i < 8; ++i) { const int n = tid + 256 * i; float y = 0.f;
#pragma unroll
        for (int k = 0; k < 4; ++k) y += w[k] * ldf(YS + (size_t)sl[k] * D + n);
        v[i] = out[(size_t)m * D + n] + mod[mr * MODW + 5 * D + n] * y; ss += v[i] * v[i]; }
    ss = block_sum256(ss, red);
    const float rstd = rsqrtf(ss * (1.0f / D) + 1e-6f);
#pragma unroll
    for (int i = 0; i < 8; ++i) { const int n = tid + 256 * i; out[(size_t)m * D + n] = v[i] * rstd * fg[n]; }
}
}

extern "C" void kernel_launch(void* const* d_in, const int* in_sizes, int n_in, void* d_out, int out_size, void* d_ws, size_t ws_size, hipStream_t stream) {
    using namespace mk;
    (void)in_sizes; (void)n_in; (void)out_size; (void)ws_size;
    static int grid = 0;
    if (grid == 0) {
        int dev = 0, cus = 0, per_cu = 0;
        if (hipGetDevice(&dev) != hipSuccess || hipDeviceGetAttribute(&cus, hipDeviceAttributeMultiprocessorCount, dev) != hipSuccess) { grid = -1; return; }
        if (hipFuncSetAttribute((const void*)mk_fwd, hipFuncAttributeMaxDynamicSharedMemorySize, LDS_BYTES) != hipSuccess) { fprintf(stderr, "kernel_launch: hipFuncSetAttribute failed\n"); grid = -1; return; }
        if (hipOccupancyMaxActiveBlocksPerMultiprocessor(&per_cu, (const void*)mk_fwd, 512, LDS_BYTES) != hipSuccess || per_cu < 1) fprintf(stderr, "kernel_launch: occupancy query reports %d\n", per_cu);
        (void)hipGetLastError();
        grid = cus;
    }
    if (grid < 0) return;
    unsigned char* ws = (unsigned char*)d_ws;
    (void)hipMemsetAsync(ws + WS_CTL, 0, CTL_ZERO_BYTES, stream);
    Args a{};
    for (int i = 0; i < 24; ++i) a.in[i] = (const float*)d_in[i];
    a.out = (float*)d_out; a.ws = ws;
    auto run = [&](int lo, int hi) { a.ph_lo = lo; a.ph_hi = hi; hipLaunchKernelGGL(mk_fwd, dim3(grid), dim3(512), LDS_BYTES, stream, a); };
#if MK_STAGE >= 7
    run(0, NPH);
#else
    using namespace nv;
    const float* x = a.in[0]; float* out = a.out; const float* mod = (const float*)(ws + WS_MOD);
    const bf16_t* YB = (const bf16_t*)(ws + WS_YB);
    float* O = (float*)(ws + 104 * MiB); float* NAO = (float*)(ws + 232 * MiB); float* T1 = (float*)(ws + 360 * MiB); float* H2 = (float*)(ws + 488 * MiB); float* A1 = (float*)(ws + 616 * MiB);
    float* G = (float*)(ws + 940 * MiB); float* ACT = (float*)(ws + 1484 * MiB); float* YS = G;
    int* pstart = (int*)(ws + 8 * MiB); int* blk_e = (int*)(ws + 9 * MiB); int* asg_slot = (int*)(ws + 10 * MiB); int* slot_tok = (int*)(ws + 11 * MiB);
    unsigned* counts = (unsigned*)(ws + WS_CTL) + CW_CNT; int* asg_e = (int*)(ws + WS_ASG_E); int* asg_pos = (int*)(ws + WS_ASG_POS); float* asg_w = (float*)(ws + WS_ASG_W);
    run(0, 1); run(1, 2); run(2, 3);
#if MK_STAGE >= 2
    run(3, 4); run(4, 5);
#else
    hipLaunchKernelGGL(k_ret, dim3(S / 16, RH, NB), dim3(256), 0, stream, YB, a.in[12], a.in[13], O);
    hipLaunchKernelGGL(k_gn_gate, dim3(NTOK), dim3(256), 0, stream, O, YB, A1);
    hipLaunchKernelGGL(k_na, dim3(S, NH, NB), dim3(256), 0, stream, YB, a.in[14], NAO);
#endif
#if MK_STAGE >= 3
    run(5, 6); run(6, 7);
#else
#if MK_STAGE >= 2
    hipLaunchKernelGGL((sgemm128<ARows<bf16_t>, BOne, ERetGate<bf16_t>>), dim3(D / 128, NTOK / 128), dim3(256), 0, stream, D, D, ARows<bf16_t>{(const bf16_t*)(ws + WS_HB), D}, BOne{a.in[9]}, ERetGate<bf16_t>{T1, YB});
    hipLaunchKernelGGL((sgemm128<ARows<bf16_t>, BOne, ENaGate<bf16_t>>), dim3(D / 128, NTOK / 128), dim3(256), 0, stream, D, D, ARows<bf16_t>{(const bf16_t*)(ws + WS_NAOB), D}, BOne{a.in[10]}, ENaGate<bf16_t>{T1, YB});
#else
    hipLaunchKernelGGL((sgemm128<ARows<float>, BOne, ERetGate<bf16_t>>), dim3(D / 128, NTOK / 128), dim3(256), 0, stream, D, D, ARows<float>{A1, D}, BOne{a.in[9]}, ERetGate<bf16_t>{T1, YB});
    hipLaunchKernelGGL((sgemm128<ARows<float>, BOne, ENaGate<bf16_t>>), dim3(D / 128, NTOK / 128), dim3(256), 0, stream, D, D, ARows<float>{NAO, D}, BOne{a.in[10]}, ENaGate<bf16_t>{T1, YB});
#endif
    hipLaunchKernelGGL((sgemm128<ARows<float>, BOne, EResid>), dim3(D / 128, NTOK / 128), dim3(256), 0, stream, D, D, ARows<float>{T1, D}, BOne{a.in[11]}, EResid{out, x, mod});
#endif
#if MK_STAGE >= 4
    run(7, 8);
#else
    hipLaunchKernelGGL(k_route, dim3(NTOK), dim3(256), 0, stream, out, a.in[7], mod, a.in[15], a.in[16], H2, counts, asg_e, asg_pos, asg_w);
#endif
#if MK_STAGE >= 5
    run(8, 9); run(9, 10); run(10, 11);
#else
    (void)hipMemsetAsync(slot_tok, 0xFF, (size_t)NSLOT * 4, stream);
    hipLaunchKernelGGL(k_route_prefix, dim3(1), dim3(64), 0, stream, counts, pstart, blk_e, 128);
    hipLaunchKernelGGL(k_route_fill, dim3(NTOK * 4 / 256), dim3(256), 0, stream, asg_e, asg_pos, pstart, asg_slot, slot_tok);
#if MK_STAGE >= 4
    hipLaunchKernelGGL((sgemm128<AGather<bf16_t>, BExpert, EGate>), dim3(FF / 128, NSLOT / 128), dim3(256), 0, stream, FF, D, AGather<bf16_t>{(const bf16_t*)(ws + WS_HB), D, slot_tok}, BExpert{a.in[17], (size_t)D * FF, blk_e}, EGate{G, a.in[18], blk_e});
    hipLaunchKernelGGL((sgemm128<AGather<bf16_t>, BExpert, EUp>), dim3(FF / 128, NSLOT / 128), dim3(256), 0, stream, FF, D, AGather<bf16_t>{(const bf16_t*)(ws + WS_HB), D, slot_tok}, BExpert{a.in[19], (size_t)D * FF, blk_e}, EUp{ACT, G, a.in[20], blk_e});
#else
    hipLaunchKernelGGL((sgemm128<AGather<float>, BExpert, EGate>), dim3(FF / 128, NSLOT / 128), dim3(256), 0, stream, FF, D, AGather<float>{H2, D, slot_tok}, BExpert{a.in[17], (size_t)D * FF, blk_e}, EGate{G, a.in[18], blk_e});
    hipLaunchKernelGGL((sgemm128<AGather<float>, BExpert, EUp>), dim3(FF / 128, NSLOT / 128), dim3(256), 0, stream, FF, D, AGather<float>{H2, D, slot_tok}, BExpert{a.in[19], (size_t)D * FF, blk_e}, EUp{ACT, G, a.in[20], blk_e});
#endif
    hipLaunchKernelGGL((sgemm128<ARows<float>, BExpert, EDown>), dim3(D / 128, NSLOT / 128), dim3(256), 0, stream, D, FF, ARows<float>{ACT, FF}, BExpert{a.in[21], (size_t)FF * D, blk_e}, EDown{YS, a.in[22], blk_e});
#endif
#if MK_STAGE >= 6
    run(11, 12);
#elif MK_STAGE >= 5
    hipLaunchKernelGGL(k_route_prefix, dim3(1), dim3(64), 0, stream, counts, pstart, blk_e, 256);
    hipLaunchKernelGGL(k_route_fill, dim3(NTOK * 4 / 256), dim3(256), 0, stream, asg_e, asg_pos, pstart, asg_slot, (int*)nullptr);
    hipLaunchKernelGGL(k_final<bf16_t>, dim3(NTOK), dim3(256), 0, stream, out, (const bf16_t*)(ws + WS_XB), asg_slot, asg_w, mod, a.in[23]);
#else
    hipLaunchKernelGGL(k_final<float>, dim3(NTOK), dim3(256), 0, stream, out, YS, asg_slot, asg_w, mod, a.in[23]);
#endif
#endif
}
```

```cpp
#include <hip/hip_runtime.h>
#include <stdint.h>
#include <stdio.h>

#define MK_REPMASK 0x0
#ifndef MK_STAGE
#define MK_STAGE 7
#endif

namespace pg8 {
#define PG8_LAS __attribute__((address_space(3)))
typedef unsigned short bf16_t;
typedef short bf16x8 __attribute__((ext_vector_type(8)));
typedef float f32x4 __attribute__((ext_vector_type(4)));
typedef unsigned u32x4 __attribute__((ext_vector_type(4)));
typedef unsigned u32x2 __attribute__((ext_vector_type(2)));
constexpr int BM = 256, BK = 64, HALF = 128, HTB = HALF * BK * 2, STAGE_BYTES = 8 * HTB, NXCD = 8, WGM = 8;

__host__ __device__ __forceinline__ int lds_byte(int r, int c) { const int st = (r >> 4) * 2 + (c >> 5), rr = r & 15, cc = c & 31, ob = rr * 64 + cc * 2; return st * 1024 + (ob ^ (((ob >> 9) & 1) << 5)); }
__host__ __device__ __forceinline__ void stage_rc(int b, int& R, int& C) { const int st = b / 1024, sb = b % 1024, swz = sb ^ (((sb >> 9) & 1) << 5); R = (st >> 1) * 16 + swz / 64; C = (st & 1) * 32 + (swz % 64) / 2; }
__host__ __device__ __forceinline__ int perm32(int rho) { const int n = rho >> 4, i = rho & 15; return 8 * (i >> 2) + 4 * n + (i & 3); }

struct Unit { int pm, pn, pb, e; };
struct Gemm { const bf16_t* A; const bf16_t* Bt; int K; };

struct StaticOrder {
    int nM, nN, nwg, G, c;
    __device__ void init(int M, int N, int G_, int c_) { nM = M / BM; nN = N / BM; nwg = nM * nN; G = G_; c = c_; }
    __device__ bool next(int i, Unit& u) const {
        const long L = (long)i * G + c; if (L >= nwg) return false;
        int wgid = (int)L; { const int q = nwg / NXCD, r = nwg % NXCD, xcd = wgid % NXCD, off = wgid / NXCD; wgid = (xcd < r ? xcd * (q + 1) : r * (q + 1) + (xcd - r) * q) + off; }
        const int nig = WGM * nN, gid = wgid / nig, fm = gid * WGM, gsz = (nM - fm) < WGM ? (nM - fm) : WGM;
        u.pm = fm + ((wgid % nig) % gsz); u.pn = (wgid % nig) / gsz; u.pb = u.pn; u.e = 0; return true;
    }
};
struct GroupedOrder {
    int NP, G, c, U; const PG8_LAS int* tp;
    __device__ void init(int NP_, int G_, int c_, const PG8_LAS int* tp_) { NP = NP_; G = G_; c = c_; tp = tp_; U = __builtin_amdgcn_readfirstlane(NP_ * tp_[32]); }
    __device__ bool next(int i, Unit& u) const {
        const int L = i * G + c; if (L >= U) return false;
        int w; { const int q = U / NXCD, r = U % NXCD, xcd = L % NXCD, off = L / NXCD; w = (xcd < r ? xcd * (q + 1) : r * (q + 1) + (xcd - r) * q) + off; }
        int e = 0; while (e < 31 && NP * tp[e + 1] <= w) ++e;
        const int local = w - NP * tp[e], nrt = tp[e + 1] - tp[e];
        const int pn = local / nrt, rt = tp[e] + (local - pn * nrt);
        u.pm = __builtin_amdgcn_readfirstlane(rt); u.pn = __builtin_amdgcn_readfirstlane(pn); u.pb = __builtin_amdgcn_readfirstlane(e * NP + pn); u.e = __builtin_amdgcn_readfirstlane(e); return true;
    }
};

__device__ __forceinline__ unsigned cvt_pk_bf16(float lo, float hi) { unsigned r; asm volatile("v_cvt_pk_bf16_f32 %0, %1, %2" : "=v"(r) : "v"(lo), "v"(hi)); return r; }
__device__ __forceinline__ float bf_lo(unsigned w) { return __uint_as_float(w << 16); }
__device__ __forceinline__ float bf_hi(unsigned w) { return __uint_as_float(w & 0xffff0000u); }
__device__ __forceinline__ float sigm(float x) { return __builtin_amdgcn_rcpf(1.0f + __expf(-x)); }

struct EpiBf16B {
    static constexpr bool PERM = true;
    bf16_t* O; int ldc; const float* bias; int bias_stride; float scale;
    __device__ __forceinline__ void operator()(const f32x4 (&acc)[2][2][4][2], const Unit& u, int wr, int wc, int fr, int fq) const {
        const int row0 = u.pm * BM + wr * 64 + fr, col0 = u.pn * BM + wc * 32 + 8 * fq;
        f32x4 bv[2][2];
#pragma unroll
        for (int bj = 0; bj < 2; ++bj)
#pragma unroll
            for (int n = 0; n < 2; ++n) bv[bj][n] = bias ? *(const f32x4*)(bias + (size_t)u.e * bias_stride + col0 + bj * HALF + 4 * n) : (f32x4){0.f, 0.f, 0.f, 0.f};
#pragma unroll
        for (int ai = 0; ai < 2; ++ai)
#pragma unroll
            for (int m = 0; m < 4; ++m) { bf16_t* rowp = O + (size_t)(row0 + ai * HALF + m * 16) * ldc + col0;
#pragma unroll
                for (int bj = 0; bj < 2; ++bj) { const f32x4 v0 = acc[ai][bj][m][0] * scale + bv[bj][0], v1 = acc[ai][bj][m][1] * scale + bv[bj][1];
                    u32x4 w; w.x = cvt_pk_bf16(v0[0], v0[1]); w.y = cvt_pk_bf16(v0[2], v0[3]); w.z = cvt_pk_bf16(v1[0], v1[1]); w.w = cvt_pk_bf16(v1[2], v1[3]);
                    *(u32x4*)(rowp + bj * HALF) = w; } }
    }
};
template <bool ADD> struct EpiGate {
    static constexpr bool PERM = true;
    bf16_t* T; int ldc; const bf16_t* gate; int gld;
    __device__ __forceinline__ void operator()(const f32x4 (&acc)[2][2][4][2], const Unit& u, int wr, int wc, int fr, int fq) const {
        const int row0 = u.pm * BM + wr * 64 + fr, col0 = u.pn * BM + wc * 32 + 8 * fq;
#pragma unroll
        for (int ai = 0; ai < 2; ++ai)
#pragma unroll
            for (int m = 0; m < 4; ++m) { const size_t r = (size_t)(row0 + ai * HALF + m * 16); bf16_t* rowp = T + r * ldc + col0; const bf16_t* gp = gate + r * gld + col0;
#pragma unroll
                for (int bj = 0; bj < 2; ++bj) { const u32x4 g = *(const u32x4*)(gp + bj * HALF); const f32x4 a0 = acc[ai][bj][m][0], a1 = acc[ai][bj][m][1];
                    float o[8];
                    o[0] = sigm(bf_lo(g.x)) * a0[0]; o[1] = sigm(bf_hi(g.x)) * a0[1]; o[2] = sigm(bf_lo(g.y)) * a0[2]; o[3] = sigm(bf_hi(g.y)) * a0[3];
                    o[4] = sigm(bf_lo(g.z)) * a1[0]; o[5] = sigm(bf_hi(g.z)) * a1[1]; o[6] = sigm(bf_lo(g.w)) * a1[2]; o[7] = sigm(bf_hi(g.w)) * a1[3];
                    if (ADD) { const u32x4 t = *(const u32x4*)(rowp + bj * HALF);
                        o[0] += bf_lo(t.x); o[1] += bf_hi(t.x); o[2] += bf_lo(t.y); o[3] += bf_hi(t.y); o[4] += bf_lo(t.z); o[5] += bf_hi(t.z); o[6] += bf_lo(t.w); o[7] += bf_hi(t.w); }
                    u32x4 w; w.x = cvt_pk_bf16(o[0], o[1]); w.y = cvt_pk_bf16(o[2], o[3]); w.z = cvt_pk_bf16(o[4], o[5]); w.w = cvt_pk_bf16(o[6], o[7]);
                    *(u32x4*)(rowp + bj * HALF) = w; } }
    }
};
struct EpiResid {
    static constexpr bool PERM = false;
    const float* x; float* out; int ldc; const float* gvec; int gstride; int rows_per_batch;
    __device__ __forceinline__ void operator()(const f32x4 (&acc)[2][2][4][2], const Unit& u, int wr, int wc, int fr, int fq) const {
        const int row0 = u.pm * BM + wr * 64 + fr, col0 = u.pn * BM + wc * 32 + 4 * fq;
        const float* gp = gvec + (size_t)((u.pm * BM) / rows_per_batch) * gstride + col0;
        f32x4 gv[2][2];
#pragma unroll
        for (int bj = 0; bj < 2; ++bj)
#pragma unroll
            for (int n = 0; n < 2; ++n) gv[bj][n] = *(const f32x4*)(gp + bj * HALF + n * 16);
#pragma unroll
        for (int ai = 0; ai < 2; ++ai)
#pragma unroll
            for (int m = 0; m < 4; ++m) { const size_t off = (size_t)(row0 + ai * HALF + m * 16) * ldc + col0;
#pragma unroll
                for (int bj = 0; bj < 2; ++bj)
#pragma unroll
                    for (int n = 0; n < 2; ++n) { const f32x4 xv = *(const f32x4*)(x + off + bj * HALF + n * 16); *(f32x4*)(out + off + bj * HALF + n * 16) = xv + gv[bj][n] * acc[ai][bj][m][n]; } }
    }
};
struct EpiSwiglu {
    static constexpr bool PERM = true;
    bf16_t* O; int ldc; const float* bgate; const float* bup; int bias_stride;
    __device__ __forceinline__ void operator()(const f32x4 (&acc)[2][2][4][2], const Unit& u, int wr, int wc, int fr, int fq) const {
        const int row0 = u.pm * BM + wr * 64 + fr, col0 = u.pn * HALF + wc * 32 + 8 * fq;
        f32x4 bg[2], bu[2];
#pragma unroll
        for (int n = 0; n < 2; ++n) { bg[n] = *(const f32x4*)(bgate + (size_t)u.e * bias_stride + col0 + 4 * n); bu[n] = *(const f32x4*)(bup + (size_t)u.e * bias_stride + col0 + 4 * n); }
#pragma unroll
        for (int ai = 0; ai < 2; ++ai)
#pragma unroll
            for (int m = 0; m < 4; ++m) { float o[8];
#pragma unroll
                for (int n = 0; n < 2; ++n)
#pragma unroll
                    for (int j = 0; j < 4; ++j) { const float gt = fminf(acc[ai][0][m][n][j] + bg[n][j], 7.0f), up = fminf(fmaxf(acc[ai][1][m][n][j] + bu[n][j], -7.0f), 7.0f);
                        o[4 * n + j] = gt * sigm(1.702f * gt) * (up + 1.0f); }
                u32x4 w; w.x = cvt_pk_bf16(o[0], o[1]); w.y = cvt_pk_bf16(o[2], o[3]); w.z = cvt_pk_bf16(o[4], o[5]); w.w = cvt_pk_bf16(o[6], o[7]);
                *(u32x4*)(O + (size_t)(row0 + ai * HALF + m * 16) * ldc + col0) = w; }
    }
};

__device__ __forceinline__ float clamp448(float v) { return fminf(fmaxf(v, -448.0f), 448.0f); }
struct EpiSwiglu8 {
    static constexpr bool PERM = true;
    unsigned char* O; int ldc; const float* bgate; const float* bup; int bias_stride; float in_scale, out_scale;
    __device__ __forceinline__ void operator()(const f32x4 (&acc)[2][2][4][2], const Unit& u, int wr, int wc, int fr, int fq) const {
        const int row0 = u.pm * BM + wr * 64 + fr, col0 = u.pn * HALF + wc * 32 + 8 * fq;
        f32x4 bg[2], bu[2];
#pragma unroll
        for (int n = 0; n < 2; ++n) { bg[n] = *(const f32x4*)(bgate + (size_t)u.e * bias_stride + col0 + 4 * n); bu[n] = *(const f32x4*)(bup + (size_t)u.e * bias_stride + col0 + 4 * n); }
#pragma unroll
        for (int ai = 0; ai < 2; ++ai)
#pragma unroll
            for (int m = 0; m < 4; ++m) { float o[8];
#pragma unroll
                for (int n = 0; n < 2; ++n)
#pragma unroll
                    for (int j = 0; j < 4; ++j) { const float gt = fminf(acc[ai][0][m][n][j] * in_scale + bg[n][j], 7.0f), up = fminf(fmaxf(acc[ai][1][m][n][j] * in_scale + bu[n][j], -7.0f), 7.0f);
                        o[4 * n + j] = clamp448(gt * sigm(1.702f * gt) * (up + 1.0f) * out_scale); }
                u32x2 w; int p = __builtin_amdgcn_cvt_pk_fp8_f32(o[0], o[1], 0, false); p = __builtin_amdgcn_cvt_pk_fp8_f32(o[2], o[3], p, true); w.x = (unsigned)p;
                p = __builtin_amdgcn_cvt_pk_fp8_f32(o[4], o[5], 0, false); p = __builtin_amdgcn_cvt_pk_fp8_f32(o[6], o[7], p, true); w.y = (unsigned)p;
                *(u32x2*)(O + (size_t)(row0 + ai * HALF + m * 16) * ldc + col0) = w; }
    }
};

typedef int i32x4 __attribute__((ext_vector_type(4)));
typedef int i32x8 __attribute__((ext_vector_type(8)));
__device__ __forceinline__ i32x8 cat32(bf16x8 a, bf16x8 b) { const i32x4 x = __builtin_bit_cast(i32x4, a), y = __builtin_bit_cast(i32x4, b); return __builtin_shufflevector(x, y, 0, 1, 2, 3, 4, 5, 6, 7); }
template <class Epi, class Sched, bool ALIGN_EPI = false, bool SP2 = false, bool FP8 = false>
__device__ __forceinline__ void gemm_phase(PG8_LAS unsigned char* lds, const Gemm g, const Sched& S, const Epi& E) {
    const int tid = threadIdx.x, wid = __builtin_amdgcn_readfirstlane(tid >> 6), lane = tid & 63, wr = wid >> 2, wc = wid & 3, fr = lane & 15, fq = lane >> 4;
    const int RB = FP8 ? g.K : g.K * 2, nt = RB / 128;
    unsigned voffA[2], voffB[2];
#pragma unroll
    for (int i = 0; i < 2; ++i) { int R, C; stage_rc(tid * 16 + i * 8192, R, C); const int Rb = Epi::PERM ? ((R & ~31) + perm32(R & 31)) : R;
        voffA[i] = (unsigned)(R * RB + C * 2); voffB[i] = (unsigned)(Rb * RB + C * 2); }
    const size_t kstep = (size_t)(BK * 2);
    const size_t hstep = (size_t)HALF * RB;
    const size_t tstep = 2 * hstep;
    const unsigned ldsw = (unsigned)wid * 1024u;
    const int aoff = lds_byte(wr * 64 + fr, fq * 8), boff = lds_byte(wc * 32 + fr, fq * 8);
#define PG8_SA(b, h) (((b) * 2 + (h)) * HTB)
#define PG8_SB(b, h) ((4 + (b) * 2 + (h)) * HTB)
#define PG8_STAGE(bufoff, gbase, voff) do { _Pragma("unroll") for (int _i = 0; _i < 2; ++_i) { unsigned _o = (voff)[_i]; asm volatile("" : "+v"(_o));   \
        __builtin_amdgcn_global_load_lds((const unsigned*)((const char*)(gbase) + _o), (PG8_LAS unsigned*)(lds + (bufoff) + ldsw + _i * 8192), 16, 0, 0); } } while (0)
#define PG8_LD32(p) cat32(*(const PG8_LAS bf16x8*)(p), *(const PG8_LAS bf16x8*)((p) + 1024))
#define PG8_LDA(dst, b, h) do { _Pragma("unroll") for (int m = 0; m < 4; ++m) dst[m] = PG8_LD32(lds + PG8_SA(b, h) + aoff + m * 2048); } while (0)
#define PG8_LDB(dst, b, h) do { _Pragma("unroll") for (int n = 0; n < 2; ++n) dst[n] = PG8_LD32(lds + PG8_SB(b, h) + boff + n * 2048); } while (0)
#define PG8_LO(v) __builtin_bit_cast(bf16x8, __builtin_shufflevector(v, v, 0, 1, 2, 3))
#define PG8_HI(v) __builtin_bit_cast(bf16x8, __builtin_shufflevector(v, v, 4, 5, 6, 7))
#define PG8_MMA(ai, bj, At, Bt) do { __builtin_amdgcn_s_setprio(1); _Pragma("unroll") for (int m = 0; m < 4; ++m) _Pragma("unroll") for (int n = 0; n < 2; ++n) { \
        if constexpr (FP8) acc[ai][bj][m][n] = __builtin_amdgcn_mfma_scale_f32_16x16x128_f8f6f4(Bt[n], At[m], acc[ai][bj][m][n], 0, 0, 0, 0, 0, 0); \
        else { acc[ai][bj][m][n] = __builtin_amdgcn_mfma_f32_16x16x32_bf16(PG8_LO(Bt[n]), PG8_LO(At[m]), acc[ai][bj][m][n], 0, 0, 0); \
               acc[ai][bj][m][n] = __builtin_amdgcn_mfma_f32_16x16x32_bf16(PG8_HI(Bt[n]), PG8_HI(At[m]), acc[ai][bj][m][n], 0, 0, 0); } } \
        __builtin_amdgcn_s_setprio(0); } while (0)
#define PG8_WAIT_V(n) asm volatile("s_waitcnt vmcnt(" #n ")" ::: "memory")
#define PG8_WAIT_L(n) asm volatile("s_waitcnt lgkmcnt(" #n ")" ::: "memory")
#define PG8_BAR __builtin_amdgcn_s_barrier()
#define PG8_SCHED __builtin_amdgcn_sched_barrier(0)
    Unit cur, nxt; int ui = 0;
    if (!S.next(0, cur)) return;
    f32x4 acc[2][2][4][2];
#pragma unroll
    for (int a = 0; a < 2; ++a)
#pragma unroll
        for (int b = 0; b < 2; ++b)
#pragma unroll
            for (int m = 0; m < 4; ++m)
#pragma unroll
                for (int n = 0; n < 2; ++n) acc[a][b][m][n] = (f32x4){0.f, 0.f, 0.f, 0.f};
    i32x8 At[4], B0[2], B1[2];
    const char* cA = (const char*)g.A + (size_t)cur.pm * tstep; const char* cB = (const char*)g.Bt + (size_t)cur.pb * tstep;
    if constexpr (SP2) {
        PG8_STAGE(PG8_SB(0, 0), cB, voffB); PG8_STAGE(PG8_SB(0, 1), cB + hstep, voffB); PG8_STAGE(PG8_SA(0, 0), cA, voffA); PG8_STAGE(PG8_SA(0, 1), cA + hstep, voffA);
        if (wr == 1) PG8_BAR;
        PG8_WAIT_V(2); PG8_BAR;
        PG8_STAGE(PG8_SB(1, 0), cB + kstep, voffB); PG8_STAGE(PG8_SA(1, 0), cA + kstep, voffA); PG8_STAGE(PG8_SB(1, 1), cB + hstep + kstep, voffB);
        PG8_WAIT_V(6); PG8_BAR;
    } else {
        PG8_STAGE(PG8_SB(0, 0), cB, voffB); PG8_STAGE(PG8_SA(0, 0), cA, voffA); PG8_STAGE(PG8_SB(0, 1), cB + hstep, voffB); PG8_STAGE(PG8_SA(0, 1), cA + hstep, voffA);
        if (wr == 1) PG8_BAR;
        PG8_WAIT_V(4); PG8_BAR;
        PG8_STAGE(PG8_SB(1, 0), cB + kstep, voffB); PG8_STAGE(PG8_SA(1, 0), cA + kstep, voffA); PG8_STAGE(PG8_SB(1, 1), cB + hstep + kstep, voffB);
        PG8_WAIT_V(6); PG8_BAR;
    }
    for (;;) {
        const bool has_next = S.next(ui + 1, nxt);
        const char* nA = has_next ? (const char*)g.A + (size_t)nxt.pm * tstep : cA; const char* nB = has_next ? (const char*)g.Bt + (size_t)nxt.pb * tstep : cB;
        for (int t = 0; t < nt; t += 2) {
            const bool last = (t == nt - 2);
            const char* a1 = cA + (size_t)(t + 1) * kstep;
            const char* a2 = last ? nA : cA + (size_t)(t + 2) * kstep; const char* b2 = last ? nB : cB + (size_t)(t + 2) * kstep;
            const char* a3 = a2 + kstep; const char* b3 = b2 + kstep;
            if constexpr (SP2) {
            PG8_LDB(B0, 0, 0); PG8_LDB(B1, 0, 1); PG8_SCHED; PG8_LDA(At, 0, 0); PG8_STAGE(PG8_SA(1, 1), a1 + hstep, voffA);
            PG8_WAIT_V(8); PG8_WAIT_L(0); PG8_BAR; PG8_MMA(0, 0, At, B0); PG8_MMA(0, 1, At, B1); PG8_BAR; PG8_SCHED;
            PG8_LDA(At, 0, 1); PG8_STAGE(PG8_SB(0, 0), b2, voffB); PG8_STAGE(PG8_SB(0, 1), b2 + hstep, voffB); PG8_STAGE(PG8_SA(0, 0), a2, voffA);
            PG8_WAIT_V(8); PG8_WAIT_L(0); PG8_BAR; PG8_MMA(1, 0, At, B0); PG8_MMA(1, 1, At, B1); PG8_BAR; PG8_SCHED;
            PG8_LDB(B0, 1, 0); PG8_LDB(B1, 1, 1); PG8_SCHED; PG8_LDA(At, 1, 0); PG8_STAGE(PG8_SA(0, 1), a2 + hstep, voffA);
            PG8_WAIT_V(8); PG8_WAIT_L(0); PG8_BAR; PG8_MMA(0, 0, At, B0); PG8_MMA(0, 1, At, B1); PG8_BAR; PG8_SCHED;
            PG8_LDA(At, 1, 1); PG8_STAGE(PG8_SB(1, 0), b3, voffB); PG8_STAGE(PG8_SB(1, 1), b3 + hstep, voffB); PG8_STAGE(PG8_SA(1, 0), a3, voffA);
            PG8_WAIT_V(8); PG8_WAIT_L(0); PG8_BAR; PG8_MMA(1, 0, At, B0); PG8_MMA(1, 1, At, B1); PG8_BAR; PG8_SCHED;
            } else {
            PG8_LDB(B0, 0, 0); PG8_SCHED; PG8_LDA(At, 0, 0); PG8_STAGE(PG8_SA(1, 1), a1 + hstep, voffA);
            PG8_WAIT_L(8); PG8_BAR; PG8_WAIT_L(0); PG8_MMA(0, 0, At, B0); PG8_BAR; PG8_SCHED;
            PG8_LDB(B1, 0, 1); PG8_STAGE(PG8_SB(0, 0), b2, voffB);
            PG8_BAR; PG8_WAIT_L(0); PG8_MMA(0, 1, At, B1); PG8_BAR;
            PG8_LDA(At, 0, 1); PG8_STAGE(PG8_SA(0, 0), a2, voffA);
            PG8_BAR; PG8_WAIT_L(0); PG8_MMA(1, 0, At, B0); PG8_BAR; PG8_SCHED;
            PG8_STAGE(PG8_SB(0, 1), b2 + hstep, voffB);
            PG8_WAIT_V(6); PG8_BAR; PG8_MMA(1, 1, At, B1); PG8_BAR;
            PG8_LDB(B0, 1, 0); PG8_SCHED; PG8_LDA(At, 1, 0); PG8_STAGE(PG8_SA(0, 1), a2 + hstep, voffA);
            PG8_WAIT_L(8); PG8_BAR; PG8_WAIT_L(0); PG8_MMA(0, 0, At, B0); PG8_BAR; PG8_SCHED;
            PG8_LDB(B1, 1, 1); PG8_STAGE(PG8_SB(1, 0), b3, voffB);
            PG8_BAR; PG8_WAIT_L(0); PG8_MMA(0, 1, At, B1); PG8_BAR;
            PG8_LDA(At, 1, 1); PG8_STAGE(PG8_SA(1, 0), a3, voffA);
            PG8_BAR; PG8_WAIT_L(0); PG8_MMA(1, 0, At, B0); PG8_BAR; PG8_SCHED;
            PG8_STAGE(PG8_SB(1, 1), b3 + hstep, voffB);
            PG8_WAIT_V(6); PG8_BAR; PG8_MMA(1, 1, At, B1); PG8_BAR;
            }
        }
        if constexpr (ALIGN_EPI) { if (wr == 0) PG8_BAR; }
        E(acc, cur, wr, wc, fr, fq);
        if (!has_next) break;
#pragma unroll
        for (int a = 0; a < 2; ++a)
#pragma unroll
            for (int b = 0; b < 2; ++b)
#pragma unroll
                for (int m = 0; m < 4; ++m)
#pragma unroll
                    for (int n = 0; n < 2; ++n) acc[a][b][m][n] = (f32x4){0.f, 0.f, 0.f, 0.f};
        cur = nxt; cA = nA; cB = nB; ++ui;
        if constexpr (ALIGN_EPI) { if (wr == 1) PG8_BAR; }
    }
    PG8_WAIT_V(0);
    if constexpr (!ALIGN_EPI) { if (wr == 0) PG8_BAR; }
    PG8_BAR;
#undef PG8_SA
#undef PG8_SB
#undef PG8_STAGE
#undef PG8_LDA
#undef PG8_LD32
#undef PG8_LO
#undef PG8_HI
#undef PG8_LDB
#undef PG8_MMA
#undef PG8_WAIT_V
#undef PG8_WAIT_L
#undef PG8_BAR
#undef PG8_SCHED
}
}

namespace mk {
using pg8::bf16_t; using pg8::bf16x8; using pg8::f32x4; using pg8::u32x4; using pg8::u32x2; using pg8::cvt_pk_bf16; using pg8::bf_lo; using pg8::bf_hi;
constexpr int D = 2048, NB = 4, S = 4096, L = 256, NTOK = NB * S, NCTX = NB * L, MR = NTOK + NCTX;
constexpr int INW = 16384, MODW = 12288;
constexpr int RH = 8, NH = 16;
constexpr int NE = 32, FF = 2048, NSLOT256 = 288 * 256;
constexpr int C_QR = 0, C_KR = 1024, C_VR = 2048, C_GR = 4096, C_QN = 6144, C_KN = 8192, C_VN = 10240, C_GA = 12288, C_GB = 14336;
constexpr float QK_SCALE = 0.08838834764831845f, LOG2E = 1.4426950408889634f;
constexpr float W8_SCALE = 256.0f, H8_SCALE = 16.0f, A8_SCALE = 4.0f;
constexpr size_t MiB = 1u << 20;
constexpr size_t WS_CTL = 0, CTL_ZERO_BYTES = 1 * MiB;
constexpr size_t WS_MOD = 1 * MiB;
constexpr size_t WS_ASG_E = 2 * MiB, WS_ASG_POS = 3 * MiB, WS_ASG_W = 4 * MiB;
constexpr size_t WS_WIN = 16 * MiB;
constexpr size_t WS_WPA = 80 * MiB, WS_WPB = 88 * MiB, WS_WO = 96 * MiB;
constexpr size_t WS_WGU = 104 * MiB;
constexpr size_t WS_WDN = 616 * MiB;
constexpr size_t WS_HB = 872 * MiB;
constexpr size_t WS_YB = 940 * MiB;
constexpr size_t WS_XB = 940 * MiB, WS_ACTB = 1228 * MiB;
constexpr size_t WS_OF = 1484 * MiB, WS_OB = 1548 * MiB, WS_NAOB = 1612 * MiB, WS_T1 = 1676 * MiB;
constexpr int CW_CNT = 64;
constexpr int CW_BAR = 4096;
constexpr int LDS_BYTES = 155648, MISC_OFF = 153600;

#define GAS __attribute__((address_space(1)))
#define LAS __attribute__((address_space(3)))
typedef GAS unsigned gu32;
#define RLX_AGENT __ATOMIC_RELAXED, __HIP_MEMORY_SCOPE_AGENT

__device__ __forceinline__ unsigned f2bf(float f) { unsigned u = __float_as_uint(f); return (u + 0x7fffu + ((u >> 16) & 1u)) >> 16; }
__device__ __forceinline__ unsigned pk2(float lo, float hi) { return f2bf(lo) | (f2bf(hi) << 16); }
__device__ __forceinline__ float wave_sum(float v) {
#pragma unroll
    for (int o = 1; o < 64; o <<= 1) v += __shfl_xor(v, o);
    return v;
}

#define XB_TMO      128
#define XB_XCNT(j)  (256  + 64 * (j))
#define XB_XSUB(j)  (1280 + 64 * (j))
#define XB_XGEN(j)  (2304 + 64 * (j))
#define XB_TOP      3328
#define XB_TOPGEN   3392
#define XCD_BAR_WORDS 3456
#define XB_SPIN_CAP (1u << 18)
__device__ __forceinline__ unsigned xb_ld(unsigned* p)              { return __hip_atomic_load(p, __ATOMIC_RELAXED, __HIP_MEMORY_SCOPE_AGENT); }
__device__ __forceinline__ unsigned xb_add(unsigned* p, unsigned v) { return __hip_atomic_fetch_add(p, v, __ATOMIC_RELAXED, __HIP_MEMORY_SCOPE_AGENT); }
__device__ __forceinline__ unsigned xb_xcc_id() { return (unsigned)__builtin_amdgcn_s_getreg((3 << 11) | 20) & 0xFu; }
#define XB_SPIN(cond, bar) do { unsigned _sp = 0; while (cond) { __builtin_amdgcn_s_sleep(1); \
    if ((++_sp & 255u) == 0u) { if (xb_ld(&(bar)[XB_TMO])) break; if (_sp > XB_SPIN_CAP) { atomicAdd(&(bar)[XB_TMO], 1u); break; } } } } while (0)
struct XcdBarrier { unsigned* bar; unsigned x; volatile LAS unsigned* st; };
__device__ __forceinline__ XcdBarrier xcd_barrier_post(unsigned* bar, volatile LAS unsigned* st) {
    XcdBarrier b; b.bar = bar; b.x = xb_xcc_id(); b.st = st;
    if (threadIdx.x == 0) (void)xb_add(&bar[XB_XCNT(b.x)], 1u);
    return b;
}
__device__ __forceinline__ void xcd_barrier_complete(unsigned* bar, unsigned x, unsigned& nloc, unsigned& nx) {
    const unsigned G = gridDim.x * gridDim.y * gridDim.z;
    unsigned sum, cnt, mine, sp = 0u;
    for (;;) {
        sum = 0u; cnt = 0u; mine = 0u;
#pragma unroll
        for (unsigned j = 0; j < 16; ++j) { const unsigned c = xb_ld(&bar[XB_XCNT(j)]); sum += c; cnt += (c > 0u) ? 1u : 0u; mine = (j == x) ? c : mine; }
        if (sum == G) break;
        __builtin_amdgcn_s_sleep(1);
        if ((++sp & 255u) == 0u) { if (xb_ld(&bar[XB_TMO])) break; if (sp > XB_SPIN_CAP) { atomicAdd(&bar[XB_TMO], 1u); break; } }
    }
    nloc = mine > 0u ? mine : 1u; nx = cnt > 0u ? cnt : 1u;
}
__device__ __forceinline__ void xcd_barrier(const XcdBarrier& b) {
    asm volatile("s_waitcnt vmcnt(0)" ::: "memory");
    __syncthreads();
    if (threadIdx.x == 0) {
        unsigned* bar = b.bar;
        __builtin_amdgcn_s_waitcnt(0);
        unsigned nloc = b.st[0], nx = b.st[1];
        if (nloc == 0u) { xcd_barrier_complete(bar, b.x, nloc, nx); b.st[0] = nloc; b.st[1] = nx; }
        const unsigned old = xb_add(&bar[XB_XSUB(b.x)], 1u);
        const unsigned gen = old / nloc;
        if (old + 1u == (gen + 1u) * nloc) {
            __builtin_amdgcn_fence(__ATOMIC_RELEASE, "agent");
            asm volatile("s_waitcnt vmcnt(0)" ::: "memory");
            const unsigned og = xb_add(&bar[XB_TOP], 1u);
            const unsigned tg = og / nx;
            if (og + 1u == (tg + 1u) * nx) xb_add(&bar[XB_TOPGEN], 1u);
            else XB_SPIN(xb_ld(&bar[XB_TOPGEN]) == tg, bar);
            __builtin_amdgcn_fence(__ATOMIC_ACQUIRE, "agent");
            xb_add(&bar[XB_XGEN(b.x)], 1u);
            asm volatile("s_waitcnt vmcnt(0)" ::: "memory");
        } else {
            XB_SPIN(xb_ld(&bar[XB_XGEN(b.x)]) == gen, bar);
            __builtin_amdgcn_fence(__ATOMIC_ACQUIRE, "agent");
            asm volatile("s_waitcnt vmcnt(0)" ::: "memory");
        }
    }
    __syncthreads();
}

typedef const float* fptr_t;
struct Frame {
    LAS unsigned char* lds;
    volatile LAS unsigned* MISC;
    unsigned* ctl;
    unsigned char* ws;
    int tid, lane, wave, G, bx;
    const __attribute__((address_space(4))) fptr_t* in;
    float* out;
};
#define LDS_WAIT() asm volatile("s_waitcnt lgkmcnt(0)" ::: "memory")

__device__ __forceinline__ void p0_transpose_item(const float* W, int K, int N, bf16_t* WT, int k0, int n0, size_t drow0, float scale, LAS float* scr, int lane) {
#pragma unroll 8
    for (int i = 0; i < 32; ++i) { const int kk = 2 * i + (lane >> 5); scr[kk * 33 + (lane & 31)] = W[(size_t)(k0 + kk) * N + n0 + (lane & 31)]; }
    LDS_WAIT(); asm volatile("" ::: "memory");
    const int c = lane & 7;
#pragma unroll
    for (int j = 0; j < 4; ++j) { const int n = (lane >> 3) + 8 * j; const LAS float* s = scr + (8 * c) * 33 + n;
        u32x4 o; o.x = pk2(s[0 * 33] * scale, s[1 * 33] * scale); o.y = pk2(s[2 * 33] * scale, s[3 * 33] * scale); o.z = pk2(s[4 * 33] * scale, s[5 * 33] * scale); o.w = pk2(s[6 * 33] * scale, s[7 * 33] * scale);
        *(u32x4*)(WT + (drow0 + n) * (size_t)K + k0 + 8 * c) = o; }
    LDS_WAIT(); asm volatile("" ::: "memory");
}

__device__ __forceinline__ void p0_transpose_item8(const float* W, int K, int N, unsigned char* WT, int k0, int n0, size_t drow0, float scale, LAS float* scr, int lane) {
#pragma unroll 8
    for (int i = 0; i < 64; ++i) { const int kk = 2 * i + (lane >> 5); scr[kk * 33 + (lane & 31)] = W[(size_t)(k0 + kk) * N + n0 + (lane & 31)]; }
    LDS_WAIT(); asm volatile("" ::: "memory");
    const int c = lane & 7;
#pragma unroll
    for (int j = 0; j < 4; ++j) { const int n = (lane >> 3) + 8 * j; const LAS float* s = scr + (16 * c) * 33 + n; unsigned o[4];
#pragma unroll
        for (int q = 0; q < 4; ++q) { int p = __builtin_amdgcn_cvt_pk_fp8_f32(pg8::clamp448(s[(4 * q) * 33] * scale), pg8::clamp448(s[(4 * q + 1) * 33] * scale), 0, false);
            p = __builtin_amdgcn_cvt_pk_fp8_f32(pg8::clamp448(s[(4 * q + 2) * 33] * scale), pg8::clamp448(s[(4 * q + 3) * 33] * scale), p, true); o[q] = (unsigned)p; }
        *(u32x4*)(WT + (drow0 + n) * (size_t)K + k0 + 16 * c) = (u32x4){o[0], o[1], o[2], o[3]}; }
    LDS_WAIT(); asm volatile("" ::: "memory");
}

__device__ __forceinline__ void p0_mod_slab(Frame& F, int slab) {
    LAS float* sv = (LAS float*)F.lds;
    LAS float* red = (LAS float*)(F.lds + 40960);
    const float* c = F.in[1]; const float* cc = F.in[3]; const float* W = F.in[4]; const float* bias = F.in[5];
    for (int i = F.tid; i < 5 * D; i += 512) { const int r = i / D, k = i % D; const float v = r < 4 ? c[r * D + k] : cc[k]; sv[i] = v / (1.0f + __expf(-v)); }
    __syncthreads();
    const int rr = F.tid >> 4, cq = F.tid & 15, col0 = slab * 64 + 4 * cq;
    f32x4 a[5];
#pragma unroll
    for (int r = 0; r < 5; ++r) a[r] = (f32x4){0.f, 0.f, 0.f, 0.f};
#pragma unroll 4
    for (int it = 0; it < 64; ++it) { const int k = rr + 32 * it; const f32x4 w = *(const f32x4*)(W + (size_t)k * MODW + col0);
#pragma unroll
        for (int r = 0; r < 5; ++r) a[r] += w * sv[r * D + k]; }
#pragma unroll
    for (int r = 0; r < 5; ++r) *(LAS f32x4*)(red + (rr * 5 + r) * 64 + 4 * cq) = a[r];
    __syncthreads();
    if (F.tid < 320) { const int r = F.tid >> 6, cl = F.tid & 63; float s = 0.f;
        for (int q = 0; q < 32; ++q) s += red[(q * 5 + r) * 64 + cl];
        ((float*)(F.ws + WS_MOD))[r * MODW + slab * 64 + cl] = s + bias[slab * 64 + cl]; }
    __syncthreads();
}

__device__ __forceinline__ void p0_prologue(Frame& F, bool conv_moe) {
    __syncthreads();
    if (F.bx < 192) p0_mod_slab(F, F.bx);
    LAS float* scr = (LAS float*)(F.lds + F.wave * 16896);
    const int gw = F.bx * 8 + F.wave, NGW = F.G * 8;
    constexpr int I_IN = (D / 64) * (INW / 32), I_SQ = (D / 64) * (D / 32);
    const int NIT = I_IN + 3 * I_SQ + (conv_moe ? 96 * (I_SQ / 2) : 0);
    LAS float* scr8 = (LAS float*)(F.lds + F.wave * 16896);
    for (int it = gw; it < NIT; it += NGW) {
        int r = it;
        if (r < I_IN) { const int kb = r / (INW / 32), nb = r % (INW / 32), n0 = nb * 32; const bool sc = (n0 >= C_KR && n0 < C_VR) || (n0 >= C_QN && n0 < C_KN);
            p0_transpose_item(F.in[8], D, INW, (bf16_t*)(F.ws + WS_WIN), kb * 64, n0, (size_t)n0, sc ? QK_SCALE : 1.0f, scr, F.lane); continue; }
        r -= I_IN;
        if (r < 3 * I_SQ) { const int mtx = r / I_SQ, q = r % I_SQ, kb = q / 64, nb = q % 64;
            p0_transpose_item(mtx == 0 ? F.in[9] : (mtx == 1 ? F.in[10] : F.in[11]), D, D, (bf16_t*)(F.ws + WS_WPA + (size_t)mtx * 8 * MiB), kb * 64, nb * 32, (size_t)nb * 32, 1.0f, scr, F.lane); continue; }
        r -= 3 * I_SQ;
        { constexpr int I_8 = I_SQ / 2;
          const int mtx = r / (32 * I_8), q = r % (32 * I_8), e = q / I_8, q2 = q % I_8, kb = q2 / 64, nb = q2 % 64, n0 = nb * 32;
          if (mtx < 2) { const float* src = (mtx == 0 ? F.in[17] : F.in[19]) + (size_t)e * D * FF;
              const size_t drow = (size_t)e * 4096 + (size_t)(n0 >> 7) * 256 + (size_t)(mtx * 128) + (size_t)(n0 & 127);
              p0_transpose_item8(src, D, FF, F.ws + WS_WGU, kb * 128, n0, drow, W8_SCALE, scr8, F.lane); }
          else { const float* src = F.in[21] + (size_t)e * FF * D;
              p0_transpose_item8(src, FF, D, F.ws + WS_WDN, kb * 128, n0, (size_t)e * 2048 + n0, W8_SCALE, scr8, F.lane); } }
    }
}

__device__ __forceinline__ void p1_rows(Frame& F) {
    const int gw = F.bx * 8 + F.wave, NGW = F.G * 8;
    const float* mod = (const float*)(F.ws + WS_MOD); const float* g = F.in[6];
    bf16_t* HB = (bf16_t*)(F.ws + WS_HB);
    for (int m = gw; m < MR; m += NGW) {
        const float* src = m < NTOK ? F.in[0] + (size_t)m * D : F.in[2] + (size_t)(m - NTOK) * D;
        const float* md = mod + (size_t)(m < NTOK ? m / S : 4) * MODW;
        f32x4 v[8]; float ss = 0.f;
#pragma unroll
        for (int j = 0; j < 8; ++j) { v[j] = *(const f32x4*)(src + 4 * F.lane + 256 * j); ss += (v[j][0] * v[j][0] + v[j][1] * v[j][1]) + (v[j][2] * v[j][2] + v[j][3] * v[j][3]); }
        const float rstd = rsqrtf(wave_sum(ss) * (1.0f / D) + 1e-6f);
#pragma unroll
        for (int j = 0; j < 8; ++j) { const int k = 4 * F.lane + 256 * j; const f32x4 gg = *(const f32x4*)(g + k), sh = *(const f32x4*)(md + k), sc = *(const f32x4*)(md + D + k);
            const f32x4 y = v[j] * rstd * gg * (sc + 1.0f) + sh; u32x2 o; o.x = pk2(y[0], y[1]); o.y = pk2(y[2], y[3]);
            *(u32x2*)(HB + (size_t)m * D + k) = o; }
    }
}

typedef short v4i16_t __attribute__((ext_vector_type(4)));
__device__ __forceinline__ v4i16_t ds_tr(const LAS unsigned char* p) { return __builtin_amdgcn_ds_read_tr16_b64_v4i16((LAS v4i16_t*)p); }
__device__ __forceinline__ bf16x8 cat8(v4i16_t a, v4i16_t b) { bf16x8 r; r[0] = a[0]; r[1] = a[1]; r[2] = a[2]; r[3] = a[3]; r[4] = b[0]; r[5] = b[1]; r[6] = b[2]; r[7] = b[3]; return r; }
#define MFMA16(a, b, c) __builtin_amdgcn_mfma_f32_16x16x32_bf16((a), (b), (c), 0, 0, 0)

constexpr int R_QS = 0, R_KS = 34816, R_KZ = 69632, R_VS = 106496, R_RT = 126976;
constexpr int PQ = 272, PK = 272, PZ = 288, PV = 160, PR = 272;

__device__ __forceinline__ void ret_unit(Frame& F, int b, int h, int dir, int dvs) {
    LAS unsigned char* lds = F.lds;
    __syncthreads();
    const int tid = F.tid, w = F.wave;
    const bf16_t* YB = (const bf16_t*)(F.ws + WS_YB);
    bf16_t* OUT = (bf16_t*)(F.ws + (dir ? WS_OB : WS_OF));
    const float dec = (dir ? F.in[13] : F.in[12])[h];
    const float l2g = -log1pf(expf(-dec)) * LOG2E;
    const float gC = exp2f(128.0f * l2g);
    u32x4 rq[2][2], rk[2][2], rv[2];
    f32x4 Racc[2][2];
#pragma unroll
    for (int a = 0; a < 2; ++a)
#pragma unroll
        for (int c = 0; c < 2; ++c) Racc[a][c] = (f32x4){0.f, 0.f, 0.f, 0.f};
    for (int i = tid; i < 64 * PR / 16; i += 512) *(LAS u32x4*)(lds + R_RT + i * 16) = (u32x4){0u, 0u, 0u, 0u};

    auto base_row = [&](int it) -> int { if (it < 2) { const int ci = dir ? 1 - it : it; return NTOK + b * L + ci * 128; } const int ci = dir ? 31 - (it - 2) : (it - 2); return b * S + ci * 128; };
    auto issue = [&](int it, int tz) {
        const int br = base_row(it); const int aj = tz & 7, colq = (aj >> 2) * 64 + 8 * (aj & 3);
#pragma unroll
        for (int i = 0; i < 2; ++i) { const int p = (tz >> 3) + 64 * i; const size_t row = (size_t)(br + (dir ? 127 - p : p));
            const bf16_t* rp = YB + row * INW;
            if (it >= 2) { rq[i][0] = *(const u32x4*)(rp + C_QR + h * 128 + colq); rq[i][1] = *(const u32x4*)(rp + C_QR + h * 128 + colq + 32); }
            rk[i][0] = *(const u32x4*)(rp + C_KR + h * 128 + colq); rk[i][1] = *(const u32x4*)(rp + C_KR + h * 128 + colq + 32);
            rv[i] = *(const u32x4*)(rp + C_VR + h * 256 + dvs * 64 + 8 * aj); }
    };
    auto commit = [&](int it, int tz, float l2z) {
        const int br = base_row(it); const bool lat = it >= 2; const int aj = tz & 7, axis = aj >> 2, jj = aj & 3, colq = axis * 64 + 8 * jj;
        float invrev[8];
#pragma unroll
        for (int e = 0; e < 8; ++e) invrev[e] = exp2f(-(float)(2 * (8 * jj + e)) * (13.287712379549449f / 64.0f)) * 0.15915494309189535f;
#pragma unroll
        for (int i = 0; i < 2; ++i) { const int p = (tz >> 3) + 64 * i; const int t = (br - b * S) + (dir ? 127 - p : p);
            float cs[8], sn[8];
            if (lat) { const float pos = (float)(axis == 0 ? (t >> 6) : (t & 63));
#pragma unroll
                for (int e = 0; e < 8; ++e) { const float rev = pos * invrev[e]; cs[e] = __builtin_amdgcn_cosf(rev); sn[e] = __builtin_amdgcn_sinf(rev); } }
            else {
#pragma unroll
                for (int e = 0; e < 8; ++e) { cs[e] = 1.0f; sn[e] = 0.0f; } }
            const float zeta = exp2f((float)(127 - p) * l2z);
            const unsigned a1[4] = {rk[i][0].x, rk[i][0].y, rk[i][0].z, rk[i][0].w}, a2[4] = {rk[i][1].x, rk[i][1].y, rk[i][1].z, rk[i][1].w};
            u32x4 k1, k2, z1, z2; unsigned* k1p = (unsigned*)&k1; unsigned* k2p = (unsigned*)&k2; unsigned* z1p = (unsigned*)&z1; unsigned* z2p = (unsigned*)&z2;
#pragma unroll
            for (int q = 0; q < 4; ++q) { const float x1a = bf_lo(a1[q]), x1b = bf_hi(a1[q]), x2a = bf_lo(a2[q]), x2b = bf_hi(a2[q]);
                const float o1a = x1a * cs[2 * q] - x2a * sn[2 * q], o1b = x1b * cs[2 * q + 1] - x2b * sn[2 * q + 1];
                const float o2a = x2a * cs[2 * q] + x1a * sn[2 * q], o2b = x2b * cs[2 * q + 1] + x1b * sn[2 * q + 1];
                k1p[q] = pk2(o1a, o1b); k2p[q] = pk2(o2a, o2b); z1p[q] = pk2(o1a * zeta, o1b * zeta); z2p[q] = pk2(o2a * zeta, o2b * zeta); }
            *(LAS u32x4*)(lds + R_KS + p * PK + colq * 2) = k1; *(LAS u32x4*)(lds + R_KS + p * PK + (colq + 32) * 2) = k2;
            *(LAS u32x4*)(lds + R_KZ + p * PZ + colq * 2) = z1; *(LAS u32x4*)(lds + R_KZ + p * PZ + (colq + 32) * 2) = z2;
            if (lat) { const unsigned b1[4] = {rq[i][0].x, rq[i][0].y, rq[i][0].z, rq[i][0].w}, b2[4] = {rq[i][1].x, rq[i][1].y, rq[i][1].z, rq[i][1].w};
                u32x4 q1, q2; unsigned* q1p = (unsigned*)&q1; unsigned* q2p = (unsigned*)&q2;
#pragma unroll
                for (int q = 0; q < 4; ++q) { const float x1a = bf_lo(b1[q]), x1b = bf_hi(b1[q]), x2a = bf_lo(b2[q]), x2b = bf_hi(b2[q]);
                    q1p[q] = pk2(x1a * cs[2 * q] - x2a * sn[2 * q], x1b * cs[2 * q + 1] - x2b * sn[2 * q + 1]);
                    q2p[q] = pk2(x2a * cs[2 * q] + x1a * sn[2 * q], x2b * cs[2 * q + 1] + x1b * sn[2 * q + 1]); }
                *(LAS u32x4*)(lds + R_QS + p * PQ + colq * 2) = q1; *(LAS u32x4*)(lds + R_QS + p * PQ + (colq + 32) * 2) = q2; }
            *(LAS u32x4*)(lds + R_VS + p * PV + aj * 16) = rv[i]; }
    };

    issue(0, tid);
    commit(0, tid, l2g);
    __syncthreads();
    const int wr4 = w >> 1, wc2 = w & 1;
    const int wr2 = w >> 2, wc4 = w & 3;
    for (int it = 0; it < 34; ++it) {
        const bool lat = it >= 2;
        float l2i = l2g; int tz = tid; asm volatile("" : "+v"(l2i), "+v"(tz));
        const int fr = tz & 15, fq = (tz & 63) >> 4;
        f32x4 Sacc[2][4], Oacc[2][2];
        if (lat) {
#pragma unroll
            for (int a = 0; a < 2; ++a) {
#pragma unroll
                for (int c = 0; c < 4; ++c) Sacc[a][c] = (f32x4){0.f, 0.f, 0.f, 0.f};
#pragma unroll
                for (int c = 0; c < 2; ++c) Oacc[a][c] = (f32x4){0.f, 0.f, 0.f, 0.f}; }
#pragma unroll
            for (int ks = 0; ks < 4; ++ks) {
                bf16x8 qa[2], kb[4], rb[2];
#pragma unroll
                for (int a = 0; a < 2; ++a) qa[a] = *(const LAS bf16x8*)(lds + R_QS + (32 * wr4 + 16 * a + fr) * PQ + (32 * ks + 8 * fq) * 2);
#pragma unroll
                for (int c = 0; c < 4; ++c) kb[c] = *(const LAS bf16x8*)(lds + R_KS + (64 * wc2 + 16 * c + fr) * PK + (32 * ks + 8 * fq) * 2);
#pragma unroll
                for (int c = 0; c < 2; ++c) rb[c] = *(const LAS bf16x8*)(lds + R_RT + (32 * wc2 + 16 * c + fr) * PR + (32 * ks + 8 * fq) * 2);
#pragma unroll
                for (int a = 0; a < 2; ++a) {
#pragma unroll
                    for (int c = 0; c < 4; ++c) Sacc[a][c] = MFMA16(kb[c], qa[a], Sacc[a][c]);
#pragma unroll
                    for (int c = 0; c < 2; ++c) Oacc[a][c] = MFMA16(rb[c], qa[a], Oacc[a][c]); }
            }
        }
        __syncthreads();
        if (lat) {
#pragma unroll
            for (int a = 0; a < 2; ++a)
#pragma unroll
                for (int c = 0; c < 4; ++c) { const int cr = 32 * wr4 + 16 * a + fr, m0 = 64 * wc2 + 16 * c + 4 * fq; float o[4];
#pragma unroll
                    for (int j = 0; j < 4; ++j) { const int dlt = cr - (m0 + j); o[j] = dlt >= 0 ? Sacc[a][c][j] * exp2f((float)dlt * l2i) : 0.0f; }
                    u32x2 wv; wv.x = pk2(o[0], o[1]); wv.y = pk2(o[2], o[3]);
                    *(LAS u32x2*)(lds + R_KS + cr * PK + m0 * 2) = wv; }
        }
        if (it + 1 < 34) issue(it + 1, tz);
        {
#pragma unroll
            for (int a = 0; a < 2; ++a)
#pragma unroll
                for (int c = 0; c < 2; ++c) Racc[a][c] *= gC;
#pragma unroll
            for (int ks = 0; ks < 4; ++ks) {
                bf16x8 va[2], zb[2];
                const int c0 = 32 * ks + 8 * fq + (fr >> 2);
#pragma unroll
                for (int a = 0; a < 2; ++a) va[a] = cat8(ds_tr(lds + R_VS + c0 * PV + (32 * wr2 + 16 * a + 4 * (fr & 3)) * 2), ds_tr(lds + R_VS + (c0 + 4) * PV + (32 * wr2 + 16 * a + 4 * (fr & 3)) * 2));
#pragma unroll
                for (int c = 0; c < 2; ++c) zb[c] = cat8(ds_tr(lds + R_KZ + c0 * PZ + (32 * wc4 + 16 * c + 4 * (fr & 3)) * 2), ds_tr(lds + R_KZ + (c0 + 4) * PZ + (32 * wc4 + 16 * c + 4 * (fr & 3)) * 2));
#pragma unroll
                for (int a = 0; a < 2; ++a)
#pragma unroll
                    for (int c = 0; c < 2; ++c) Racc[a][c] = MFMA16(zb[c], va[a], Racc[a][c]);
            }
        }
        __syncthreads();
        if (lat) {
#pragma unroll
            for (int a = 0; a < 2; ++a) { const float xi = exp2f((float)(32 * wr4 + 16 * a + fr + 1) * l2i);
#pragma unroll
                for (int c = 0; c < 2; ++c) Oacc[a][c] *= xi; }
#pragma unroll
            for (int ks = 0; ks < 4; ++ks) {
                bf16x8 sa[2], vb[2];
                const int c0 = 32 * ks + 8 * fq + (fr >> 2);
#pragma unroll
                for (int a = 0; a < 2; ++a) sa[a] = *(const LAS bf16x8*)(lds + R_KS + (32 * wr4 + 16 * a + fr) * PK + (32 * ks + 8 * fq) * 2);
#pragma unroll
                for (int c = 0; c < 2; ++c) vb[c] = cat8(ds_tr(lds + R_VS + c0 * PV + (32 * wc2 + 16 * c + 4 * (fr & 3)) * 2), ds_tr(lds + R_VS + (c0 + 4) * PV + (32 * wc2 + 16 * c + 4 * (fr & 3)) * 2));
#pragma unroll
                for (int a = 0; a < 2; ++a)
#pragma unroll
                    for (int c = 0; c < 2; ++c) Oacc[a][c] = MFMA16(vb[c], sa[a], Oacc[a][c]);
            }
            const int br = base_row(it);
#pragma unroll
            for (int a = 0; a < 2; ++a) { const int p = 32 * wr4 + 16 * a + fr; const size_t row = (size_t)(br + (dir ? 127 - p : p));
#pragma unroll
                for (int c = 0; c < 2; ++c) { u32x2 wv; wv.x = pk2(Oacc[a][c][0], Oacc[a][c][1]); wv.y = pk2(Oacc[a][c][2], Oacc[a][c][3]);
                    *(u32x2*)(OUT + row * D + h * 256 + dvs * 64 + 32 * wc2 + 16 * c + 4 * fq) = wv; } }
        }
#pragma unroll
        for (int a = 0; a < 2; ++a)
#pragma unroll
            for (int c = 0; c < 2; ++c) { u32x2 wv; wv.x = pk2(Racc[a][c][0], Racc[a][c][1]); wv.y = pk2(Racc[a][c][2], Racc[a][c][3]);
                *(LAS u32x2*)(lds + R_RT + (32 * wr2 + 16 * a + fr) * PR + (32 * wc4 + 16 * c + 4 * fq) * 2) = wv; }
        __syncthreads();
        if (it + 1 < 34) commit(it + 1, tz, l2i);
        __syncthreads();
    }
}

constexpr int N_K = 0, N_V = 18432, N_RPB = 36864, NP_ = 288;
__device__ __forceinline__ void na_unit(Frame& F, int b, int h, int rp) {
    LAS unsigned char* lds = F.lds;
    const int tid = F.tid, lane = F.lane, w = F.wave, fr = lane & 15, fq = lane >> 4;
    const bf16_t* YB = (const bf16_t*)(F.ws + WS_YB);
    bf16_t* NAOB = (bf16_t*)(F.ws + WS_NAOB);
    const int r0 = 2 * rp, qrow = r0 + (w >> 2), j = w & 3;
    const int kstart = j == 0 ? 0 : (j == 1 ? 8 : (j == 2 ? 24 : 32));
    const int rs_w = min(max(qrow - 4, 0), 56);
    const int lo = min(max(r0 - 4, 0), 56), hi = min(max(r0 + 1 - 4, 0), 56) + 7, nloc = hi - lo + 1, ns = nloc + 4;
    const int qc = 16 * j + fr, cs = min(max(qc - 8, 0), 48);
    bf16x8 Qf[4];
    { const bf16_t* qp = YB + (size_t)(b * S + qrow * 64 + 16 * j + fr) * INW + C_QN + h * 128 + 8 * fq;
#pragma unroll
      for (int ks = 0; ks < 4; ++ks) Qf[ks] = *(const bf16x8*)(qp + 32 * ks); }
    f32x4 O[8];
#pragma unroll
    for (int d = 0; d < 8; ++d) O[d] = (f32x4){0.f, 0.f, 0.f, 0.f};
    float m_run = -1e30f, l_part = 0.f;
    u32x4 rk[2], rv[2];
    auto issue = [&](int st) {
#pragma unroll
        for (int i = 0; i < 2; ++i) { const int T = tid + 512 * i, key = T >> 4, ch = T & 15;
            const size_t row = st < nloc ? (size_t)(b * S + (lo + st) * 64 + key) : (size_t)(NTOK + b * L + (st - nloc) * 64 + key);
            rk[i] = *(const u32x4*)(YB + row * INW + C_KN + h * 128 + 8 * ch); rv[i] = *(const u32x4*)(YB + row * INW + C_VN + h * 128 + 8 * ch); }
    };
    auto block32 = [&](int kb0, bool local, int kr) {
        f32x4 Sx[2];
#pragma unroll
        for (int t = 0; t < 2; ++t) { Sx[t] = (f32x4){0.f, 0.f, 0.f, 0.f};
#pragma unroll
            for (int ks = 0; ks < 4; ++ks) { const bf16x8 kf = *(const LAS bf16x8*)(lds + N_K + (kb0 + 16 * t + fr) * NP_ + (32 * ks + 8 * fq) * 2); Sx[t] = MFMA16(kf, Qf[ks], Sx[t]); } }
        float s[8]; float mx = -1e30f;
#pragma unroll
        for (int t = 0; t < 2; ++t)
#pragma unroll
            for (int e = 0; e < 4; ++e) { float v = Sx[t][e] * LOG2E;
                if (local) { const int kc = kb0 + 16 * t + 4 * fq + e; const bool ok = kc >= cs && kc < cs + 16;
                    const int bi = min(max(kc - qc + 15, 0), 30);
                    v = ok ? v + ((const LAS float*)(lds + N_RPB))[(kr - qrow + 7) * 31 + bi] : -1e30f; }
                s[4 * t + e] = v; mx = fmaxf(mx, v); }
        mx = fmaxf(mx, __shfl_xor(mx, 16)); mx = fmaxf(mx, __shfl_xor(mx, 32));
        const float m_new = fmaxf(m_run, mx), alpha = exp2f(m_run - m_new);
        float ps = 0.f; float p[8];
#pragma unroll
        for (int e = 0; e < 8; ++e) { p[e] = exp2f(s[e] - m_new); ps += p[e]; }
        l_part = l_part * alpha + ps; m_run = m_new;
#pragma unroll
        for (int d = 0; d < 8; ++d) O[d] *= alpha;
        u32x4 pw; pw.x = pk2(p[0], p[1]); pw.y = pk2(p[2], p[3]); pw.z = pk2(p[4], p[5]); pw.w = pk2(p[6], p[7]);
        const bf16x8 pf = __builtin_bit_cast(bf16x8, pw);
        const int k0 = kb0 + 4 * fq + (fr >> 2);
#pragma unroll
        for (int d = 0; d < 8; ++d) { const bf16x8 vf = cat8(ds_tr(lds + N_V + k0 * NP_ + (16 * d + 4 * (fr & 3)) * 2), ds_tr(lds + N_V + (k0 + 16) * NP_ + (16 * d + 4 * (fr & 3)) * 2));
            O[d] = MFMA16(vf, pf, O[d]); }
    };
    issue(0);
    for (int st = 0; st < ns; ++st) {
        __syncthreads();
#pragma unroll
        for (int i = 0; i < 2; ++i) { const int T = tid + 512 * i, key = T >> 4, ch = T & 15;
            *(LAS u32x4*)(lds + N_K + key * NP_ + ch * 16) = rk[i]; *(LAS u32x4*)(lds + N_V + key * NP_ + ch * 16) = rv[i]; }
        if (st == 0 && tid < 465) ((LAS float*)(lds + N_RPB))[tid] = F.in[14][h * 465 + tid] * LOG2E;
        __syncthreads();
        if (st + 1 < ns) issue(st + 1);
        if (st < nloc) { const int kr = lo + st; if (kr >= rs_w && kr < rs_w + 8) block32(kstart, true, kr); }
        else { block32(0, false, 0); block32(32, false, 0); }
    }
    float l = l_part; l += __shfl_xor(l, 16); l += __shfl_xor(l, 32);
    const float inv = 1.0f / l;
    bf16_t* op = NAOB + (size_t)(b * S + qrow * 64 + 16 * j + fr) * D + h * 128 + 4 * fq;
#pragma unroll
    for (int d = 0; d < 8; ++d) { u32x2 wv; wv.x = pk2(O[d][0] * inv, O[d][1] * inv); wv.y = pk2(O[d][2] * inv, O[d][3] * inv); *(u32x2*)(op + 16 * d) = wv; }
}

__device__ __forceinline__ void p4_rows(Frame& F) {
    const int gw = F.bx * 8 + F.wave, NGW = F.G * 8;
    const bf16_t* OF = (const bf16_t*)(F.ws + WS_OF); const bf16_t* OB = (const bf16_t*)(F.ws + WS_OB); const bf16_t* YB = (const bf16_t*)(F.ws + WS_YB);
    bf16_t* A1B = (bf16_t*)(F.ws + WS_HB);
    for (int m = gw; m < NTOK; m += NGW) {
#pragma unroll
        for (int hh = 0; hh < RH; ++hh) { const size_t o = (size_t)m * D + hh * 256 + 4 * F.lane;
            const u32x2 a = *(const u32x2*)(OF + o), c = *(const u32x2*)(OB + o), g = *(const u32x2*)(YB + (size_t)m * INW + C_GR + hh * 256 + 4 * F.lane);
            float v[4] = {bf_lo(a.x) + bf_lo(c.x), bf_hi(a.x) + bf_hi(c.x), bf_lo(a.y) + bf_lo(c.y), bf_hi(a.y) + bf_hi(c.y)};
            const float mu = wave_sum((v[0] + v[1]) + (v[2] + v[3])) * (1.0f / 256.0f);
#pragma unroll
            for (int q = 0; q < 4; ++q) v[q] -= mu;
            const float rstd = rsqrtf(wave_sum((v[0] * v[0] + v[1] * v[1]) + (v[2] * v[2] + v[3] * v[3])) * (1.0f / 256.0f) + 1e-5f);
            const float gg[4] = {bf_lo(g.x), bf_hi(g.x), bf_lo(g.y), bf_hi(g.y)};
#pragma unroll
            for (int q = 0; q < 4; ++q) v[q] = v[q] * rstd * gg[q] * pg8::sigm(gg[q]);
            u32x2 wv; wv.x = pk2(v[0], v[1]); wv.y = pk2(v[2], v[3]); *(u32x2*)(A1B + o) = wv; }
    }
}

__device__ __forceinline__ void p7_route(Frame& F) {
    LAS float* gs = (LAS float*)(F.lds);
    LAS float* shv = (LAS float*)(F.lds + 8192);
    LAS float* part = (LAS float*)(F.lds + 16384);
    LAS float* ssq = (LAS float*)(F.lds + 32768);
    LAS float* qc = (LAS float*)(F.lds + 33280);
    LAS float* lgt = (LAS float*)(F.lds + 35328);
    LAS float* rsd = (LAS float*)(F.lds + 37376);
    const int tid = F.tid, lane = F.lane, w = F.wave, ri = lane & 15, kq = lane >> 4;
    const float* X1 = F.out; const float* g2 = F.in[7]; const float* Wr = F.in[15]; const float* br = F.in[16];
    const float* mod = (const float*)(F.ws + WS_MOD);
    unsigned char* H2B = F.ws + WS_HB;
    int* asg_e = (int*)(F.ws + WS_ASG_E); int* asg_pos = (int*)(F.ws + WS_ASG_POS); float* asg_w = (float*)(F.ws + WS_ASG_W);
    unsigned* counts = F.ctl + CW_CNT;
    for (int grp = F.bx; grp < NTOK / 16; grp += F.G) {
        const int row0 = grp * 16, bb = row0 / S; const float* md = mod + (size_t)bb * MODW;
        __syncthreads();
        for (int k = tid; k < D; k += 512) { gs[k] = g2[k] * (1.0f + md[4 * D + k]); shv[k] = md[3 * D + k]; }
        __syncthreads();
        { const int e = tid & 31, pt = tid >> 5; float s = 0.f;
          for (int k = pt * 128; k < pt * 128 + 128; ++k) s += shv[k] * Wr[k * 32 + e];
          qc[pt * 32 + e] = s; }
        f32x4 acc0 = (f32x4){0.f, 0.f, 0.f, 0.f}, acc1 = acc0; float ss = 0.f;
        const float* xr = X1 + (size_t)(row0 + ri) * D + 256 * w + 4 * kq;
#pragma unroll 4
        for (int s = 0; s < 16; ++s) { const int k0 = 256 * w + 16 * s + 4 * kq; const f32x4 xv = *(const f32x4*)(xr + 16 * s);
            ss += (xv[0] * xv[0] + xv[1] * xv[1]) + (xv[2] * xv[2] + xv[3] * xv[3]);
#pragma unroll
            for (int q = 0; q < 4; ++q) { const float a = xv[q] * gs[k0 + q]; const float b0 = Wr[(k0 + q) * 32 + ri], b1 = Wr[(k0 + q) * 32 + 16 + ri];
                acc0 = __builtin_amdgcn_mfma_f32_16x16x4f32(a, b0, acc0, 0, 0, 0); acc1 = __builtin_amdgcn_mfma_f32_16x16x4f32(a, b1, acc1, 0, 0, 0); } }
        ss += __shfl_xor(ss, 16); ss += __shfl_xor(ss, 32);
#pragma unroll
        for (int q = 0; q < 4; ++q) { part[(w * 16 + 4 * kq + q) * 32 + ri] = acc0[q]; part[(w * 16 + 4 * kq + q) * 32 + 16 + ri] = acc1[q]; }
        if (kq == 0) ssq[w * 16 + ri] = ss;
        __syncthreads();
        { const int row = tid >> 5, e = tid & 31; float sq = 0.f, pp = 0.f, qq = 0.f;
#pragma unroll
          for (int q = 0; q < 8; ++q) { sq += ssq[q * 16 + row]; pp += part[(q * 16 + row) * 32 + e]; }
#pragma unroll
          for (int q = 0; q < 16; ++q) qq += qc[q * 32 + e];
          const float rstd = rsqrtf(sq * (1.0f / D) + 1e-6f);
          lgt[row * 32 + e] = rstd * pp + qq + br[e]; if (e == 0) rsd[row] = rstd; }
        __syncthreads();
        if (tid < 16) { const int m = row0 + tid; int sel[4]; float val[4]; unsigned used = 0u;
#pragma unroll
            for (int k = 0; k < 4; ++k) { int bi = -1; float bv = 0.f;
                for (int e = 0; e < 32; ++e) { const float x = lgt[tid * 32 + e]; if (!((used >> e) & 1u) && (bi < 0 || x > bv)) { bi = e; bv = x; } }
                used |= 1u << bi; sel[k] = bi; val[k] = bv; }
            float den = 0.f, ex[4];
#pragma unroll
            for (int k = 0; k < 4; ++k) { ex[k] = __expf(val[k] - val[0]); den += ex[k]; }
#pragma unroll
            for (int k = 0; k < 4; ++k) { const unsigned pos = atomicAdd(&counts[sel[k]], 1u); asg_e[m * 4 + k] = sel[k]; asg_pos[m * 4 + k] = (int)pos; asg_w[m * 4 + k] = ex[k] / den; } }
        for (int i = tid; i < 16 * (D / 8); i += 512) { const int row = i >> 8, k = (i & 255) * 8; const float rstd = rsd[row]; float y[8];
            const f32x4 xa = *(const f32x4*)(X1 + (size_t)(row0 + row) * D + k), xb = *(const f32x4*)(X1 + (size_t)(row0 + row) * D + k + 4);
#pragma unroll
            for (int q = 0; q < 4; ++q) { y[q] = pg8::clamp448((xa[q] * rstd * gs[k + q] + shv[k + q]) * H8_SCALE); y[4 + q] = pg8::clamp448((xb[q] * rstd * gs[k + 4 + q] + shv[k + 4 + q]) * H8_SCALE); }
            u32x2 wv; int p = __builtin_amdgcn_cvt_pk_fp8_f32(y[0], y[1], 0, false); p = __builtin_amdgcn_cvt_pk_fp8_f32(y[2], y[3], p, true); wv.x = (unsigned)p;
            p = __builtin_amdgcn_cvt_pk_fp8_f32(y[4], y[5], 0, false); p = __builtin_amdgcn_cvt_pk_fp8_f32(y[6], y[7], p, true); wv.y = (unsigned)p;
            *(u32x2*)(H2B + (size_t)(row0 + row) * D + k) = wv; }
    }
}

__device__ __forceinline__ void load_tp(Frame& F, LAS int* tp) {
    __syncthreads();
    if (F.tid == 0) { int a = 0; for (int e = 0; e < 32; ++e) { tp[e] = a; a += ((int)__hip_atomic_load(F.ctl + CW_CNT + e, RLX_AGENT) + 255) >> 8; } tp[32] = a; }
    __syncthreads();
}
__device__ __forceinline__ void p8_gather(Frame& F, LAS int* tp) {
    const int gw = F.bx * 8 + F.wave, NGW = F.G * 8;
    const unsigned char* H2B = F.ws + WS_HB; unsigned char* XB = F.ws + WS_XB;
    const int* asg_e = (const int*)(F.ws + WS_ASG_E); const int* asg_pos = (const int*)(F.ws + WS_ASG_POS);
    for (int a = gw; a < NTOK * 4; a += NGW) { const int e = asg_e[a], slot = 256 * tp[e] + asg_pos[a];
        const u32x4* src = (const u32x4*)(H2B + (size_t)(a >> 2) * D) + F.lane; u32x4* dst = (u32x4*)(XB + (size_t)slot * D) + F.lane;
        const u32x4 v0 = src[0], v1 = src[64]; dst[0] = v0; dst[64] = v1; }
}
__device__ __forceinline__ void p11_final(Frame& F, LAS int* tp) {
    const int gw = F.bx * 8 + F.wave, NGW = F.G * 8;
    const bf16_t* YSB = (const bf16_t*)(F.ws + WS_XB);
    const int* asg_e = (const int*)(F.ws + WS_ASG_E); const int* asg_pos = (const int*)(F.ws + WS_ASG_POS); const float* asg_w = (const float*)(F.ws + WS_ASG_W);
    const float* mod = (const float*)(F.ws + WS_MOD); const float* fg = F.in[23];
    for (int m = gw; m < NTOK; m += NGW) {
        const float* g2v = mod + (size_t)(m / S) * MODW + 5 * D;
        size_t so[4]; float wk[4];
#pragma unroll
        for (int k = 0; k < 4; ++k) { so[k] = (size_t)(256 * tp[asg_e[m * 4 + k]] + asg_pos[m * 4 + k]) * D; wk[k] = asg_w[m * 4 + k]; }
        f32x4 v[8]; float ss = 0.f;
#pragma unroll
        for (int j = 0; j < 8; ++j) { const int n = 4 * F.lane + 256 * j; f32x4 y = (f32x4){0.f, 0.f, 0.f, 0.f};
#pragma unroll
            for (int k = 0; k < 4; ++k) { const u32x2 t = *(const u32x2*)(YSB + so[k] + n); y += (f32x4){bf_lo(t.x), bf_hi(t.x), bf_lo(t.y), bf_hi(t.y)} * wk[k]; }
            v[j] = *(const f32x4*)(F.out + (size_t)m * D + n) + *(const f32x4*)(g2v + n) * y;
            ss += (v[j][0] * v[j][0] + v[j][1] * v[j][1]) + (v[j][2] * v[j][2] + v[j][3] * v[j][3]); }
        const float rstd = rsqrtf(wave_sum(ss) * (1.0f / D) + 1e-6f);
#pragma unroll
        for (int j = 0; j < 8; ++j) { const int n = 4 * F.lane + 256 * j; *(f32x4*)(F.out + (size_t)m * D + n) = v[j] * rstd * *(const f32x4*)(fg + n); }
    }
}

struct Args { const float* in[24]; float* out; unsigned char* ws; int ph_lo, ph_hi; };
constexpr int NPH = 12;
__global__ void __launch_bounds__(512, 2) mk_fwd(Args args) {
    extern __shared__ __attribute__((aligned(16))) unsigned char lds[];
    Frame F;
    F.lds = (LAS unsigned char*)lds; F.MISC = (volatile LAS unsigned*)(F.lds + MISC_OFF);
    F.tid = threadIdx.x; F.lane = F.tid & 63; F.wave = __builtin_amdgcn_readfirstlane(F.tid >> 6); F.G = gridDim.x; F.bx = blockIdx.x;
    F.ws = args.ws; F.ctl = (unsigned*)(args.ws + WS_CTL); F.out = args.out;
    F.in = (const __attribute__((address_space(4))) fptr_t*)__builtin_amdgcn_kernarg_segment_ptr();
    for (int u = F.tid; u < (LDS_BYTES - MISC_OFF) / 4; u += 512) ((LAS unsigned*)(F.lds + MISC_OFF))[u] = 0u;
    __syncthreads();
    const int lo = args.ph_lo, hi = args.ph_hi;
    const bool multi = (hi - lo) > 1;
    XcdBarrier bar; bar.bar = F.ctl + CW_BAR; bar.x = 0; bar.st = nullptr;
    if (multi) bar = xcd_barrier_post(F.ctl + CW_BAR, F.MISC + 8);
#ifndef MK_PHMASK
#define MK_PHMASK 0xfff
#endif
#define IN(k) (((MK_PHMASK >> (k)) & 1) && lo <= (k) && (k) < hi)
#define SEAM(k) do { if (IN(k) && IN((k) + 1)) xcd_barrier(bar); } while (0)
    LAS int* tp = (LAS int*)(F.lds + MISC_OFF + 256);
#ifndef MK_REPMASK
#define MK_REPMASK 0x0
#endif
#define REP(k) for (int rep_ = 0; rep_ < (((MK_REPMASK >> (k)) & 1) ? 2 : 1); ++rep_)

    if (IN(0)) REP(0) { p0_prologue(F, MK_STAGE >= 5); } SEAM(0);
    if (IN(1)) REP(1) { p1_rows(F); } SEAM(1);
    if (IN(2)) REP(2) {
        pg8::Gemm g{(const bf16_t*)(F.ws + WS_HB), (const bf16_t*)(F.ws + WS_WIN), D}; pg8::StaticOrder So; So.init(MR, INW, F.G, F.bx);
        pg8::EpiBf16B E{(bf16_t*)(F.ws + WS_YB), INW, nullptr, 0, 1.0f};
        pg8::gemm_phase<pg8::EpiBf16B, pg8::StaticOrder, true, true>(F.lds, g, So, E);
    } SEAM(2);
    if (IN(3)) REP(3) {
        for (int u = F.bx; u < 256; u += F.G) { const int x = u & 7, jj = u >> 3; ret_unit(F, (x + 8 * (jj >> 3)) >> 3, (x + 8 * (jj >> 3)) & 7, (jj & 7) >> 2, jj & 3); }
        for (int i = 0; ; ++i) { const int L_ = i * F.G + F.bx; if (L_ >= 2048) break; const int c = L_ % 256, ii = L_ / 256; const int bh = 8 * ii + (c & 7), rp = c >> 3; na_unit(F, bh >> 4, bh & 15, rp); }
        __syncthreads();
    } SEAM(3);
    if (IN(4)) REP(4) { p4_rows(F); } SEAM(4);
    if (IN(5)) REP(5) {
        pg8::StaticOrder So; So.init(NTOK, D, F.G, F.bx);
        { pg8::Gemm g{(const bf16_t*)(F.ws + WS_HB), (const bf16_t*)(F.ws + WS_WPA), D}; pg8::EpiGate<false> E{(bf16_t*)(F.ws + WS_T1), D, (const bf16_t*)(F.ws + WS_YB) + C_GA, INW};
          pg8::gemm_phase<pg8::EpiGate<false>, pg8::StaticOrder, true, true>(F.lds, g, So, E); }
        { pg8::Gemm g{(const bf16_t*)(F.ws + WS_NAOB), (const bf16_t*)(F.ws + WS_WPB), D}; pg8::EpiGate<true> E{(bf16_t*)(F.ws + WS_T1), D, (const bf16_t*)(F.ws + WS_YB) + C_GB, INW};
          pg8::gemm_phase<pg8::EpiGate<true>, pg8::StaticOrder, true, true>(F.lds, g, So, E); }
    } SEAM(5);
    if (IN(6)) REP(6) {
        pg8::Gemm g{(const bf16_t*)(F.ws + WS_T1), (const bf16_t*)(F.ws + WS_WO), D}; pg8::StaticOrder So; So.init(NTOK, D, F.G, F.bx);
        pg8::EpiResid E{F.in[0], F.out, D, (const float*)(F.ws + WS_MOD) + 2 * D, MODW, S};
        pg8::gemm_phase<pg8::EpiResid, pg8::StaticOrder, true, true>(F.lds, g, So, E);
    } SEAM(6);
    if (IN(7)) REP(7) { p7_route(F); } SEAM(7);
    if (IN(8)) REP(8) { load_tp(F, tp); p8_gather(F, tp); } SEAM(8);
    if (IN(9)) REP(9) {
        load_tp(F, tp);
        pg8::Gemm g{(const bf16_t*)(F.ws + WS_XB), (const bf16_t*)(F.ws + WS_WGU), D}; pg8::GroupedOrder So; So.init(16, F.G, F.bx, tp);
        pg8::EpiSwiglu8 E{F.ws + WS_ACTB, FF, F.in[18], F.in[20], FF, 1.0f / (W8_SCALE * H8_SCALE), A8_SCALE};
        pg8::gemm_phase<pg8::EpiSwiglu8, pg8::GroupedOrder, true, true, true>(F.lds, g, So, E);
    } SEAM(9);
    if (IN(10)) REP(10) {
        load_tp(F, tp);
        pg8::Gemm g{(const bf16_t*)(F.ws + WS_ACTB), (const bf16_t*)(F.ws + WS_WDN), FF}; pg8::GroupedOrder So; So.init(8, F.G, F.bx, tp);
        pg8::EpiBf16B E{(bf16_t*)(F.ws + WS_XB), D, F.in[22], D, 1.0f / (W8_SCALE * A8_SCALE)};
        pg8::gemm_phase<pg8::EpiBf16B, pg8::GroupedOrder, true, true, true>(F.lds, g, So, E);
    } SEAM(10);
    if (IN(11)) REP(11) { load_tp(F, tp); p11_final(F, tp); }
#undef IN
#undef SEAM
}
}

namespace nv {
using namespace mk;
constexpr int NSLOT = 544 * 128;
__device__ __forceinline__ float sigmoidf_(float x) { return 1.0f / (1.0f + expf(-x)); }
__device__ __forceinline__ float siluf_(float x) { return x * sigmoidf_(x); }
__device__ __forceinline__ float ldf(const float* p) { return *p; }
__device__ __forceinline__ float ldf(const bf16_t* p) { return __uint_as_float(((unsigned)*p) << 16); }
__device__ __forceinline__ float block_sum256(float v, float* red) {
#pragma unroll
    for (int o = 32; o >= 1; o >>= 1) v += __shfl_xor(v, o);
    __syncthreads();
    if ((threadIdx.x & 63) == 0) red[threadIdx.x >> 6] = v;
    __syncthreads();
    float r = 0.f;
    for (int i = 0; i < (int)(blockDim.x >> 6); ++i) r += red[i];
    return r;
}
__device__ __forceinline__ float block_max256(float v, float* red) {
#pragma unroll
    for (int o = 32; o >= 1; o >>= 1) v = fmaxf(v, __shfl_xor(v, o));
    __syncthreads();
    if ((threadIdx.x & 63) == 0) red[threadIdx.x >> 6] = v;
    __syncthreads();
    float r = red[0];
    for (int i = 1; i < (int)(blockDim.x >> 6); ++i) r = fmaxf(r, red[i]);
    return r;
}
template <class AF, class BF, class EF>
__global__ __launch_bounds__(256) void sgemm128(int N, int K, AF af, BF bf, EF ef) {
    __shared__ float As[16][132];
    __shared__ float Bs[16][132];
    const int tid = threadIdx.x, bm = blockIdx.y * 128, bn = blockIdx.x * 128;
    const float* Bbase = bf(blockIdx.y);
    if (!Bbase) return;
    const int ar = tid >> 1, ak = (tid & 1) * 8;
    const int bk = tid >> 4, bc = (tid & 15) * 8;
    const int ty = tid >> 4, tx = tid & 15;
    float acc[8][8];
#pragma unroll
    for (int i = 0; i < 8; ++i)
#pragma unroll
        for (int j = 0; j < 8; ++j) acc[i][j] = 0.f;
    for (int k0 = 0; k0 < K; k0 += 16) {
        float a8[8]; af.load8(bm + ar, k0 + ak, a8);
        const float4 b0 = *(const float4*)(Bbase + (size_t)(k0 + bk) * N + bn + bc);
        const float4 b1 = *(const float4*)(Bbase + (size_t)(k0 + bk) * N + bn + bc + 4);
        __syncthreads();
#pragma unroll
        for (int q = 0; q < 8; ++q) As[ak + q][ar] = a8[q];
        *(float4*)&Bs[bk][bc] = b0; *(float4*)&Bs[bk][bc + 4] = b1;
        __syncthreads();
#pragma unroll
        for (int kk = 0; kk < 16; ++kk) {
            float a[8], b[8];
            const float4 x0 = *(const float4*)&As[kk][ty * 8], x1 = *(const float4*)&As[kk][ty * 8 + 4];
            const float4 y0 = *(const float4*)&Bs[kk][tx * 8], y1 = *(const float4*)&Bs[kk][tx * 8 + 4];
            a[0] = x0.x; a[1] = x0.y; a[2] = x0.z; a[3] = x0.w; a[4] = x1.x; a[5] = x1.y; a[6] = x1.z; a[7] = x1.w;
            b[0] = y0.x; b[1] = y0.y; b[2] = y0.z; b[3] = y0.w; b[4] = y1.x; b[5] = y1.y; b[6] = y1.z; b[7] = y1.w;
#pragma unroll
            for (int i = 0; i < 8; ++i)
#pragma unroll
                for (int j = 0; j < 8; ++j) acc[i][j] += a[i] * b[j];
        }
    }
#pragma unroll
    for (int i = 0; i < 8; ++i)
#pragma unroll
        for (int j = 0; j < 8; ++j) ef(bm + ty * 8 + i, bn + tx * 8 + j, acc[i][j]);
}
template <class T> struct ARows { const T* A; long lda; __device__ void load8(int m, int k, float (&o)[8]) const {
#pragma unroll
    for (int q = 0; q < 8; ++q) o[q] = ldf(A + (size_t)m * lda + k + q); } };
template <class T> struct AGather { const T* A; long lda; const int* idx; __device__ void load8(int m, int k, float (&o)[8]) const { const int t = idx[m];
#pragma unroll
    for (int q = 0; q < 8; ++q) o[q] = t >= 0 ? ldf(A + (size_t)t * lda + k + q) : 0.f; } };
struct BOne { const float* Bp; __device__ const float* operator()(int) const { return Bp; } };
struct BExpert { const float* Bp; size_t stride; const int* blk_e; __device__ const float* operator()(int tm) const { int e = blk_e[tm]; return e >= 0 ? Bp + (size_t)e * stride : nullptr; } };
template <class TY> struct ERetGate { float* T; const TY* Y; __device__ void operator()(int m, int n, float v) const { T[(size_t)m * D + n] = sigmoidf_(ldf(Y + (size_t)m * INW + C_GA + n)) * v; } };
template <class TY> struct ENaGate { float* T; const TY* Y; __device__ void operator()(int m, int n, float v) const { T[(size_t)m * D + n] += sigmoidf_(ldf(Y + (size_t)m * INW + C_GB + n)) * v; } };
struct EResid { float* out; const float* x; const float* mod; __device__ void operator()(int m, int n, float v) const { out[(size_t)m * D + n] = x[(size_t)m * D + n] + mod[(m / S) * MODW + 2 * D + n] * v; } };
struct EGate { float* G; const float* bias; const int* blk_e; __device__ void operator()(int m, int n, float v) const { int e = blk_e[m >> 7]; G[(size_t)m * FF + n] = v + bias[e * FF + n]; } };
struct EUp { float* ACT; const float* G; const float* bias; const int* blk_e; __device__ void operator()(int m, int n, float v) const { int e = blk_e[m >> 7];
    float gate = fminf(G[(size_t)m * FF + n], 7.0f), up = fminf(fmaxf(v + bias[e * FF + n], -7.0f), 7.0f);
    ACT[(size_t)m * FF + n] = gate * sigmoidf_(1.702f * gate) * (up + 1.0f); } };
struct EDown { float* YS; const float* bias; const int* blk_e; __device__ void operator()(int m, int n, float v) const { int e = blk_e[m >> 7]; YS[(size_t)m * D + n] = v + bias[e * D + n]; } };

__device__ __forceinline__ float rope_val(const bf16_t* hrow, int t, int d) {
    const int axis = d >> 6, half = (d >> 5) & 1, f = d & 31;
    const float pos = (float)(axis == 0 ? (t >> 6) : (t & 63));
    const float inv = powf(10000.0f, -(float)(2 * f) / 64.0f);
    const float ang = pos * inv, cs = cosf(ang), sn = sinf(ang);
    const float x1 = ldf(hrow + axis * 64 + f), x2 = ldf(hrow + axis * 64 + 32 + f);
    return half == 0 ? x1 * cs - x2 * sn : x2 * cs + x1 * sn;
}
__global__ __launch_bounds__(256) void k_ret(const bf16_t* Y, const float* dec_f, const float* dec_b, float* O) {
    __shared__ float qs[16][128];
    __shared__ float ks[64][129];
    __shared__ float wsm[16][64];
    const int t0 = blockIdx.x * 16, h = blockIdx.y, b = blockIdx.z, tid = threadIdx.x;
    const float lgf = -log1pf(expf(-dec_f[h])), lgb = -log1pf(expf(-dec_b[h]));
    for (int idx = tid; idx < 16 * 128; idx += 256) { int qi = idx >> 7, d = idx & 127; qs[qi][d] = rope_val(Y + (size_t)(b * S + t0 + qi) * INW + C_QR + h * 128, t0 + qi, d); }
    float acc[16];
#pragma unroll
    for (int i = 0; i < 16; ++i) acc[i] = 0.f;
    for (int u0 = 0; u0 < L + S; u0 += 64) {
        __syncthreads();
        for (int idx = tid; idx < 64 * 128; idx += 256) { int kk = idx >> 7, d = idx & 127, u = u0 + kk; float val;
            if (u < L) val = ldf(Y + (size_t)(NTOK + b * L + u) * INW + C_KR + h * 128 + d);
            else val = rope_val(Y + (size_t)(b * S + (u - L)) * INW + C_KR + h * 128, u - L, d);
            ks[kk][d] = val; }
        __syncthreads();
#pragma unroll
        for (int i = 0; i < 4; ++i) { int idx = tid + 256 * i, qi = idx >> 6, kk = idx & 63; float dot = 0.f;
            for (int d = 0; d < 128; ++d) dot += qs[qi][d] * ks[kk][d];
            const int t = t0 + qi, u = u0 + kk; float w;
            if (u < L) w = expf((float)(t + 1 + 255 - u) * lgf) + expf((float)(S - t + u) * lgb);
            else { const int s = u - L; w = (s <= t ? expf((float)(t - s) * lgf) : 0.f) + (s >= t ? expf((float)(s - t) * lgb) : 0.f); }
            wsm[qi][kk] = dot * w; }
        __syncthreads();
        for (int kk = 0; kk < 64; ++kk) { const int u = u0 + kk; const size_t row = u < L ? (size_t)(NTOK + b * L + u) : (size_t)(b * S + (u - L));
            const float v = ldf(Y + row * INW + C_VR + h * 256 + tid);
#pragma unroll
            for (int qi = 0; qi < 16; ++qi) acc[qi] += wsm[qi][kk] * v; }
    }
#pragma unroll
    for (int qi = 0; qi < 16; ++qi) O[(size_t)(b * S + t0 + qi) * D + h * 256 + tid] = acc[qi];
}
__global__ __launch_bounds__(256) void k_gn_gate(const float* O, const bf16_t* Y, float* A1) {
    __shared__ float red[8];
    const int m = blockIdx.x, tid = threadIdx.x;
    for (int h = 0; h < RH; ++h) {
        const float o = O[(size_t)m * D + h * 256 + tid];
        const float mu = block_sum256(o, red) * (1.0f / 256.0f);
        const float dlt = o - mu;
        const float var = block_sum256(dlt * dlt, red) * (1.0f / 256.0f);
        const float g = ldf(Y + (size_t)m * INW + C_GR + h * 256 + tid);
        A1[(size_t)m * D + h * 256 + tid] = siluf_(g) * dlt * rsqrtf(var + 1e-5f);
    }
}
__global__ __launch_bounds__(256) void k_na(const bf16_t* Y, const float* rpb, float* NAO) {
    __shared__ float qs[128];
    __shared__ float sc[384];
    __shared__ float red[8];
    __shared__ float part[128];
    const int t = blockIdx.x, h = blockIdx.y, b = blockIdx.z, tid = threadIdx.x, lane = tid & 63, w = tid >> 6;
    const int r = t >> 6, qc = t & 63;
    const int rs = min(max(r - 4, 0), 56), cs = min(max(qc - 8, 0), 48);
    if (tid < 128) qs[tid] = ldf(Y + (size_t)(b * S + t) * INW + C_QN + h * 128 + tid);
    __syncthreads();
    for (int key = w; key < 384; key += 4) {
        size_t row; float bias = 0.f;
        if (key < 128) { const int kr = key >> 4, kc = key & 15; row = (size_t)(b * S + (rs + kr) * 64 + cs + kc); bias = rpb[(h * 15 + (rs + kr - r + 7)) * 31 + (cs + kc - qc + 15)]; }
        else row = (size_t)(NTOK + b * L + (key - 128));
        const bf16_t* kp = Y + row * INW + C_KN + h * 128;
        float d = qs[lane] * ldf(kp + lane) + qs[lane + 64] * ldf(kp + lane + 64);
#pragma unroll
        for (int o = 32; o >= 1; o >>= 1) d += __shfl_xor(d, o);
        if (lane == 0) sc[key] = d + bias;
    }
    __syncthreads();
    float mx = -1e30f;
    for (int i = tid; i < 384; i += 256) mx = fmaxf(mx, sc[i]);
    mx = block_max256(mx, red);
    float sm = 0.f;
    for (int i = tid; i < 384; i += 256) { float e = expf(sc[i] - mx); sc[i] = e; sm += e; }
    sm = block_sum256(sm, red);
    const int d = tid & 127, half = tid >> 7;
    float acc = 0.f;
    for (int key = half * 192; key < half * 192 + 192; ++key) {
        size_t row;
        if (key < 128) { const int kr = key >> 4, kc = key & 15; row = (size_t)(b * S + (rs + kr) * 64 + cs + kc); }
        else row = (size_t)(NTOK + b * L + (key - 128));
        acc += sc[key] * ldf(Y + row * INW + C_VN + h * 128 + d);
    }
    if (half == 1) part[d] = acc;
    __syncthreads();
    if (half == 0) NAO[(size_t)(b * S + t) * D + h * 128 + d] = (acc + part[d]) / sm;
}
__global__ __launch_bounds__(256) void k_route(const float* X1, const float* g, const float* mod, const float* Wr, const float* br, float* H2,
                                               unsigned* counts, int* asg_e, int* asg_pos, float* asg_w) {
    __shared__ float red[8];
    __shared__ float hs[D];
    __shared__ float lg[32];
    const int m = blockIdx.x, tid = threadIdx.x, mr = m / S;
    float v[8]; float ss = 0.f;
#pragma unroll
    for (int i = 0; i < 8; ++i) { v[i] = X1[(size_t)m * D + tid + 256 * i]; ss += v[i] * v[i]; }
    ss = block_sum256(ss, red);
    const float rstd = rsqrtf(ss * (1.0f / D) + 1e-6f);
#pragma unroll
    for (int i = 0; i < 8; ++i) { int k = tid + 256 * i; float y = v[i] * rstd * g[k]; float hv = y * (1.0f + mod[mr * MODW + 4 * D + k]) + mod[mr * MODW + 3 * D + k]; hs[k] = hv; H2[(size_t)m * D + k] = hv; }
    __syncthreads();
    { const int e = tid >> 3, part = tid & 7; float d = 0.f;
      for (int k = part * 256; k < part * 256 + 256; ++k) d += hs[k] * Wr[k * 32 + e];
      d += __shfl_xor(d, 1); d += __shfl_xor(d, 2); d += __shfl_xor(d, 4);
      if (part == 0) lg[e] = d + br[e]; }
    __syncthreads();
    if (tid == 0) {
        int sel[4]; float val[4]; unsigned used = 0u;
#pragma unroll
        for (int k = 0; k < 4; ++k) { int bi = -1; float bv = 0.f;
            for (int e = 0; e < 32; ++e) { if ((used >> e) & 1u) continue; const float x = lg[e]; if (bi < 0 || x > bv) { bi = e; bv = x; } }
            used |= 1u << bi; sel[k] = bi; val[k] = bv; }
        float den = 0.f, ex[4];
#pragma unroll
        for (int k = 0; k < 4; ++k) { ex[k] = expf(val[k] - val[0]); den += ex[k]; }
#pragma unroll
        for (int k = 0; k < 4; ++k) { const unsigned pos = atomicAdd(&counts[sel[k]], 1u); asg_e[m * 4 + k] = sel[k]; asg_pos[m * 4 + k] = (int)pos; asg_w[m * 4 + k] = ex[k] / den; }
    }
}
__global__ void k_route_prefix(const unsigned* counts, int* pstart, int* blk_e, int pad) {
    __shared__ int ps[33];
    if (threadIdx.x == 0) { int a = 0; for (int e = 0; e < 32; ++e) { ps[e] = a; a += ((int)counts[e] + pad - 1) / pad * pad; } ps[32] = a; }
    __syncthreads();
    if (threadIdx.x < 33) pstart[threadIdx.x] = ps[threadIdx.x];
    for (int blk = threadIdx.x; blk < 544; blk += blockDim.x) { int e = -1; for (int q = 0; q < 32; ++q) if (blk * 128 >= ps[q] && blk * 128 < ps[q + 1]) e = q; blk_e[blk] = e; }
}
__global__ void k_route_fill(const int* asg_e, const int* asg_pos, const int* pstart, int* asg_slot, int* slot_tok) {
    const int a = blockIdx.x * blockDim.x + threadIdx.x;
    if (a < NTOK * 4) { const int slot = pstart[asg_e[a]] + asg_pos[a]; asg_slot[a] = slot; if (slot_tok) slot_tok[slot] = a >> 2; }
}
template <class T> __global__ __launch_bounds__(256) void k_final(float* out, const T* YS, const int* asg_slot, const float* asg_w, const float* mod, const float* fg) {
    __shared__ float red[8];
    const int m = blockIdx.x, tid = threadIdx.x, mr = m / S;
    int sl[4]; float w[4];
#pragma unroll
    for (int k = 0; k < 4; ++k) { sl[k] = asg_slot[m * 4 + k]; w[k] = asg_w[m * 4 + k]; }
    float v[8]; float ss = 0.f;
#pragma unroll
    for (int i = 0; i < 8; ++i) { const int n = tid + 256 * i; float y = 0.f;
#pragma unroll
        for (int k = 0; k < 4; ++k) y += w[k] * ldf(YS + (size_t)sl[k] * D + n);
        v[i] = out[(size_t)m * D + n] + mod[mr * MODW + 5 * D + n] * y; ss += v[i] * v[i]; }
    ss = block_sum256(ss, red);
    const float rstd = rsqrtf(ss * (1.0f / D) + 1e-6f);
#pragma unroll
    for (int i = 0; i < 8; ++i) { const int n = tid + 256 * i; out[(size_t)m * D + n] = v[i] * rstd * fg[n]; }
}
}

extern "C" void kernel_launch(void* const* d_in, const int* in_sizes, int n_in, void* d_out, int out_size, void* d_ws, size_t ws_size, hipStream_t stream) {
    using namespace mk;
    (void)in_sizes; (void)n_in; (void)out_size; (void)ws_size;
    static int grid = 0;
    if (grid == 0) {
        int dev = 0, cus = 0, per_cu = 0;
        if (hipGetDevice(&dev) != hipSuccess || hipDeviceGetAttribute(&cus, hipDeviceAttributeMultiprocessorCount, dev) != hipSuccess) { grid = -1; return; }
        if (hipFuncSetAttribute((const void*)mk_fwd, hipFuncAttributeMaxDynamicSharedMemorySize, LDS_BYTES) != hipSuccess) { fprintf(stderr, "kernel_launch: hipFuncSetAttribute failed\n"); grid = -1; return; }
        if (hipOccupancyMaxActiveBlocksPerMultiprocessor(&per_cu, (const void*)mk_fwd, 512, LDS_BYTES) != hipSuccess || per_cu < 1) fprintf(stderr, "kernel_launch: occupancy query reports %d\n", per_cu);
        (void)hipGetLastError();
        grid = cus;
    }
    if (grid < 0) return;
    unsigned char* ws = (unsigned char*)d_ws;
    (void)hipMemsetAsync(ws + WS_CTL, 0, CTL_ZERO_BYTES, stream);
    Args a{};
    for (int i = 0; i < 24; ++i) a.in[i] = (const float*)d_in[i];
    a.out = (float*)d_out; a.ws = ws;
    auto run = [&](int lo, int hi) { a.ph_lo = lo; a.ph_hi = hi; hipLaunchKernelGGL(mk_fwd, dim3(grid), dim3(512), LDS_BYTES, stream, a); };
#if MK_STAGE >= 7
    run(0, NPH);
#else
    using namespace nv;
    const float* x = a.in[0]; float* out = a.out; const float* mod = (const float*)(ws + WS_MOD);
    const bf16_t* YB = (const bf16_t*)(ws + WS_YB);
    float* O = (float*)(ws + 104 * MiB); float* NAO = (float*)(ws + 232 * MiB); float* T1 = (float*)(ws + 360 * MiB); float* H2 = (float*)(ws + 488 * MiB); float* A1 = (float*)(ws + 616 * MiB);
    float* G = (float*)(ws + 940 * MiB); float* ACT = (float*)(ws + 1484 * MiB); float* YS = G;
    int* pstart = (int*)(ws + 8 * MiB); int* blk_e = (int*)(ws + 9 * MiB); int* asg_slot = (int*)(ws + 10 * MiB); int* slot_tok = (int*)(ws + 11 * MiB);
    unsigned* counts = (unsigned*)(ws + WS_CTL) + CW_CNT; int* asg_e = (int*)(ws + WS_ASG_E); int* asg_pos = (int*)(ws + WS_ASG_POS); float* asg_w = (float*)(ws + WS_ASG_W);
    run(0, 1); run(1, 2); run(2, 3);
#if MK_STAGE >= 2
    run(3, 4); run(4, 5);
#else
    hipLaunchKernelGGL(k_ret, dim3(S / 16, RH, NB), dim3(256), 0, stream, YB, a.in[12], a.in[13], O);
    hipLaunchKernelGGL(k_gn_gate, dim3(NTOK), dim3(256), 0, stream, O, YB, A1);
    hipLaunchKernelGGL(k_na, dim3(S, NH, NB), dim3(256), 0, stream, YB, a.in[14], NAO);
#endif
#if MK_STAGE >= 3
    run(5, 6); run(6, 7);
#else
#if MK_STAGE >= 2
    hipLaunchKernelGGL((sgemm128<ARows<bf16_t>, BOne, ERetGate<bf16_t>>), dim3(D / 128, NTOK / 128), dim3(256), 0, stream, D, D, ARows<bf16_t>{(const bf16_t*)(ws + WS_HB), D}, BOne{a.in[9]}, ERetGate<bf16_t>{T1, YB});
    hipLaunchKernelGGL((sgemm128<ARows<bf16_t>, BOne, ENaGate<bf16_t>>), dim3(D / 128, NTOK / 128), dim3(256), 0, stream, D, D, ARows<bf16_t>{(const bf16_t*)(ws + WS_NAOB), D}, BOne{a.in[10]}, ENaGate<bf16_t>{T1, YB});
#else
    hipLaunchKernelGGL((sgemm128<ARows<float>, BOne, ERetGate<bf16_t>>), dim3(D / 128, NTOK / 128), dim3(256), 0, stream, D, D, ARows<float>{A1, D}, BOne{a.in[9]}, ERetGate<bf16_t>{T1, YB});
    hipLaunchKernelGGL((sgemm128<ARows<float>, BOne, ENaGate<bf16_t>>), dim3(D / 128, NTOK / 128), dim3(256), 0, stream, D, D, ARows<float>{NAO, D}, BOne{a.in[10]}, ENaGate<bf16_t>{T1, YB});
#endif
    hipLaunchKernelGGL((sgemm128<ARows<float>, BOne, EResid>), dim3(D / 128, NTOK / 128), dim3(256), 0, stream, D, D, ARows<float>{T1, D}, BOne{a.in[11]}, EResid{out, x, mod});
#endif
#if MK_STAGE >= 4
    run(7, 8);
#else
    hipLaunchKernelGGL(k_route, dim3(NTOK), dim3(256), 0, stream, out, a.in[7], mod, a.in[15], a.in[16], H2, counts, asg_e, asg_pos, asg_w);
#endif
#if MK_STAGE >= 5
    run(8, 9); run(9, 10); run(10, 11);
#else
    (void)hipMemsetAsync(slot_tok, 0xFF, (size_t)NSLOT * 4, stream);
    hipLaunchKernelGGL(k_route_prefix, dim3(1), dim3(64), 0, stream, counts, pstart, blk_e, 128);
    hipLaunchKernelGGL(k_route_fill, dim3(NTOK * 4 / 256), dim3(256), 0, stream, asg_e, asg_pos, pstart, asg_slot, slot_tok);
#if MK_STAGE >= 4
    hipLaunchKernelGGL((sgemm128<AGather<bf16_t>, BExpert, EGate>), dim3(FF / 128, NSLOT / 128), dim3(256), 0, stream, FF, D, AGather<bf16_t>{(const bf16_t*)(ws + WS_HB), D, slot_tok}, BExpert{a.in[17], (size_t)D * FF, blk_e}, EGate{G, a.in[18], blk_e});
    hipLaunchKernelGGL((sgemm128<AGather<bf16_t>, BExpert, EUp>), dim3(FF / 128, NSLOT / 128), dim3(256), 0, stream, FF, D, AGather<bf16_t>{(const bf16_t*)(ws + WS_HB), D, slot_tok}, BExpert{a.in[19], (size_t)D * FF, blk_e}, EUp{ACT, G, a.in[20], blk_e});
#else
    hipLaunchKernelGGL((sgemm128<AGather<float>, BExpert, EGate>), dim3(FF / 128, NSLOT / 128), dim3(256), 0, stream, FF, D, AGather<float>{H2, D, slot_tok}, BExpert{a.in[17], (size_t)D * FF, blk_e}, EGate{G, a.in[18], blk_e});
    hipLaunchKernelGGL((sgemm128<AGather<float>, BExpert, EUp>), dim3(FF / 128, NSLOT / 128), dim3(256), 0, stream, FF, D, AGather<float>{H2, D, slot_tok}, BExpert{a.in[19], (size_t)D * FF, blk_e}, EUp{ACT, G, a.in[20], blk_e});
#endif
    hipLaunchKernelGGL((sgemm128<ARows<float>, BExpert, EDown>), dim3(D / 128, NSLOT / 128), dim3(256), 0, stream, D, FF, ARows<float>{ACT, FF}, BExpert{a.in[21], (size_t)FF * D, blk_e}, EDown{YS, a.in[22], blk_e});
#endif
#if MK_STAGE >= 6
    run(11, 12);
#elif MK_STAGE >= 5
    hipLaunchKernelGGL(k_route_prefix, dim3(1), dim3(64), 0, stream, counts, pstart, blk_e, 256);
    hipLaunchKernelGGL(k_route_fill, dim3(NTOK * 4 / 256), dim3(256), 0, stream, asg_e, asg_pos, pstart, asg_slot, (int*)nullptr);
    hipLaunchKernelGGL(k_final<bf16_t>, dim3(NTOK), dim3(256), 0, stream, out, (const bf16_t*)(ws + WS_XB), asg_slot, asg_w, mod, a.in[23]);
#else
    hipLaunchKernelGGL(k_final<float>, dim3(NTOK), dim3(256), 0, stream, out, YS, asg_slot, asg_w, mod, a.in[23]);
#endif
#endif
}
```

```cpp
#include <hip/hip_runtime.h>
#include <stdint.h>
#include <stdio.h>

#define MK_REPMASK 0x0
#ifndef MK_FP8_INPROJ
#define MK_FP8_INPROJ 1
#endif
#ifndef MK_STAGE
#define MK_STAGE 7
#endif

namespace pg8 {
#define PG8_LAS __attribute__((address_space(3)))
typedef unsigned short bf16_t;
typedef short bf16x8 __attribute__((ext_vector_type(8)));
typedef float f32x4 __attribute__((ext_vector_type(4)));
typedef unsigned u32x4 __attribute__((ext_vector_type(4)));
typedef unsigned u32x2 __attribute__((ext_vector_type(2)));
constexpr int BM = 256, BK = 64, HALF = 128, HTB = HALF * BK * 2, STAGE_BYTES = 8 * HTB, NXCD = 8, WGM = 8;

__host__ __device__ __forceinline__ int lds_byte(int r, int c) { const int st = (r >> 4) * 2 + (c >> 5), rr = r & 15, cc = c & 31, ob = rr * 64 + cc * 2; return st * 1024 + (ob ^ (((ob >> 9) & 1) << 5)); }
__host__ __device__ __forceinline__ void stage_rc(int b, int& R, int& C) { const int st = b / 1024, sb = b % 1024, swz = sb ^ (((sb >> 9) & 1) << 5); R = (st >> 1) * 16 + swz / 64; C = (st & 1) * 32 + (swz % 64) / 2; }
__host__ __device__ __forceinline__ int perm32(int rho) { const int n = rho >> 4, i = rho & 15; return 8 * (i >> 2) + 4 * n + (i & 3); }

struct Unit { int pm, pn, pb, e; };
struct Gemm { const bf16_t* A; const bf16_t* Bt; int K; };

struct StaticOrder {
    int nM, nN, nwg, G, c;
    __device__ void init(int M, int N, int G_, int c_) { nM = M / BM; nN = N / BM; nwg = nM * nN; G = G_; c = c_; }
    __device__ bool next(int i, Unit& u) const {
        const long L = (long)i * G + c; if (L >= nwg) return false;
        int wgid = (int)L; { const int q = nwg / NXCD, r = nwg % NXCD, xcd = wgid % NXCD, off = wgid / NXCD; wgid = (xcd < r ? xcd * (q + 1) : r * (q + 1) + (xcd - r) * q) + off; }
        const int nig = WGM * nN, gid = wgid / nig, fm = gid * WGM, gsz = (nM - fm) < WGM ? (nM - fm) : WGM;
        u.pm = fm + ((wgid % nig) % gsz); u.pn = (wgid % nig) / gsz; u.pb = u.pn; u.e = 0; return true;
    }
};
struct GroupedOrder {
    int NP, G, c, U; const PG8_LAS int* tp;
    __device__ void init(int NP_, int G_, int c_, const PG8_LAS int* tp_) { NP = NP_; G = G_; c = c_; tp = tp_; U = __builtin_amdgcn_readfirstlane(NP_ * tp_[32]); }
    __device__ bool next(int i, Unit& u) const {
        const int L = i * G + c; if (L >= U) return false;
        int w; { const int q = U / NXCD, r = U % NXCD, xcd = L % NXCD, off = L / NXCD; w = (xcd < r ? xcd * (q + 1) : r * (q + 1) + (xcd - r) * q) + off; }
        int e = 0; while (e < 31 && NP * tp[e + 1] <= w) ++e;
        const int local = w - NP * tp[e], nrt = tp[e + 1] - tp[e];
        const int pn = local / nrt, rt = tp[e] + (local - pn * nrt);
        u.pm = __builtin_amdgcn_readfirstlane(rt); u.pn = __builtin_amdgcn_readfirstlane(pn); u.pb = __builtin_amdgcn_readfirstlane(e * NP + pn); u.e = __builtin_amdgcn_readfirstlane(e); return true;
    }
};

__device__ __forceinline__ unsigned cvt_pk_bf16(float lo, float hi) { unsigned r; asm volatile("v_cvt_pk_bf16_f32 %0, %1, %2" : "=v"(r) : "v"(lo), "v"(hi)); return r; }
__device__ __forceinline__ float bf_lo(unsigned w) { return __uint_as_float(w << 16); }
__device__ __forceinline__ float bf_hi(unsigned w) { return __uint_as_float(w & 0xffff0000u); }
__device__ __forceinline__ float sigm(float x) { return __builtin_amdgcn_rcpf(1.0f + __expf(-x)); }

struct EpiBf16B {
    static constexpr bool PERM = true;
    bf16_t* O; int ldc; const float* bias; int bias_stride; float scale;
    __device__ __forceinline__ void operator()(const f32x4 (&acc)[2][2][4][2], const Unit& u, int wr, int wc, int fr, int fq) const {
        const int row0 = u.pm * BM + wr * 64 + fr, col0 = u.pn * BM + wc * 32 + 8 * fq;
        f32x4 bv[2][2];
#pragma unroll
        for (int bj = 0; bj < 2; ++bj)
#pragma unroll
            for (int n = 0; n < 2; ++n) bv[bj][n] = bias ? *(const f32x4*)(bias + (size_t)u.e * bias_stride + col0 + bj * HALF + 4 * n) : (f32x4){0.f, 0.f, 0.f, 0.f};
#pragma unroll
        for (int ai = 0; ai < 2; ++ai)
#pragma unroll
            for (int m = 0; m < 4; ++m) { bf16_t* rowp = O + (size_t)(row0 + ai * HALF + m * 16) * ldc + col0;
#pragma unroll
                for (int bj = 0; bj < 2; ++bj) { const f32x4 v0 = acc[ai][bj][m][0] * scale + bv[bj][0], v1 = acc[ai][bj][m][1] * scale + bv[bj][1];
                    u32x4 w; w.x = cvt_pk_bf16(v0[0], v0[1]); w.y = cvt_pk_bf16(v0[2], v0[3]); w.z = cvt_pk_bf16(v1[0], v1[1]); w.w = cvt_pk_bf16(v1[2], v1[3]);
                    *(u32x4*)(rowp + bj * HALF) = w; } }
    }
};
template <bool ADD> struct EpiGate {
    static constexpr bool PERM = true;
    bf16_t* T; int ldc; const bf16_t* gate; int gld;
    __device__ __forceinline__ void operator()(const f32x4 (&acc)[2][2][4][2], const Unit& u, int wr, int wc, int fr, int fq) const {
        const int row0 = u.pm * BM + wr * 64 + fr, col0 = u.pn * BM + wc * 32 + 8 * fq;
#pragma unroll
        for (int ai = 0; ai < 2; ++ai)
#pragma unroll
            for (int m = 0; m < 4; ++m) { const size_t r = (size_t)(row0 + ai * HALF + m * 16); bf16_t* rowp = T + r * ldc + col0; const bf16_t* gp = gate + r * gld + col0;
#pragma unroll
                for (int bj = 0; bj < 2; ++bj) { const u32x4 g = *(const u32x4*)(gp + bj * HALF); const f32x4 a0 = acc[ai][bj][m][0], a1 = acc[ai][bj][m][1];
                    float o[8];
                    o[0] = sigm(bf_lo(g.x)) * a0[0]; o[1] = sigm(bf_hi(g.x)) * a0[1]; o[2] = sigm(bf_lo(g.y)) * a0[2]; o[3] = sigm(bf_hi(g.y)) * a0[3];
                    o[4] = sigm(bf_lo(g.z)) * a1[0]; o[5] = sigm(bf_hi(g.z)) * a1[1]; o[6] = sigm(bf_lo(g.w)) * a1[2]; o[7] = sigm(bf_hi(g.w)) * a1[3];
                    if (ADD) { const u32x4 t = *(const u32x4*)(rowp + bj * HALF);
                        o[0] += bf_lo(t.x); o[1] += bf_hi(t.x); o[2] += bf_lo(t.y); o[3] += bf_hi(t.y); o[4] += bf_lo(t.z); o[5] += bf_hi(t.z); o[6] += bf_lo(t.w); o[7] += bf_hi(t.w); }
                    u32x4 w; w.x = cvt_pk_bf16(o[0], o[1]); w.y = cvt_pk_bf16(o[2], o[3]); w.z = cvt_pk_bf16(o[4], o[5]); w.w = cvt_pk_bf16(o[6], o[7]);
                    *(u32x4*)(rowp + bj * HALF) = w; } }
    }
};
struct EpiResid {
    static constexpr bool PERM = false;
    const float* x; float* out; int ldc; const float* gvec; int gstride; int rows_per_batch;
    __device__ __forceinline__ void operator()(const f32x4 (&acc)[2][2][4][2], const Unit& u, int wr, int wc, int fr, int fq) const {
        const int row0 = u.pm * BM + wr * 64 + fr, col0 = u.pn * BM + wc * 32 + 4 * fq;
        const float* gp = gvec + (size_t)((u.pm * BM) / rows_per_batch) * gstride + col0;
        f32x4 gv[2][2];
#pragma unroll
        for (int bj = 0; bj < 2; ++bj)
#pragma unroll
            for (int n = 0; n < 2; ++n) gv[bj][n] = *(const f32x4*)(gp + bj * HALF + n * 16);
#pragma unroll
        for (int ai = 0; ai < 2; ++ai)
#pragma unroll
            for (int m = 0; m < 4; ++m) { const size_t off = (size_t)(row0 + ai * HALF + m * 16) * ldc + col0;
#pragma unroll
                for (int bj = 0; bj < 2; ++bj)
#pragma unroll
                    for (int n = 0; n < 2; ++n) { const f32x4 xv = *(const f32x4*)(x + off + bj * HALF + n * 16); *(f32x4*)(out + off + bj * HALF + n * 16) = xv + gv[bj][n] * acc[ai][bj][m][n]; } }
    }
};
struct EpiSwiglu {
    static constexpr bool PERM = true;
    bf16_t* O; int ldc; const float* bgate; const float* bup; int bias_stride;
    __device__ __forceinline__ void operator()(const f32x4 (&acc)[2][2][4][2], const Unit& u, int wr, int wc, int fr, int fq) const {
        const int row0 = u.pm * BM + wr * 64 + fr, col0 = u.pn * HALF + wc * 32 + 8 * fq;
        f32x4 bg[2], bu[2];
#pragma unroll
        for (int n = 0; n < 2; ++n) { bg[n] = *(const f32x4*)(bgate + (size_t)u.e * bias_stride + col0 + 4 * n); bu[n] = *(const f32x4*)(bup + (size_t)u.e * bias_stride + col0 + 4 * n); }
#pragma unroll
        for (int ai = 0; ai < 2; ++ai)
#pragma unroll
            for (int m = 0; m < 4; ++m) { float o[8];
#pragma unroll
                for (int n = 0; n < 2; ++n)
#pragma unroll
                    for (int j = 0; j < 4; ++j) { const float gt = fminf(acc[ai][0][m][n][j] + bg[n][j], 7.0f), up = fminf(fmaxf(acc[ai][1][m][n][j] + bu[n][j], -7.0f), 7.0f);
                        o[4 * n + j] = gt * sigm(1.702f * gt) * (up + 1.0f); }
                u32x4 w; w.x = cvt_pk_bf16(o[0], o[1]); w.y = cvt_pk_bf16(o[2], o[3]); w.z = cvt_pk_bf16(o[4], o[5]); w.w = cvt_pk_bf16(o[6], o[7]);
                *(u32x4*)(O + (size_t)(row0 + ai * HALF + m * 16) * ldc + col0) = w; }
    }
};

__device__ __forceinline__ float clamp448(float v) { return fminf(fmaxf(v, -448.0f), 448.0f); }
struct EpiSwiglu8 {
    static constexpr bool PERM = true;
    unsigned char* O; int ldc; const float* bgate; const float* bup; int bias_stride; float in_scale, out_scale;
    __device__ __forceinline__ void operator()(const f32x4 (&acc)[2][2][4][2], const Unit& u, int wr, int wc, int fr, int fq) const {
        const int row0 = u.pm * BM + wr * 64 + fr, col0 = u.pn * HALF + wc * 32 + 8 * fq;
        f32x4 bg[2], bu[2];
#pragma unroll
        for (int n = 0; n < 2; ++n) { bg[n] = *(const f32x4*)(bgate + (size_t)u.e * bias_stride + col0 + 4 * n); bu[n] = *(const f32x4*)(bup + (size_t)u.e * bias_stride + col0 + 4 * n); }
#pragma unroll
        for (int ai = 0; ai < 2; ++ai)
#pragma unroll
            for (int m = 0; m < 4; ++m) { float o[8];
#pragma unroll
                for (int n = 0; n < 2; ++n)
#pragma unroll
                    for (int j = 0; j < 4; ++j) { const float gt = fminf(acc[ai][0][m][n][j] * in_scale + bg[n][j], 7.0f), up = fminf(fmaxf(acc[ai][1][m][n][j] * in_scale + bu[n][j], -7.0f), 7.0f);
                        o[4 * n + j] = clamp448(gt * sigm(1.702f * gt) * (up + 1.0f) * out_scale); }
                u32x2 w; int p = __builtin_amdgcn_cvt_pk_fp8_f32(o[0], o[1], 0, false); p = __builtin_amdgcn_cvt_pk_fp8_f32(o[2], o[3], p, true); w.x = (unsigned)p;
                p = __builtin_amdgcn_cvt_pk_fp8_f32(o[4], o[5], 0, false); p = __builtin_amdgcn_cvt_pk_fp8_f32(o[6], o[7], p, true); w.y = (unsigned)p;
                *(u32x2*)(O + (size_t)(row0 + ai * HALF + m * 16) * ldc + col0) = w; }
    }
};

typedef int i32x4 __attribute__((ext_vector_type(4)));
typedef int i32x8 __attribute__((ext_vector_type(8)));
__device__ __forceinline__ i32x8 cat32(bf16x8 a, bf16x8 b) { const i32x4 x = __builtin_bit_cast(i32x4, a), y = __builtin_bit_cast(i32x4, b); return __builtin_shufflevector(x, y, 0, 1, 2, 3, 4, 5, 6, 7); }
template <class Epi, class Sched, bool ALIGN_EPI = false, bool SP2 = false, bool FP8 = false>
__device__ __forceinline__ void gemm_phase(PG8_LAS unsigned char* lds, const Gemm g, const Sched& S, const Epi& E) {
    const int tid = threadIdx.x, wid = __builtin_amdgcn_readfirstlane(tid >> 6), lane = tid & 63, wr = wid >> 2, wc = wid & 3, fr = lane & 15, fq = lane >> 4;
    const int RB = FP8 ? g.K : g.K * 2, nt = RB / 128;
    unsigned voffA[2], voffB[2];
#pragma unroll
    for (int i = 0; i < 2; ++i) { int R, C; stage_rc(tid * 16 + i * 8192, R, C); const int Rb = Epi::PERM ? ((R & ~31) + perm32(R & 31)) : R;
        voffA[i] = (unsigned)(R * RB + C * 2); voffB[i] = (unsigned)(Rb * RB + C * 2); }
    const size_t kstep = (size_t)(BK * 2);
    const size_t hstep = (size_t)HALF * RB;
    const size_t tstep = 2 * hstep;
    const unsigned ldsw = (unsigned)wid * 1024u;
    const int aoff = lds_byte(wr * 64 + fr, fq * 8), boff = lds_byte(wc * 32 + fr, fq * 8);
#define PG8_SA(b, h) (((b) * 2 + (h)) * HTB)
#define PG8_SB(b, h) ((4 + (b) * 2 + (h)) * HTB)
#define PG8_STAGE(bufoff, gbase, voff) do { _Pragma("unroll") for (int _i = 0; _i < 2; ++_i) { unsigned _o = (voff)[_i]; asm volatile("" : "+v"(_o));   \
        __builtin_amdgcn_global_load_lds((const unsigned*)((const char*)(gbase) + _o), (PG8_LAS unsigned*)(lds + (bufoff) + ldsw + _i * 8192), 16, 0, 0); } } while (0)
#define PG8_LD32(p) cat32(*(const PG8_LAS bf16x8*)(p), *(const PG8_LAS bf16x8*)((p) + 1024))
#define PG8_LDA(dst, b, h) do { _Pragma("unroll") for (int m = 0; m < 4; ++m) dst[m] = PG8_LD32(lds + PG8_SA(b, h) + aoff + m * 2048); } while (0)
#define PG8_LDB(dst, b, h) do { _Pragma("unroll") for (int n = 0; n < 2; ++n) dst[n] = PG8_LD32(lds + PG8_SB(b, h) + boff + n * 2048); } while (0)
#define PG8_LO(v) __builtin_bit_cast(bf16x8, __builtin_shufflevector(v, v, 0, 1, 2, 3))
#define PG8_HI(v) __builtin_bit_cast(bf16x8, __builtin_shufflevector(v, v, 4, 5, 6, 7))
#define PG8_MMA(ai, bj, At, Bt) do { __builtin_amdgcn_s_setprio(1); _Pragma("unroll") for (int m = 0; m < 4; ++m) _Pragma("unroll") for (int n = 0; n < 2; ++n) { \
        if constexpr (FP8) acc[ai][bj][m][n] = __builtin_amdgcn_mfma_scale_f32_16x16x128_f8f6f4(Bt[n], At[m], acc[ai][bj][m][n], 0, 0, 0, 0, 0, 0); \
        else { acc[ai][bj][m][n] = __builtin_amdgcn_mfma_f32_16x16x32_bf16(PG8_LO(Bt[n]), PG8_LO(At[m]), acc[ai][bj][m][n], 0, 0, 0); \
               acc[ai][bj][m][n] = __builtin_amdgcn_mfma_f32_16x16x32_bf16(PG8_HI(Bt[n]), PG8_HI(At[m]), acc[ai][bj][m][n], 0, 0, 0); } } \
        __builtin_amdgcn_s_setprio(0); } while (0)
#define PG8_WAIT_V(n) asm volatile("s_waitcnt vmcnt(" #n ")" ::: "memory")
#define PG8_WAIT_L(n) asm volatile("s_waitcnt lgkmcnt(" #n ")" ::: "memory")
#define PG8_BAR __builtin_amdgcn_s_barrier()
#define PG8_SCHED __builtin_amdgcn_sched_barrier(0)
    Unit cur, nxt; int ui = 0;
    if (!S.next(0, cur)) return;
    f32x4 acc[2][2][4][2];
#pragma unroll
    for (int a = 0; a < 2; ++a)
#pragma unroll
        for (int b = 0; b < 2; ++b)
#pragma unroll
            for (int m = 0; m < 4; ++m)
#pragma unroll
                for (int n = 0; n < 2; ++n) acc[a][b][m][n] = (f32x4){0.f, 0.f, 0.f, 0.f};
    i32x8 At[4], B0[2], B1[2];
    const char* cA = (const char*)g.A + (size_t)cur.pm * tstep; const char* cB = (const char*)g.Bt + (size_t)cur.pb * tstep;
    if constexpr (SP2) {
        PG8_STAGE(PG8_SB(0, 0), cB, voffB); PG8_STAGE(PG8_SB(0, 1), cB + hstep, voffB); PG8_STAGE(PG8_SA(0, 0), cA, voffA); PG8_STAGE(PG8_SA(0, 1), cA + hstep, voffA);
        if (wr == 1) PG8_BAR;
        PG8_WAIT_V(2); PG8_BAR;
        PG8_STAGE(PG8_SB(1, 0), cB + kstep, voffB); PG8_STAGE(PG8_SA(1, 0), cA + kstep, voffA); PG8_STAGE(PG8_SB(1, 1), cB + hstep + kstep, voffB);
        PG8_WAIT_V(6); PG8_BAR;
    } else {
        PG8_STAGE(PG8_SB(0, 0), cB, voffB); PG8_STAGE(PG8_SA(0, 0), cA, voffA); PG8_STAGE(PG8_SB(0, 1), cB + hstep, voffB); PG8_STAGE(PG8_SA(0, 1), cA + hstep, voffA);
        if (wr == 1) PG8_BAR;
        PG8_WAIT_V(4); PG8_BAR;
        PG8_STAGE(PG8_SB(1, 0), cB + kstep, voffB); PG8_STAGE(PG8_SA(1, 0), cA + kstep, voffA); PG8_STAGE(PG8_SB(1, 1), cB + hstep + kstep, voffB);
        PG8_WAIT_V(6); PG8_BAR;
    }
    for (;;) {
        const bool has_next = S.next(ui + 1, nxt);
        const char* nA = has_next ? (const char*)g.A + (size_t)nxt.pm * tstep : cA; const char* nB = has_next ? (const char*)g.Bt + (size_t)nxt.pb * tstep : cB;
        for (int t = 0; t < nt; t += 2) {
            const bool last = (t == nt - 2);
            const char* a1 = cA + (size_t)(t + 1) * kstep;
            const char* a2 = last ? nA : cA + (size_t)(t + 2) * kstep; const char* b2 = last ? nB : cB + (size_t)(t + 2) * kstep;
            const char* a3 = a2 + kstep; const char* b3 = b2 + kstep;
            if constexpr (SP2) {
            PG8_LDB(B0, 0, 0); PG8_LDB(B1, 0, 1); PG8_SCHED; PG8_LDA(At, 0, 0); PG8_STAGE(PG8_SA(1, 1), a1 + hstep, voffA);
            PG8_WAIT_V(8); PG8_WAIT_L(0); PG8_BAR; PG8_MMA(0, 0, At, B0); PG8_MMA(0, 1, At, B1); PG8_BAR; PG8_SCHED;
            PG8_LDA(At, 0, 1); PG8_STAGE(PG8_SB(0, 0), b2, voffB); PG8_STAGE(PG8_SB(0, 1), b2 + hstep, voffB); PG8_STAGE(PG8_SA(0, 0), a2, voffA);
            PG8_WAIT_V(8); PG8_WAIT_L(0); PG8_BAR; PG8_MMA(1, 0, At, B0); PG8_MMA(1, 1, At, B1); PG8_BAR; PG8_SCHED;
            PG8_LDB(B0, 1, 0); PG8_LDB(B1, 1, 1); PG8_SCHED; PG8_LDA(At, 1, 0); PG8_STAGE(PG8_SA(0, 1), a2 + hstep, voffA);
            PG8_WAIT_V(8); PG8_WAIT_L(0); PG8_BAR; PG8_MMA(0, 0, At, B0); PG8_MMA(0, 1, At, B1); PG8_BAR; PG8_SCHED;
            PG8_LDA(At, 1, 1); PG8_STAGE(PG8_SB(1, 0), b3, voffB); PG8_STAGE(PG8_SB(1, 1), b3 + hstep, voffB); PG8_STAGE(PG8_SA(1, 0), a3, voffA);
            PG8_WAIT_V(8); PG8_WAIT_L(0); PG8_BAR; PG8_MMA(1, 0, At, B0); PG8_MMA(1, 1, At, B1); PG8_BAR; PG8_SCHED;
            } else {
            PG8_LDB(B0, 0, 0); PG8_SCHED; PG8_LDA(At, 0, 0); PG8_STAGE(PG8_SA(1, 1), a1 + hstep, voffA);
            PG8_WAIT_L(8); PG8_BAR; PG8_WAIT_L(0); PG8_MMA(0, 0, At, B0); PG8_BAR; PG8_SCHED;
            PG8_LDB(B1, 0, 1); PG8_STAGE(PG8_SB(0, 0), b2, voffB);
            PG8_BAR; PG8_WAIT_L(0); PG8_MMA(0, 1, At, B1); PG8_BAR;
            PG8_LDA(At, 0, 1); PG8_STAGE(PG8_SA(0, 0), a2, voffA);
            PG8_BAR; PG8_WAIT_L(0); PG8_MMA(1, 0, At, B0); PG8_BAR; PG8_SCHED;
            PG8_STAGE(PG8_SB(0, 1), b2 + hstep, voffB);
            PG8_WAIT_V(6); PG8_BAR; PG8_MMA(1, 1, At, B1); PG8_BAR;
            PG8_LDB(B0, 1, 0); PG8_SCHED; PG8_LDA(At, 1, 0); PG8_STAGE(PG8_SA(0, 1), a2 + hstep, voffA);
            PG8_WAIT_L(8); PG8_BAR; PG8_WAIT_L(0); PG8_MMA(0, 0, At, B0); PG8_BAR; PG8_SCHED;
            PG8_LDB(B1, 1, 1); PG8_STAGE(PG8_SB(1, 0), b3, voffB);
            PG8_BAR; PG8_WAIT_L(0); PG8_MMA(0, 1, At, B1); PG8_BAR;
            PG8_LDA(At, 1, 1); PG8_STAGE(PG8_SA(1, 0), a3, voffA);
            PG8_BAR; PG8_WAIT_L(0); PG8_MMA(1, 0, At, B0); PG8_BAR; PG8_SCHED;
            PG8_STAGE(PG8_SB(1, 1), b3 + hstep, voffB);
            PG8_WAIT_V(6); PG8_BAR; PG8_MMA(1, 1, At, B1); PG8_BAR;
            }
        }
        if constexpr (ALIGN_EPI) { if (wr == 0) PG8_BAR; }
        E(acc, cur, wr, wc, fr, fq);
        if (!has_next) break;
#pragma unroll
        for (int a = 0; a < 2; ++a)
#pragma unroll
            for (int b = 0; b < 2; ++b)
#pragma unroll
                for (int m = 0; m < 4; ++m)
#pragma unroll
                    for (int n = 0; n < 2; ++n) acc[a][b][m][n] = (f32x4){0.f, 0.f, 0.f, 0.f};
        cur = nxt; cA = nA; cB = nB; ++ui;
        if constexpr (ALIGN_EPI) { if (wr == 1) PG8_BAR; }
    }
    PG8_WAIT_V(0);
    if constexpr (!ALIGN_EPI) { if (wr == 0) PG8_BAR; }
    PG8_BAR;
#undef PG8_SA
#undef PG8_SB
#undef PG8_STAGE
#undef PG8_LDA
#undef PG8_LD32
#undef PG8_LO
#undef PG8_HI
#undef PG8_LDB
#undef PG8_MMA
#undef PG8_WAIT_V
#undef PG8_WAIT_L
#undef PG8_BAR
#undef PG8_SCHED
}
}

namespace mk {
using pg8::bf16_t; using pg8::bf16x8; using pg8::f32x4; using pg8::u32x4; using pg8::u32x2; using pg8::cvt_pk_bf16; using pg8::bf_lo; using pg8::bf_hi;
constexpr int D = 2048, NB = 4, S = 4096, L = 256, NTOK = NB * S, NCTX = NB * L, MR = NTOK + NCTX;
constexpr int INW = 16384, MODW = 12288;
constexpr int RH = 8, NH = 16;
constexpr int NE = 32, FF = 2048, NSLOT256 = 288 * 256;
constexpr int C_QR = 0, C_KR = 1024, C_VR = 2048, C_GR = 4096, C_QN = 6144, C_KN = 8192, C_VN = 10240, C_GA = 12288, C_GB = 14336;
constexpr float QK_SCALE = 0.08838834764831845f, LOG2E = 1.4426950408889634f;
constexpr float W8_SCALE = 256.0f, H8_SCALE = 16.0f, A8_SCALE = 4.0f;
constexpr size_t MiB = 1u << 20;
constexpr size_t WS_CTL = 0, CTL_ZERO_BYTES = 1 * MiB;
constexpr size_t WS_MOD = 1 * MiB;
constexpr size_t WS_ASG_E = 2 * MiB, WS_ASG_POS = 3 * MiB, WS_ASG_W = 4 * MiB;
constexpr size_t WS_WIN = 16 * MiB;
constexpr size_t WS_WPA = 80 * MiB, WS_WPB = 88 * MiB, WS_WO = 96 * MiB;
constexpr size_t WS_WGU = 104 * MiB;
constexpr size_t WS_WDN = 616 * MiB;
constexpr size_t WS_HB = 872 * MiB;
constexpr size_t WS_YB = 940 * MiB;
constexpr size_t WS_XB = 940 * MiB, WS_ACTB = 1228 * MiB;
constexpr size_t WS_OF = 1484 * MiB, WS_OB = 1548 * MiB, WS_NAOB = 1612 * MiB, WS_T1 = 1676 * MiB;
constexpr int CW_CNT = 64;
constexpr int CW_BAR = 4096;
constexpr int LDS_BYTES = 155648, MISC_OFF = 153600;

#define GAS __attribute__((address_space(1)))
#define LAS __attribute__((address_space(3)))
typedef GAS unsigned gu32;
#define RLX_AGENT __ATOMIC_RELAXED, __HIP_MEMORY_SCOPE_AGENT

__device__ __forceinline__ unsigned f2bf(float f) { unsigned u = __float_as_uint(f); return (u + 0x7fffu + ((u >> 16) & 1u)) >> 16; }
__device__ __forceinline__ unsigned pk2(float lo, float hi) { return f2bf(lo) | (f2bf(hi) << 16); }
__device__ __forceinline__ float wave_sum(float v) {
#pragma unroll
    for (int o = 1; o < 64; o <<= 1) v += __shfl_xor(v, o);
    return v;
}

#define XB_TMO      128
#define XB_XCNT(j)  (256  + 64 * (j))
#define XB_XSUB(j)  (1280 + 64 * (j))
#define XB_XGEN(j)  (2304 + 64 * (j))
#define XB_TOP      3328
#define XB_TOPGEN   3392
#define XCD_BAR_WORDS 3456
#define XB_SPIN_CAP (1u << 18)
__device__ __forceinline__ unsigned xb_ld(unsigned* p)              { return __hip_atomic_load(p, __ATOMIC_RELAXED, __HIP_MEMORY_SCOPE_AGENT); }
__device__ __forceinline__ unsigned xb_add(unsigned* p, unsigned v) { return __hip_atomic_fetch_add(p, v, __ATOMIC_RELAXED, __HIP_MEMORY_SCOPE_AGENT); }
__device__ __forceinline__ unsigned xb_xcc_id() { return (unsigned)__builtin_amdgcn_s_getreg((3 << 11) | 20) & 0xFu; }
#define XB_SPIN(cond, bar) do { unsigned _sp = 0; while (cond) { __builtin_amdgcn_s_sleep(1); \
    if ((++_sp & 255u) == 0u) { if (xb_ld(&(bar)[XB_TMO])) break; if (_sp > XB_SPIN_CAP) { atomicAdd(&(bar)[XB_TMO], 1u); break; } } } } while (0)
struct XcdBarrier { unsigned* bar; unsigned x; volatile LAS unsigned* st; };
__device__ __forceinline__ XcdBarrier xcd_barrier_post(unsigned* bar, volatile LAS unsigned* st) {
    XcdBarrier b; b.bar = bar; b.x = xb_xcc_id(); b.st = st;
    if (threadIdx.x == 0) (void)xb_add(&bar[XB_XCNT(b.x)], 1u);
    return b;
}
__device__ __forceinline__ void xcd_barrier_complete(unsigned* bar, unsigned x, unsigned& nloc, unsigned& nx) {
    const unsigned G = gridDim.x * gridDim.y * gridDim.z;
    unsigned sum, cnt, mine, sp = 0u;
    for (;;) {
        sum = 0u; cnt = 0u; mine = 0u;
#pragma unroll
        for (unsigned j = 0; j < 16; ++j) { const unsigned c = xb_ld(&bar[XB_XCNT(j)]); sum += c; cnt += (c > 0u) ? 1u : 0u; mine = (j == x) ? c : mine; }
        if (sum == G) break;
        __builtin_amdgcn_s_sleep(1);
        if ((++sp & 255u) == 0u) { if (xb_ld(&bar[XB_TMO])) break; if (sp > XB_SPIN_CAP) { atomicAdd(&bar[XB_TMO], 1u); break; } }
    }
    nloc = mine > 0u ? mine : 1u; nx = cnt > 0u ? cnt : 1u;
}
__device__ __forceinline__ void xcd_barrier(const XcdBarrier& b) {
    asm volatile("s_waitcnt vmcnt(0)" ::: "memory");
    __syncthreads();
    if (threadIdx.x == 0) {
        unsigned* bar = b.bar;
        __builtin_amdgcn_s_waitcnt(0);
        unsigned nloc = b.st[0], nx = b.st[1];
        if (nloc == 0u) { xcd_barrier_complete(bar, b.x, nloc, nx); b.st[0] = nloc; b.st[1] = nx; }
        const unsigned old = xb_add(&bar[XB_XSUB(b.x)], 1u);
        const unsigned gen = old / nloc;
        if (old + 1u == (gen + 1u) * nloc) {
            __builtin_amdgcn_fence(__ATOMIC_RELEASE, "agent");
            asm volatile("s_waitcnt vmcnt(0)" ::: "memory");
            const unsigned og = xb_add(&bar[XB_TOP], 1u);
            const unsigned tg = og / nx;
            if (og + 1u == (tg + 1u) * nx) xb_add(&bar[XB_TOPGEN], 1u);
            else XB_SPIN(xb_ld(&bar[XB_TOPGEN]) == tg, bar);
            __builtin_amdgcn_fence(__ATOMIC_ACQUIRE, "agent");
            xb_add(&bar[XB_XGEN(b.x)], 1u);
            asm volatile("s_waitcnt vmcnt(0)" ::: "memory");
        } else {
            XB_SPIN(xb_ld(&bar[XB_XGEN(b.x)]) == gen, bar);
            __builtin_amdgcn_fence(__ATOMIC_ACQUIRE, "agent");
            asm volatile("s_waitcnt vmcnt(0)" ::: "memory");
        }
    }
    __syncthreads();
}

typedef const float* fptr_t;
struct Frame {
    LAS unsigned char* lds;
    volatile LAS unsigned* MISC;
    unsigned* ctl;
    unsigned char* ws;
    int tid, lane, wave, G, bx;
    const __attribute__((address_space(4))) fptr_t* in;
    float* out;
};
#define LDS_WAIT() asm volatile("s_waitcnt lgkmcnt(0)" ::: "memory")

__device__ __forceinline__ void p0_transpose_item(const float* W, int K, int N, bf16_t* WT, int k0, int n0, size_t drow0, float scale, LAS float* scr, int lane) {
#pragma unroll 8
    for (int i = 0; i < 32; ++i) { const int kk = 2 * i + (lane >> 5); scr[kk * 33 + (lane & 31)] = W[(size_t)(k0 + kk) * N + n0 + (lane & 31)]; }
    LDS_WAIT(); asm volatile("" ::: "memory");
    const int c = lane & 7;
#pragma unroll
    for (int j = 0; j < 4; ++j) { const int n = (lane >> 3) + 8 * j; const LAS float* s = scr + (8 * c) * 33 + n;
        u32x4 o; o.x = pk2(s[0 * 33] * scale, s[1 * 33] * scale); o.y = pk2(s[2 * 33] * scale, s[3 * 33] * scale); o.z = pk2(s[4 * 33] * scale, s[5 * 33] * scale); o.w = pk2(s[6 * 33] * scale, s[7 * 33] * scale);
        *(u32x4*)(WT + (drow0 + n) * (size_t)K + k0 + 8 * c) = o; }
    LDS_WAIT(); asm volatile("" ::: "memory");
}

__device__ __forceinline__ void p0_transpose_item8(const float* W, int K, int N, unsigned char* WT, int k0, int n0, size_t drow0, float scale, LAS float* scr, int lane) {
#pragma unroll 8
    for (int i = 0; i < 64; ++i) { const int kk = 2 * i + (lane >> 5); scr[kk * 33 + (lane & 31)] = W[(size_t)(k0 + kk) * N + n0 + (lane & 31)]; }
    LDS_WAIT(); asm volatile("" ::: "memory");
    const int c = lane & 7;
#pragma unroll
    for (int j = 0; j < 4; ++j) { const int n = (lane >> 3) + 8 * j; const LAS float* s = scr + (16 * c) * 33 + n; unsigned o[4];
#pragma unroll
        for (int q = 0; q < 4; ++q) { int p = __builtin_amdgcn_cvt_pk_fp8_f32(pg8::clamp448(s[(4 * q) * 33] * scale), pg8::clamp448(s[(4 * q + 1) * 33] * scale), 0, false);
            p = __builtin_amdgcn_cvt_pk_fp8_f32(pg8::clamp448(s[(4 * q + 2) * 33] * scale), pg8::clamp448(s[(4 * q + 3) * 33] * scale), p, true); o[q] = (unsigned)p; }
        *(u32x4*)(WT + (drow0 + n) * (size_t)K + k0 + 16 * c) = (u32x4){o[0], o[1], o[2], o[3]}; }
    LDS_WAIT(); asm volatile("" ::: "memory");
}

__device__ __forceinline__ void p0_mod_slab(Frame& F, int slab) {
    LAS float* sv = (LAS float*)F.lds;
    LAS float* red = (LAS float*)(F.lds + 40960);
    const float* c = F.in[1]; const float* cc = F.in[3]; const float* W = F.in[4]; const float* bias = F.in[5];
    for (int i = F.tid; i < 5 * D; i += 512) { const int r = i / D, k = i % D; const float v = r < 4 ? c[r * D + k] : cc[k]; sv[i] = v / (1.0f + __expf(-v)); }
    __syncthreads();
    const int rr = F.tid >> 4, cq = F.tid & 15, col0 = slab * 64 + 4 * cq;
    f32x4 a[5];
#pragma unroll
    for (int r = 0; r < 5; ++r) a[r] = (f32x4){0.f, 0.f, 0.f, 0.f};
#pragma unroll 4
    for (int it = 0; it < 64; ++it) { const int k = rr + 32 * it; const f32x4 w = *(const f32x4*)(W + (size_t)k * MODW + col0);
#pragma unroll
        for (int r = 0; r < 5; ++r) a[r] += w * sv[r * D + k]; }
#pragma unroll
    for (int r = 0; r < 5; ++r) *(LAS f32x4*)(red + (rr * 5 + r) * 64 + 4 * cq) = a[r];
    __syncthreads();
    if (F.tid < 320) { const int r = F.tid >> 6, cl = F.tid & 63; float s = 0.f;
        for (int q = 0; q < 32; ++q) s += red[(q * 5 + r) * 64 + cl];
        ((float*)(F.ws + WS_MOD))[r * MODW + slab * 64 + cl] = s + bias[slab * 64 + cl]; }
    __syncthreads();
}

__device__ __forceinline__ void p0_prologue(Frame& F, bool conv_moe) {
    __syncthreads();
    if (F.bx < 192) p0_mod_slab(F, F.bx);
    LAS float* scr = (LAS float*)(F.lds + F.wave * 16896);
    const int gw = F.bx * 8 + F.wave, NGW = F.G * 8;
    constexpr int I_IN = (D / (MK_FP8_INPROJ ? 128 : 64)) * (INW / 32), I_SQ = (D / 64) * (D / 32);
    const int NIT = I_IN + 3 * I_SQ + (conv_moe ? 96 * (I_SQ / 2) : 0);
    LAS float* scr8 = (LAS float*)(F.lds + F.wave * 16896);
    for (int it = gw; it < NIT; it += NGW) {
        int r = it;
        if (r < I_IN) { const int kb = r / (INW / 32), nb = r % (INW / 32), n0 = nb * 32; const bool sc = (n0 >= C_KR && n0 < C_VR) || (n0 >= C_QN && n0 < C_KN);
#if MK_FP8_INPROJ
            p0_transpose_item8(F.in[8], D, INW, F.ws + WS_WIN, kb * 128, n0, (size_t)n0, (sc ? QK_SCALE : 1.0f) * W8_SCALE, scr8, F.lane); continue; }
#else
            p0_transpose_item(F.in[8], D, INW, (bf16_t*)(F.ws + WS_WIN), kb * 64, n0, (size_t)n0, sc ? QK_SCALE : 1.0f, scr, F.lane); continue; }
#endif
        r -= I_IN;
        if (r < 3 * I_SQ) { const int mtx = r / I_SQ, q = r % I_SQ, kb = q / 64, nb = q % 64;
            p0_transpose_item(mtx == 0 ? F.in[9] : (mtx == 1 ? F.in[10] : F.in[11]), D, D, (bf16_t*)(F.ws + WS_WPA + (size_t)mtx * 8 * MiB), kb * 64, nb * 32, (size_t)nb * 32, 1.0f, scr, F.lane); continue; }
        r -= 3 * I_SQ;
        { constexpr int I_8 = I_SQ / 2;
          const int mtx = r / (32 * I_8), q = r % (32 * I_8), e = q / I_8, q2 = q % I_8, kb = q2 / 64, nb = q2 % 64, n0 = nb * 32;
          if (mtx < 2) { const float* src = (mtx == 0 ? F.in[17] : F.in[19]) + (size_t)e * D * FF;
              const size_t drow = (size_t)e * 4096 + (size_t)(n0 >> 7) * 256 + (size_t)(mtx * 128) + (size_t)(n0 & 127);
              p0_transpose_item8(src, D, FF, F.ws + WS_WGU, kb * 128, n0, drow, W8_SCALE, scr8, F.lane); }
          else { const float* src = F.in[21] + (size_t)e * FF * D;
              p0_transpose_item8(src, FF, D, F.ws + WS_WDN, kb * 128, n0, (size_t)e * 2048 + n0, W8_SCALE, scr8, F.lane); } }
    }
}

__device__ __forceinline__ void p1_rows(Frame& F) {
    const int gw = F.bx * 8 + F.wave, NGW = F.G * 8;
    const float* mod = (const float*)(F.ws + WS_MOD); const float* g = F.in[6];
    bf16_t* HB = (bf16_t*)(F.ws + WS_HB);
    for (int m = gw; m < MR; m += NGW) {
        const float* src = m < NTOK ? F.in[0] + (size_t)m * D : F.in[2] + (size_t)(m - NTOK) * D;
        const float* md = mod + (size_t)(m < NTOK ? m / S : 4) * MODW;
        f32x4 v[8]; float ss = 0.f;
#pragma unroll
        for (int j = 0; j < 8; ++j) { v[j] = *(const f32x4*)(src + 4 * F.lane + 256 * j); ss += (v[j][0] * v[j][0] + v[j][1] * v[j][1]) + (v[j][2] * v[j][2] + v[j][3] * v[j][3]); }
        const float rstd = rsqrtf(wave_sum(ss) * (1.0f / D) + 1e-6f);
#pragma unroll
        for (int j = 0; j < 8; ++j) { const int k = 4 * F.lane + 256 * j; const f32x4 gg = *(const f32x4*)(g + k), sh = *(const f32x4*)(md + k), sc = *(const f32x4*)(md + D + k);
            const f32x4 y = v[j] * rstd * gg * (sc + 1.0f) + sh;
#if MK_FP8_INPROJ
            int p = __builtin_amdgcn_cvt_pk_fp8_f32(pg8::clamp448(y[0] * H8_SCALE), pg8::clamp448(y[1] * H8_SCALE), 0, false); p = __builtin_amdgcn_cvt_pk_fp8_f32(pg8::clamp448(y[2] * H8_SCALE), pg8::clamp448(y[3] * H8_SCALE), p, true);
            *(int*)((unsigned char*)HB + (size_t)m * D + k) = p; }
#else
            u32x2 o; o.x = pk2(y[0], y[1]); o.y = pk2(y[2], y[3]);
            *(u32x2*)(HB + (size_t)m * D + k) = o; }
#endif
    }
}

typedef short v4i16_t __attribute__((ext_vector_type(4)));
__device__ __forceinline__ v4i16_t ds_tr(const LAS unsigned char* p) { return __builtin_amdgcn_ds_read_tr16_b64_v4i16((LAS v4i16_t*)p); }
__device__ __forceinline__ bf16x8 cat8(v4i16_t a, v4i16_t b) { bf16x8 r; r[0] = a[0]; r[1] = a[1]; r[2] = a[2]; r[3] = a[3]; r[4] = b[0]; r[5] = b[1]; r[6] = b[2]; r[7] = b[3]; return r; }
#define MFMA16(a, b, c) __builtin_amdgcn_mfma_f32_16x16x32_bf16((a), (b), (c), 0, 0, 0)

constexpr int R_QS = 0, R_KS = 34816, R_KZ = 69632, R_VS = 106496, R_RT = 126976;
constexpr int PQ = 272, PK = 272, PZ = 288, PV = 160, PR = 272;

__device__ __forceinline__ void ret_unit(Frame& F, int b, int h, int dir, int dvs) {
    LAS unsigned char* lds = F.lds;
    __syncthreads();
    const int tid = F.tid, w = F.wave;
    const bf16_t* YB = (const bf16_t*)(F.ws + WS_YB);
    bf16_t* OUT = (bf16_t*)(F.ws + (dir ? WS_OB : WS_OF));
    const float dec = (dir ? F.in[13] : F.in[12])[h];
    const float l2g = -log1pf(expf(-dec)) * LOG2E;
    const float gC = exp2f(128.0f * l2g);
    u32x4 rq[2][2], rk[2][2], rv[2];
    f32x4 Racc[2][2];
#pragma unroll
    for (int a = 0; a < 2; ++a)
#pragma unroll
        for (int c = 0; c < 2; ++c) Racc[a][c] = (f32x4){0.f, 0.f, 0.f, 0.f};
    for (int i = tid; i < 64 * PR / 16; i += 512) *(LAS u32x4*)(lds + R_RT + i * 16) = (u32x4){0u, 0u, 0u, 0u};

    auto base_row = [&](int it) -> int { if (it < 2) { const int ci = dir ? 1 - it : it; return NTOK + b * L + ci * 128; } const int ci = dir ? 31 - (it - 2) : (it - 2); return b * S + ci * 128; };
    auto issue = [&](int it, int tz) {
        const int br = base_row(it); const int aj = tz & 7, colq = (aj >> 2) * 64 + 8 * (aj & 3);
#pragma unroll
        for (int i = 0; i < 2; ++i) { const int p = (tz >> 3) + 64 * i; const size_t row = (size_t)(br + (dir ? 127 - p : p));
            const bf16_t* rp = YB + row * INW;
            if (it >= 2) { rq[i][0] = *(const u32x4*)(rp + C_QR + h * 128 + colq); rq[i][1] = *(const u32x4*)(rp + C_QR + h * 128 + colq + 32); }
            rk[i][0] = *(const u32x4*)(rp + C_KR + h * 128 + colq); rk[i][1] = *(const u32x4*)(rp + C_KR + h * 128 + colq + 32);
            rv[i] = *(const u32x4*)(rp + C_VR + h * 256 + dvs * 64 + 8 * aj); }
    };
    auto commit = [&](int it, int tz, float l2z) {
        const int br = base_row(it); const bool lat = it >= 2; const int aj = tz & 7, axis = aj >> 2, jj = aj & 3, colq = axis * 64 + 8 * jj;
        float invrev[8];
#pragma unroll
        for (int e = 0; e < 8; ++e) invrev[e] = exp2f(-(float)(2 * (8 * jj + e)) * (13.287712379549449f / 64.0f)) * 0.15915494309189535f;
#pragma unroll
        for (int i = 0; i < 2; ++i) { const int p = (tz >> 3) + 64 * i; const int t = (br - b * S) + (dir ? 127 - p : p);
            float cs[8], sn[8];
            if (lat) { const float pos = (float)(axis == 0 ? (t >> 6) : (t & 63));
#pragma unroll
                for (int e = 0; e < 8; ++e) { const float rev = pos * invrev[e]; cs[e] = __builtin_amdgcn_cosf(rev); sn[e] = __builtin_amdgcn_sinf(rev); } }
            else {
#pragma unroll
                for (int e = 0; e < 8; ++e) { cs[e] = 1.0f; sn[e] = 0.0f; } }
            const float zeta = exp2f((float)(127 - p) * l2z);
            const unsigned a1[4] = {rk[i][0].x, rk[i][0].y, rk[i][0].z, rk[i][0].w}, a2[4] = {rk[i][1].x, rk[i][1].y, rk[i][1].z, rk[i][1].w};
            u32x4 k1, k2, z1, z2; unsigned* k1p = (unsigned*)&k1; unsigned* k2p = (unsigned*)&k2; unsigned* z1p = (unsigned*)&z1; unsigned* z2p = (unsigned*)&z2;
#pragma unroll
            for (int q = 0; q < 4; ++q) { const float x1a = bf_lo(a1[q]), x1b = bf_hi(a1[q]), x2a = bf_lo(a2[q]), x2b = bf_hi(a2[q]);
                const float o1a = x1a * cs[2 * q] - x2a * sn[2 * q], o1b = x1b * cs[2 * q + 1] - x2b * sn[2 * q + 1];
                const float o2a = x2a * cs[2 * q] + x1a * sn[2 * q], o2b = x2b * cs[2 * q + 1] + x1b * sn[2 * q + 1];
                k1p[q] = pk2(o1a, o1b); k2p[q] = pk2(o2a, o2b); z1p[q] = pk2(o1a * zeta, o1b * zeta); z2p[q] = pk2(o2a * zeta, o2b * zeta); }
            *(LAS u32x4*)(lds + R_KS + p * PK + colq * 2) = k1; *(LAS u32x4*)(lds + R_KS + p * PK + (colq + 32) * 2) = k2;
            *(LAS u32x4*)(lds + R_KZ + p * PZ + colq * 2) = z1; *(LAS u32x4*)(lds + R_KZ + p * PZ + (colq + 32) * 2) = z2;
            if (lat) { const unsigned b1[4] = {rq[i][0].x, rq[i][0].y, rq[i][0].z, rq[i][0].w}, b2[4] = {rq[i][1].x, rq[i][1].y, rq[i][1].z, rq[i][1].w};
                u32x4 q1, q2; unsigned* q1p = (unsigned*)&q1; unsigned* q2p = (unsigned*)&q2;
#pragma unroll
                for (int q = 0; q < 4; ++q) { const float x1a = bf_lo(b1[q]), x1b = bf_hi(b1[q]), x2a = bf_lo(b2[q]), x2b = bf_hi(b2[q]);
                    q1p[q] = pk2(x1a * cs[2 * q] - x2a * sn[2 * q], x1b * cs[2 * q + 1] - x2b * sn[2 * q + 1]);
                    q2p[q] = pk2(x2a * cs[2 * q] + x1a * sn[2 * q], x2b * cs[2 * q + 1] + x1b * sn[2 * q + 1]); }
                *(LAS u32x4*)(lds + R_QS + p * PQ + colq * 2) = q1; *(LAS u32x4*)(lds + R_QS + p * PQ + (colq + 32) * 2) = q2; }
            *(LAS u32x4*)(lds + R_VS + p * PV + aj * 16) = rv[i]; }
    };

    issue(0, tid);
    commit(0, tid, l2g);
    __syncthreads();
    const int wr4 = w >> 1, wc2 = w & 1;
    const int wr2 = w >> 2, wc4 = w & 3;
    for (int it = 0; it < 34; ++it) {
        const bool lat = it >= 2;
        float l2i = l2g; int tz = tid; asm volatile("" : "+v"(l2i), "+v"(tz));
        const int fr = tz & 15, fq = (tz & 63) >> 4;
        f32x4 Sacc[2][4], Oacc[2][2];
        if (lat) {
#pragma unroll
            for (int a = 0; a < 2; ++a) {
#pragma unroll
                for (int c = 0; c < 4; ++c) Sacc[a][c] = (f32x4){0.f, 0.f, 0.f, 0.f};
#pragma unroll
                for (int c = 0; c < 2; ++c) Oacc[a][c] = (f32x4){0.f, 0.f, 0.f, 0.f}; }
#pragma unroll
            for (int ks = 0; ks < 4; ++ks) {
                bf16x8 qa[2], kb[4], rb[2];
#pragma unroll
                for (int a = 0; a < 2; ++a) qa[a] = *(const LAS bf16x8*)(lds + R_QS + (32 * wr4 + 16 * a + fr) * PQ + (32 * ks + 8 * fq) * 2);
#pragma unroll
                for (int c = 0; c < 4; ++c) kb[c] = *(const LAS bf16x8*)(lds + R_KS + (64 * wc2 + 16 * c + fr) * PK + (32 * ks + 8 * fq) * 2);
#pragma unroll
                for (int c = 0; c < 2; ++c) rb[c] = *(const LAS bf16x8*)(lds + R_RT + (32 * wc2 + 16 * c + fr) * PR + (32 * ks + 8 * fq) * 2);
#pragma unroll
                for (int a = 0; a < 2; ++a) {
#pragma unroll
                    for (int c = 0; c < 4; ++c) Sacc[a][c] = MFMA16(kb[c], qa[a], Sacc[a][c]);
#pragma unroll
                    for (int c = 0; c < 2; ++c) Oacc[a][c] = MFMA16(rb[c], qa[a], Oacc[a][c]); }
            }
        }
        __syncthreads();
        if (lat) {
#pragma unroll
            for (int a = 0; a < 2; ++a)
#pragma unroll
                for (int c = 0; c < 4; ++c) { const int cr = 32 * wr4 + 16 * a + fr, m0 = 64 * wc2 + 16 * c + 4 * fq; float o[4];
#pragma unroll
                    for (int j = 0; j < 4; ++j) { const int dlt = cr - (m0 + j); o[j] = dlt >= 0 ? Sacc[a][c][j] * exp2f((float)dlt * l2i) : 0.0f; }
                    u32x2 wv; wv.x = pk2(o[0], o[1]); wv.y = pk2(o[2], o[3]);
                    *(LAS u32x2*)(lds + R_KS + cr * PK + m0 * 2) = wv; }
        }
        if (it + 1 < 34) issue(it + 1, tz);
        {
#pragma unroll
            for (int a = 0; a < 2; ++a)
#pragma unroll
                for (int c = 0; c < 2; ++c) Racc[a][c] *= gC;
#pragma unroll
            for (int ks = 0; ks < 4; ++ks) {
                bf16x8 va[2], zb[2];
                const int c0 = 32 * ks + 8 * fq + (fr >> 2);
#pragma unroll
                for (int a = 0; a < 2; ++a) va[a] = cat8(ds_tr(lds + R_VS + c0 * PV + (32 * wr2 + 16 * a + 4 * (fr & 3)) * 2), ds_tr(lds + R_VS + (c0 + 4) * PV + (32 * wr2 + 16 * a + 4 * (fr & 3)) * 2));
#pragma unroll
                for (int c = 0; c < 2; ++c) zb[c] = cat8(ds_tr(lds + R_KZ + c0 * PZ + (32 * wc4 + 16 * c + 4 * (fr & 3)) * 2), ds_tr(lds + R_KZ + (c0 + 4) * PZ + (32 * wc4 + 16 * c + 4 * (fr & 3)) * 2));
#pragma unroll
                for (int a = 0; a < 2; ++a)
#pragma unroll
                    for (int c = 0; c < 2; ++c) Racc[a][c] = MFMA16(zb[c], va[a], Racc[a][c]);
            }
        }
        __syncthreads();
        if (lat) {
#pragma unroll
            for (int a = 0; a < 2; ++a) { const float xi = exp2f((float)(32 * wr4 + 16 * a + fr + 1) * l2i);
#pragma unroll
                for (int c = 0; c < 2; ++c) Oacc[a][c] *= xi; }
#pragma unroll
            for (int ks = 0; ks < 4; ++ks) {
                bf16x8 sa[2], vb[2];
                const int c0 = 32 * ks + 8 * fq + (fr >> 2);
#pragma unroll
                for (int a = 0; a < 2; ++a) sa[a] = *(const LAS bf16x8*)(lds + R_KS + (32 * wr4 + 16 * a + fr) * PK + (32 * ks + 8 * fq) * 2);
#pragma unroll
                for (int c = 0; c < 2; ++c) vb[c] = cat8(ds_tr(lds + R_VS + c0 * PV + (32 * wc2 + 16 * c + 4 * (fr & 3)) * 2), ds_tr(lds + R_VS + (c0 + 4) * PV + (32 * wc2 + 16 * c + 4 * (fr & 3)) * 2));
#pragma unroll
                for (int a = 0; a < 2; ++a)
#pragma unroll
                    for (int c = 0; c < 2; ++c) Oacc[a][c] = MFMA16(vb[c], sa[a], Oacc[a][c]);
            }
            const int br = base_row(it);
#pragma unroll
            for (int a = 0; a < 2; ++a) { const int p = 32 * wr4 + 16 * a + fr; const size_t row = (size_t)(br + (dir ? 127 - p : p));
#pragma unroll
                for (int c = 0; c < 2; ++c) { u32x2 wv; wv.x = pk2(Oacc[a][c][0], Oacc[a][c][1]); wv.y = pk2(Oacc[a][c][2], Oacc[a][c][3]);
                    *(u32x2*)(OUT + row * D + h * 256 + dvs * 64 + 32 * wc2 + 16 * c + 4 * fq) = wv; } }
        }
#pragma unroll
        for (int a = 0; a < 2; ++a)
#pragma unroll
            for (int c = 0; c < 2; ++c) { u32x2 wv; wv.x = pk2(Racc[a][c][0], Racc[a][c][1]); wv.y = pk2(Racc[a][c][2], Racc[a][c][3]);
                *(LAS u32x2*)(lds + R_RT + (32 * wr2 + 16 * a + fr) * PR + (32 * wc4 + 16 * c + 4 * fq) * 2) = wv; }
        __syncthreads();
        if (it + 1 < 34) commit(it + 1, tz, l2i);
        __syncthreads();
    }
}

constexpr int N_K = 0, N_V = 18432, N_RPB = 36864, NP_ = 288;
__device__ __forceinline__ void na_unit(Frame& F, int b, int h, int rp) {
    LAS unsigned char* lds = F.lds;
    const int tid = F.tid, lane = F.lane, w = F.wave, fr = lane & 15, fq = lane >> 4;
    const bf16_t* YB = (const bf16_t*)(F.ws + WS_YB);
    bf16_t* NAOB = (bf16_t*)(F.ws + WS_NAOB);
    const int r0 = 2 * rp, qrow = r0 + (w >> 2), j = w & 3;
    const int kstart = j == 0 ? 0 : (j == 1 ? 8 : (j == 2 ? 24 : 32));
    const int rs_w = min(max(qrow - 4, 0), 56);
    const int lo = min(max(r0 - 4, 0), 56), hi = min(max(r0 + 1 - 4, 0), 56) + 7, nloc = hi - lo + 1, ns = nloc + 4;
    const int qc = 16 * j + fr, cs = min(max(qc - 8, 0), 48);
    bf16x8 Qf[4];
    { const bf16_t* qp = YB + (size_t)(b * S + qrow * 64 + 16 * j + fr) * INW + C_QN + h * 128 + 8 * fq;
#pragma unroll
      for (int ks = 0; ks < 4; ++ks) Qf[ks] = *(const bf16x8*)(qp + 32 * ks); }
    f32x4 O[8];
#pragma unroll
    for (int d = 0; d < 8; ++d) O[d] = (f32x4){0.f, 0.f, 0.f, 0.f};
    float m_run = -1e30f, l_part = 0.f;
    u32x4 rk[2], rv[2];
    auto issue = [&](int st) {
#pragma unroll
        for (int i = 0; i < 2; ++i) { const int T = tid + 512 * i, key = T >> 4, ch = T & 15;
            const size_t row = st < nloc ? (size_t)(b * S + (lo + st) * 64 + key) : (size_t)(NTOK + b * L + (st - nloc) * 64 + key);
            rk[i] = *(const u32x4*)(YB + row * INW + C_KN + h * 128 + 8 * ch); rv[i] = *(const u32x4*)(YB + row * INW + C_VN + h * 128 + 8 * ch); }
    };
    auto block32 = [&](int kb0, bool local, int kr) {
        f32x4 Sx[2];
#pragma unroll
        for (int t = 0; t < 2; ++t) { Sx[t] = (f32x4){0.f, 0.f, 0.f, 0.f};
#pragma unroll
            for (int ks = 0; ks < 4; ++ks) { const bf16x8 kf = *(const LAS bf16x8*)(lds + N_K + (kb0 + 16 * t + fr) * NP_ + (32 * ks + 8 * fq) * 2); Sx[t] = MFMA16(kf, Qf[ks], Sx[t]); } }
        float s[8]; float mx = -1e30f;
#pragma unroll
        for (int t = 0; t < 2; ++t)
#pragma unroll
            for (int e = 0; e < 4; ++e) { float v = Sx[t][e] * LOG2E;
                if (local) { const int kc = kb0 + 16 * t + 4 * fq + e; const bool ok = kc >= cs && kc < cs + 16;
                    const int bi = min(max(kc - qc + 15, 0), 30);
                    v = ok ? v + ((const LAS float*)(lds + N_RPB))[(kr - qrow + 7) * 31 + bi] : -1e30f; }
                s[4 * t + e] = v; mx = fmaxf(mx, v); }
        mx = fmaxf(mx, __shfl_xor(mx, 16)); mx = fmaxf(mx, __shfl_xor(mx, 32));
        const float m_new = fmaxf(m_run, mx), alpha = exp2f(m_run - m_new);
        float ps = 0.f; float p[8];
#pragma unroll
        for (int e = 0; e < 8; ++e) { p[e] = exp2f(s[e] - m_new); ps += p[e]; }
        l_part = l_part * alpha + ps; m_run = m_new;
#pragma unroll
        for (int d = 0; d < 8; ++d) O[d] *= alpha;
        u32x4 pw; pw.x = pk2(p[0], p[1]); pw.y = pk2(p[2], p[3]); pw.z = pk2(p[4], p[5]); pw.w = pk2(p[6], p[7]);
        const bf16x8 pf = __builtin_bit_cast(bf16x8, pw);
        const int k0 = kb0 + 4 * fq + (fr >> 2);
#pragma unroll
        for (int d = 0; d < 8; ++d) { const bf16x8 vf = cat8(ds_tr(lds + N_V + k0 * NP_ + (16 * d + 4 * (fr & 3)) * 2), ds_tr(lds + N_V + (k0 + 16) * NP_ + (16 * d + 4 * (fr & 3)) * 2));
            O[d] = MFMA16(vf, pf, O[d]); }
    };
    issue(0);
    for (int st = 0; st < ns; ++st) {
        __syncthreads();
#pragma unroll
        for (int i = 0; i < 2; ++i) { const int T = tid + 512 * i, key = T >> 4, ch = T & 15;
            *(LAS u32x4*)(lds + N_K + key * NP_ + ch * 16) = rk[i]; *(LAS u32x4*)(lds + N_V + key * NP_ + ch * 16) = rv[i]; }
        if (st == 0 && tid < 465) ((LAS float*)(lds + N_RPB))[tid] = F.in[14][h * 465 + tid] * LOG2E;
        __syncthreads();
        if (st + 1 < ns) issue(st + 1);
        if (st < nloc) { const int kr = lo + st; if (kr >= rs_w && kr < rs_w + 8) block32(kstart, true, kr); }
        else { block32(0, false, 0); block32(32, false, 0); }
    }
    float l = l_part; l += __shfl_xor(l, 16); l += __shfl_xor(l, 32);
    const float inv = 1.0f / l;
    bf16_t* op = NAOB + (size_t)(b * S + qrow * 64 + 16 * j + fr) * D + h * 128 + 4 * fq;
#pragma unroll
    for (int d = 0; d < 8; ++d) { u32x2 wv; wv.x = pk2(O[d][0] * inv, O[d][1] * inv); wv.y = pk2(O[d][2] * inv, O[d][3] * inv); *(u32x2*)(op + 16 * d) = wv; }
}

__device__ __forceinline__ void p4_rows(Frame& F) {
    const int gw = F.bx * 8 + F.wave, NGW = F.G * 8;
    const bf16_t* OF = (const bf16_t*)(F.ws + WS_OF); const bf16_t* OB = (const bf16_t*)(F.ws + WS_OB); const bf16_t* YB = (const bf16_t*)(F.ws + WS_YB);
    bf16_t* A1B = (bf16_t*)(F.ws + WS_HB);
    for (int m = gw; m < NTOK; m += NGW) {
#pragma unroll
        for (int hh = 0; hh < RH; ++hh) { const size_t o = (size_t)m * D + hh * 256 + 4 * F.lane;
            const u32x2 a = *(const u32x2*)(OF + o), c = *(const u32x2*)(OB + o), g = *(const u32x2*)(YB + (size_t)m * INW + C_GR + hh * 256 + 4 * F.lane);
            float v[4] = {bf_lo(a.x) + bf_lo(c.x), bf_hi(a.x) + bf_hi(c.x), bf_lo(a.y) + bf_lo(c.y), bf_hi(a.y) + bf_hi(c.y)};
            const float mu = wave_sum((v[0] + v[1]) + (v[2] + v[3])) * (1.0f / 256.0f);
#pragma unroll
            for (int q = 0; q < 4; ++q) v[q] -= mu;
            const float rstd = rsqrtf(wave_sum((v[0] * v[0] + v[1] * v[1]) + (v[2] * v[2] + v[3] * v[3])) * (1.0f / 256.0f) + 1e-5f);
            const float gg[4] = {bf_lo(g.x), bf_hi(g.x), bf_lo(g.y), bf_hi(g.y)};
#pragma unroll
            for (int q = 0; q < 4; ++q) v[q] = v[q] * rstd * gg[q] * pg8::sigm(gg[q]);
            u32x2 wv; wv.x = pk2(v[0], v[1]); wv.y = pk2(v[2], v[3]); *(u32x2*)(A1B + o) = wv; }
    }
}

__device__ __forceinline__ void p7_route(Frame& F) {
    LAS float* gs = (LAS float*)(F.lds);
    LAS float* shv = (LAS float*)(F.lds + 8192);
    LAS float* part = (LAS float*)(F.lds + 16384);
    LAS float* ssq = (LAS float*)(F.lds + 32768);
    LAS float* qc = (LAS float*)(F.lds + 33280);
    LAS float* lgt = (LAS float*)(F.lds + 35328);
    LAS float* rsd = (LAS float*)(F.lds + 37376);
    const int tid = F.tid, lane = F.lane, w = F.wave, ri = lane & 15, kq = lane >> 4;
    const float* X1 = F.out; const float* g2 = F.in[7]; const float* Wr = F.in[15]; const float* br = F.in[16];
    const float* mod = (const float*)(F.ws + WS_MOD);
    unsigned char* H2B = F.ws + WS_HB;
    int* asg_e = (int*)(F.ws + WS_ASG_E); int* asg_pos = (int*)(F.ws + WS_ASG_POS); float* asg_w = (float*)(F.ws + WS_ASG_W);
    unsigned* counts = F.ctl + CW_CNT;
    for (int grp = F.bx; grp < NTOK / 16; grp += F.G) {
        const int row0 = grp * 16, bb = row0 / S; const float* md = mod + (size_t)bb * MODW;
        __syncthreads();
        for (int k = tid; k < D; k += 512) { gs[k] = g2[k] * (1.0f + md[4 * D + k]); shv[k] = md[3 * D + k]; }
        __syncthreads();
        { const int e = tid & 31, pt = tid >> 5; float s = 0.f;
          for (int k = pt * 128; k < pt * 128 + 128; ++k) s += shv[k] * Wr[k * 32 + e];
          qc[pt * 32 + e] = s; }
        f32x4 acc0 = (f32x4){0.f, 0.f, 0.f, 0.f}, acc1 = acc0; float ss = 0.f;
        const float* xr = X1 + (size_t)(row0 + ri) * D + 256 * w + 4 * kq;
#pragma unroll 4
        for (int s = 0; s < 16; ++s) { const int k0 = 256 * w + 16 * s + 4 * kq; const f32x4 xv = *(const f32x4*)(xr + 16 * s);
            ss += (xv[0] * xv[0] + xv[1] * xv[1]) + (xv[2] * xv[2] + xv[3] * xv[3]);
#pragma unroll
            for (int q = 0; q < 4; ++q) { const float a = xv[q] * gs[k0 + q]; const float b0 = Wr[(k0 + q) * 32 + ri], b1 = Wr[(k0 + q) * 32 + 16 + ri];
                acc0 = __builtin_amdgcn_mfma_f32_16x16x4f32(a, b0, acc0, 0, 0, 0); acc1 = __builtin_amdgcn_mfma_f32_16x16x4f32(a, b1, acc1, 0, 0, 0); } }
        ss += __shfl_xor(ss, 16); ss += __shfl_xor(ss, 32);
#pragma unroll
        for (int q = 0; q < 4; ++q) { part[(w * 16 + 4 * kq + q) * 32 + ri] = acc0[q]; part[(w * 16 + 4 * kq + q) * 32 + 16 + ri] = acc1[q]; }
        if (kq == 0) ssq[w * 16 + ri] = ss;
        __syncthreads();
        { const int row = tid >> 5, e = tid & 31; float sq = 0.f, pp = 0.f, qq = 0.f;
#pragma unroll
          for (int q = 0; q < 8; ++q) { sq += ssq[q * 16 + row]; pp += part[(q * 16 + row) * 32 + e]; }
#pragma unroll
          for (int q = 0; q < 16; ++q) qq += qc[q * 32 + e];
          const float rstd = rsqrtf(sq * (1.0f / D) + 1e-6f);
          lgt[row * 32 + e] = rstd * pp + qq + br[e]; if (e == 0) rsd[row] = rstd; }
        __syncthreads();
        if (tid < 16) { const int m = row0 + tid; int sel[4]; float val[4]; unsigned used = 0u;
#pragma unroll
            for (int k = 0; k < 4; ++k) { int bi = -1; float bv = 0.f;
                for (int e = 0; e < 32; ++e) { const float x = lgt[tid * 32 + e]; if (!((used >> e) & 1u) && (bi < 0 || x > bv)) { bi = e; bv = x; } }
                used |= 1u << bi; sel[k] = bi; val[k] = bv; }
            float den = 0.f, ex[4];
#pragma unroll
            for (int k = 0; k < 4; ++k) { ex[k] = __expf(val[k] - val[0]); den += ex[k]; }
#pragma unroll
            for (int k = 0; k < 4; ++k) { const unsigned pos = atomicAdd(&counts[sel[k]], 1u); asg_e[m * 4 + k] = sel[k]; asg_pos[m * 4 + k] = (int)pos; asg_w[m * 4 + k] = ex[k] / den; } }
        for (int i = tid; i < 16 * (D / 8); i += 512) { const int row = i >> 8, k = (i & 255) * 8; const float rstd = rsd[row]; float y[8];
            const f32x4 xa = *(const f32x4*)(X1 + (size_t)(row0 + row) * D + k), xb = *(const f32x4*)(X1 + (size_t)(row0 + row) * D + k + 4);
#pragma unroll
            for (int q = 0; q < 4; ++q) { y[q] = pg8::clamp448((xa[q] * rstd * gs[k + q] + shv[k + q]) * H8_SCALE); y[4 + q] = pg8::clamp448((xb[q] * rstd * gs[k + 4 + q] + shv[k + 4 + q]) * H8_SCALE); }
            u32x2 wv; int p = __builtin_amdgcn_cvt_pk_fp8_f32(y[0], y[1], 0, false); p = __builtin_amdgcn_cvt_pk_fp8_f32(y[2], y[3], p, true); wv.x = (unsigned)p;
            p = __builtin_amdgcn_cvt_pk_fp8_f32(y[4], y[5], 0, false); p = __builtin_amdgcn_cvt_pk_fp8_f32(y[6], y[7], p, true); wv.y = (unsigned)p;
            *(u32x2*)(H2B + (size_t)(row0 + row) * D + k) = wv; }
    }
}

__device__ __forceinline__ void load_tp(Frame& F, LAS int* tp) {
    __syncthreads();
    if (F.tid == 0) { int a = 0; for (int e = 0; e < 32; ++e) { tp[e] = a; a += ((int)__hip_atomic_load(F.ctl + CW_CNT + e, RLX_AGENT) + 255) >> 8; } tp[32] = a; }
    __syncthreads();
}
__device__ __forceinline__ void p8_gather(Frame& F, LAS int* tp) {
    const int gw = F.bx * 8 + F.wave, NGW = F.G * 8;
    const unsigned char* H2B = F.ws + WS_HB; unsigned char* XB = F.ws + WS_XB;
    const int* asg_e = (const int*)(F.ws + WS_ASG_E); const int* asg_pos = (const int*)(F.ws + WS_ASG_POS);
    for (int a = gw; a < NTOK * 4; a += NGW) { const int e = asg_e[a], slot = 256 * tp[e] + asg_pos[a];
        const u32x4* src = (const u32x4*)(H2B + (size_t)(a >> 2) * D) + F.lane; u32x4* dst = (u32x4*)(XB + (size_t)slot * D) + F.lane;
        const u32x4 v0 = src[0], v1 = src[64]; dst[0] = v0; dst[64] = v1; }
}
__device__ __forceinline__ void p11_final(Frame& F, LAS int* tp) {
    const int gw = F.bx * 8 + F.wave, NGW = F.G * 8;
    const bf16_t* YSB = (const bf16_t*)(F.ws + WS_XB);
    const int* asg_e = (const int*)(F.ws + WS_ASG_E); const int* asg_pos = (const int*)(F.ws + WS_ASG_POS); const float* asg_w = (const float*)(F.ws + WS_ASG_W);
    const float* mod = (const float*)(F.ws + WS_MOD); const float* fg = F.in[23];
    for (int m = gw; m < NTOK; m += NGW) {
        const float* g2v = mod + (size_t)(m / S) * MODW + 5 * D;
        size_t so[4]; float wk[4];
#pragma unroll
        for (int k = 0; k < 4; ++k) { so[k] = (size_t)(256 * tp[asg_e[m * 4 + k]] + asg_pos[m * 4 + k]) * D; wk[k] = asg_w[m * 4 + k]; }
        f32x4 v[8]; float ss = 0.f;
#pragma unroll
        for (int j = 0; j < 8; ++j) { const int n = 4 * F.lane + 256 * j; f32x4 y = (f32x4){0.f, 0.f, 0.f, 0.f};
#pragma unroll
            for (int k = 0; k < 4; ++k) { const u32x2 t = *(const u32x2*)(YSB + so[k] + n); y += (f32x4){bf_lo(t.x), bf_hi(t.x), bf_lo(t.y), bf_hi(t.y)} * wk[k]; }
            v[j] = *(const f32x4*)(F.out + (size_t)m * D + n) + *(const f32x4*)(g2v + n) * y;
            ss += (v[j][0] * v[j][0] + v[j][1] * v[j][1]) + (v[j][2] * v[j][2] + v[j][3] * v[j][3]); }
        const float rstd = rsqrtf(wave_sum(ss) * (1.0f / D) + 1e-6f);
#pragma unroll
        for (int j = 0; j < 8; ++j) { const int n = 4 * F.lane + 256 * j; *(f32x4*)(F.out + (size_t)m * D + n) = v[j] * rstd * *(const f32x4*)(fg + n); }
    }
}

struct Args { const float* in[24]; float* out; unsigned char* ws; int ph_lo, ph_hi; };
constexpr int NPH = 12;
__global__ void __launch_bounds__(512, 2) mk_fwd(Args args) {
    extern __shared__ __attribute__((aligned(16))) unsigned char lds[];
    Frame F;
    F.lds = (LAS unsigned char*)lds; F.MISC = (volatile LAS unsigned*)(F.lds + MISC_OFF);
    F.tid = threadIdx.x; F.lane = F.tid & 63; F.wave = __builtin_amdgcn_readfirstlane(F.tid >> 6); F.G = gridDim.x; F.bx = blockIdx.x;
    F.ws = args.ws; F.ctl = (unsigned*)(args.ws + WS_CTL); F.out = args.out;
    F.in = (const __attribute__((address_space(4))) fptr_t*)__builtin_amdgcn_kernarg_segment_ptr();
    for (int u = F.tid; u < (LDS_BYTES - MISC_OFF) / 4; u += 512) ((LAS unsigned*)(F.lds + MISC_OFF))[u] = 0u;
    __syncthreads();
    const int lo = args.ph_lo, hi = args.ph_hi;
    const bool multi = (hi - lo) > 1;
    XcdBarrier bar; bar.bar = F.ctl + CW_BAR; bar.x = 0; bar.st = nullptr;
    if (multi) bar = xcd_barrier_post(F.ctl + CW_BAR, F.MISC + 8);
#ifndef MK_PHMASK
#define MK_PHMASK 0xfff
#endif
#define IN(k) (((MK_PHMASK >> (k)) & 1) && lo <= (k) && (k) < hi)
#define SEAM(k) do { if (IN(k) && IN((k) + 1)) xcd_barrier(bar); } while (0)
    LAS int* tp = (LAS int*)(F.lds + MISC_OFF + 256);
#ifndef MK_REPMASK
#define MK_REPMASK 0x0
#ifndef MK_FP8_INPROJ
#define MK_FP8_INPROJ 1
#endif
#endif
#define REP(k) for (int rep_ = 0; rep_ < (((MK_REPMASK >> (k)) & 1) ? 2 : 1); ++rep_)

    if (IN(0)) REP(0) { p0_prologue(F, MK_STAGE >= 5); } SEAM(0);
    if (IN(1)) REP(1) { p1_rows(F); } SEAM(1);
    if (IN(2)) REP(2) {
        pg8::Gemm g{(const bf16_t*)(F.ws + WS_HB), (const bf16_t*)(F.ws + WS_WIN), D}; pg8::StaticOrder So; So.init(MR, INW, F.G, F.bx);
        pg8::EpiBf16B E{(bf16_t*)(F.ws + WS_YB), INW, nullptr, 0, MK_FP8_INPROJ ? 1.0f / (W8_SCALE * H8_SCALE) : 1.0f};
        pg8::gemm_phase<pg8::EpiBf16B, pg8::StaticOrder, true, true, MK_FP8_INPROJ != 0>(F.lds, g, So, E);
    } SEAM(2);
    if (IN(3)) REP(3) {
        for (int u = F.bx; u < 256; u += F.G) { const int x = u & 7, jj = u >> 3; ret_unit(F, (x + 8 * (jj >> 3)) >> 3, (x + 8 * (jj >> 3)) & 7, (jj & 7) >> 2, jj & 3); }
        for (int i = 0; ; ++i) { const int L_ = i * F.G + F.bx; if (L_ >= 2048) break; const int c = L_ % 256, ii = L_ / 256; const int bh = 8 * ii + (c & 7), rp = c >> 3; na_unit(F, bh >> 4, bh & 15, rp); }
        __syncthreads();
    } SEAM(3);
    if (IN(4)) REP(4) { p4_rows(F); } SEAM(4);
    if (IN(5)) REP(5) {
        pg8::StaticOrder So; So.init(NTOK, D, F.G, F.bx);
        { pg8::Gemm g{(const bf16_t*)(F.ws + WS_HB), (const bf16_t*)(F.ws + WS_WPA), D}; pg8::EpiGate<false> E{(bf16_t*)(F.ws + WS_T1), D, (const bf16_t*)(F.ws + WS_YB) + C_GA, INW};
          pg8::gemm_phase<pg8::EpiGate<false>, pg8::StaticOrder, true, true>(F.lds, g, So, E); }
        { pg8::Gemm g{(const bf16_t*)(F.ws + WS_NAOB), (const bf16_t*)(F.ws + WS_WPB), D}; pg8::EpiGate<true> E{(bf16_t*)(F.ws + WS_T1), D, (const bf16_t*)(F.ws + WS_YB) + C_GB, INW};
          pg8::gemm_phase<pg8::EpiGate<true>, pg8::StaticOrder, true, true>(F.lds, g, So, E); }
    } SEAM(5);
    if (IN(6)) REP(6) {
        pg8::Gemm g{(const bf16_t*)(F.ws + WS_T1), (const bf16_t*)(F.ws + WS_WO), D}; pg8::StaticOrder So; So.init(NTOK, D, F.G, F.bx);
        pg8::EpiResid E{F.in[0], F.out, D, (const float*)(F.ws + WS_MOD) + 2 * D, MODW, S};
        pg8::gemm_phase<pg8::EpiResid, pg8::StaticOrder, true, true>(F.lds, g, So, E);
    } SEAM(6);
    if (IN(7)) REP(7) { p7_route(F); } SEAM(7);
    if (IN(8)) REP(8) { load_tp(F, tp); p8_gather(F, tp); } SEAM(8);
    if (IN(9)) REP(9) {
        load_tp(F, tp);
        pg8::Gemm g{(const bf16_t*)(F.ws + WS_XB), (const bf16_t*)(F.ws + WS_WGU), D}; pg8::GroupedOrder So; So.init(16, F.G, F.bx, tp);
        pg8::EpiSwiglu8 E{F.ws + WS_ACTB, FF, F.in[18], F.in[20], FF, 1.0f / (W8_SCALE * H8_SCALE), A8_SCALE};
        pg8::gemm_phase<pg8::EpiSwiglu8, pg8::GroupedOrder, true, true, true>(F.lds, g, So, E);
    } SEAM(9);
    if (IN(10)) REP(10) {
        load_tp(F, tp);
        pg8::Gemm g{(const bf16_t*)(F.ws + WS_ACTB), (const bf16_t*)(F.ws + WS_WDN), FF}; pg8::GroupedOrder So; So.init(8, F.G, F.bx, tp);
        pg8::EpiBf16B E{(bf16_t*)(F.ws + WS_XB), D, F.in[22], D, 1.0f / (W8_SCALE * A8_SCALE)};
        pg8::gemm_phase<pg8::EpiBf16B, pg8::GroupedOrder, true, true, true>(F.lds, g, So, E);
    } SEAM(10);
    if (IN(11)) REP(11) { load_tp(F, tp); p11_final(F, tp); }
#undef IN
#undef SEAM
}
}

namespace nv {
using namespace mk;
constexpr int NSLOT = 544 * 128;
__device__ __forceinline__ float sigmoidf_(float x) { return 1.0f / (1.0f + expf(-x)); }
__device__ __forceinline__ float siluf_(float x) { return x * sigmoidf_(x); }
__device__ __forceinline__ float ldf(const float* p) { return *p; }
__device__ __forceinline__ float ldf(const bf16_t* p) { return __uint_as_float(((unsigned)*p) << 16); }
__device__ __forceinline__ float block_sum256(float v, float* red) {
#pragma unroll
    for (int o = 32; o >= 1; o >>= 1) v += __shfl_xor(v, o);
    __syncthreads();
    if ((threadIdx.x & 63) == 0) red[threadIdx.x >> 6] = v;
    __syncthreads();
    float r = 0.f;
    for (int i = 0; i < (int)(blockDim.x >> 6); ++i) r += red[i];
    return r;
}
__device__ __forceinline__ float block_max256(float v, float* red) {
#pragma unroll
    for (int o = 32; o >= 1; o >>= 1) v = fmaxf(v, __shfl_xor(v, o));
    __syncthreads();
    if ((threadIdx.x & 63) == 0) red[threadIdx.x >> 6] = v;
    __syncthreads();
    float r = red[0];
    for (int i = 1; i < (int)(blockDim.x >> 6); ++i) r = fmaxf(r, red[i]);
    return r;
}
template <class AF, class BF, class EF>
__global__ __launch_bounds__(256) void sgemm128(int N, int K, AF af, BF bf, EF ef) {
    __shared__ float As[16][132];
    __shared__ float Bs[16][132];
    const int tid = threadIdx.x, bm = blockIdx.y * 128, bn = blockIdx.x * 128;
    const float* Bbase = bf(blockIdx.y);
    if (!Bbase) return;
    const int ar = tid >> 1, ak = (tid & 1) * 8;
    const int bk = tid >> 4, bc = (tid & 15) * 8;
    const int ty = tid >> 4, tx = tid & 15;
    float acc[8][8];
#pragma unroll
    for (int i = 0; i < 8; ++i)
#pragma unroll
        for (int j = 0; j < 8; ++j) acc[i][j] = 0.f;
    for (int k0 = 0; k0 < K; k0 += 16) {
        float a8[8]; af.load8(bm + ar, k0 + ak, a8);
        const float4 b0 = *(const float4*)(Bbase + (size_t)(k0 + bk) * N + bn + bc);
        const float4 b1 = *(const float4*)(Bbase + (size_t)(k0 + bk) * N + bn + bc + 4);
        __syncthreads();
#pragma unroll
        for (int q = 0; q < 8; ++q) As[ak + q][ar] = a8[q];
        *(float4*)&Bs[bk][bc] = b0; *(float4*)&Bs[bk][bc + 4] = b1;
        __syncthreads();
#pragma unroll
        for (int kk = 0; kk < 16; ++kk) {
            float a[8], b[8];
            const float4 x0 = *(const float4*)&As[kk][ty * 8], x1 = *(const float4*)&As[kk][ty * 8 + 4];
            const float4 y0 = *(const float4*)&Bs[kk][tx * 8], y1 = *(const float4*)&Bs[kk][tx * 8 + 4];
            a[0] = x0.x; a[1] = x0.y; a[2] = x0.z; a[3] = x0.w; a[4] = x1.x; a[5] = x1.y; a[6] = x1.z; a[7] = x1.w;
            b[0] = y0.x; b[1] = y0.y; b[2] = y0.z; b[3] = y0.w; b[4] = y1.x; b[5] = y1.y; b[6] = y1.z; b[7] = y1.w;
#pragma unroll
            for (int i = 0; i < 8; ++i)
#pragma unroll
                for (int j = 0; j < 8; ++j) acc[i][j] += a[i] * b[j];
        }
    }
#pragma unroll
    for (int i = 0; i < 8; ++i)
#pragma unroll
        for (int j = 0; j < 8; ++j) ef(bm + ty * 8 + i, bn + tx * 8 + j, acc[i][j]);
}
template <class T> struct ARows { const T* A; long lda; __device__ void load8(int m, int k, float (&o)[8]) const {
#pragma unroll
    for (int q = 0; q < 8; ++q) o[q] = ldf(A + (size_t)m * lda + k + q); } };
template <class T> struct AGather { const T* A; long lda; const int* idx; __device__ void load8(int m, int k, float (&o)[8]) const { const int t = idx[m];
#pragma unroll
    for (int q = 0; q < 8; ++q) o[q] = t >= 0 ? ldf(A + (size_t)t * lda + k + q) : 0.f; } };
struct BOne { const float* Bp; __device__ const float* operator()(int) const { return Bp; } };
struct BExpert { const float* Bp; size_t stride; const int* blk_e; __device__ const float* operator()(int tm) const { int e = blk_e[tm]; return e >= 0 ? Bp + (size_t)e * stride : nullptr; } };
template <class TY> struct ERetGate { float* T; const TY* Y; __device__ void operator()(int m, int n, float v) const { T[(size_t)m * D + n] = sigmoidf_(ldf(Y + (size_t)m * INW + C_GA + n)) * v; } };
template <class TY> struct ENaGate { float* T; const TY* Y; __device__ void operator()(int m, int n, float v) const { T[(size_t)m * D + n] += sigmoidf_(ldf(Y + (size_t)m * INW + C_GB + n)) * v; } };
struct EResid { float* out; const float* x; const float* mod; __device__ void operator()(int m, int n, float v) const { out[(size_t)m * D + n] = x[(size_t)m * D + n] + mod[(m / S) * MODW + 2 * D + n] * v; } };
struct EGate { float* G; const float* bias; const int* blk_e; __device__ void operator()(int m, int n, float v) const { int e = blk_e[m >> 7]; G[(size_t)m * FF + n] = v + bias[e * FF + n]; } };
struct EUp { float* ACT; const float* G; const float* bias; const int* blk_e; __device__ void operator()(int m, int n, float v) const { int e = blk_e[m >> 7];
    float gate = fminf(G[(size_t)m * FF + n], 7.0f), up = fminf(fmaxf(v + bias[e * FF + n], -7.0f), 7.0f);
    ACT[(size_t)m * FF + n] = gate * sigmoidf_(1.702f * gate) * (up + 1.0f); } };
struct EDown { float* YS; const float* bias; const int* blk_e; __device__ void operator()(int m, int n, float v) const { int e = blk_e[m >> 7]; YS[(size_t)m * D + n] = v + bias[e * D + n]; } };

__device__ __forceinline__ float rope_val(const bf16_t* hrow, int t, int d) {
    const int axis = d >> 6, half = (d >> 5) & 1, f = d & 31;
    const float pos = (float)(axis == 0 ? (t >> 6) : (t & 63));
    const float inv = powf(10000.0f, -(float)(2 * f) / 64.0f);
    const float ang = pos * inv, cs = cosf(ang), sn = sinf(ang);
    const float x1 = ldf(hrow + axis * 64 + f), x2 = ldf(hrow + axis * 64 + 32 + f);
    return half == 0 ? x1 * cs - x2 * sn : x2 * cs + x1 * sn;
}
__global__ __launch_bounds__(256) void k_ret(const bf16_t* Y, const float* dec_f, const float* dec_b, float* O) {
    __shared__ float qs[16][128];
    __shared__ float ks[64][129];
    __shared__ float wsm[16][64];
    const int t0 = blockIdx.x * 16, h = blockIdx.y, b = blockIdx.z, tid = threadIdx.x;
    const float lgf = -log1pf(expf(-dec_f[h])), lgb = -log1pf(expf(-dec_b[h]));
    for (int idx = tid; idx < 16 * 128; idx += 256) { int qi = idx >> 7, d = idx & 127; qs[qi][d] = rope_val(Y + (size_t)(b * S + t0 + qi) * INW + C_QR + h * 128, t0 + qi, d); }
    float acc[16];
#pragma unroll
    for (int i = 0; i < 16; ++i) acc[i] = 0.f;
    for (int u0 = 0; u0 < L + S; u0 += 64) {
        __syncthreads();
        for (int idx = tid; idx < 64 * 128; idx += 256) { int kk = idx >> 7, d = idx & 127, u = u0 + kk; float val;
            if (u < L) val = ldf(Y + (size_t)(NTOK + b * L + u) * INW + C_KR + h * 128 + d);
            else val = rope_val(Y + (size_t)(b * S + (u - L)) * INW + C_KR + h * 128, u - L, d);
            ks[kk][d] = val; }
        __syncthreads();
#pragma unroll
        for (int i = 0; i < 4; ++i) { int idx = tid + 256 * i, qi = idx >> 6, kk = idx & 63; float dot = 0.f;
            for (int d = 0; d < 128; ++d) dot += qs[qi][d] * ks[kk][d];
            const int t = t0 + qi, u = u0 + kk; float w;
            if (u < L) w = expf((float)(t + 1 + 255 - u) * lgf) + expf((float)(S - t + u) * lgb);
            else { const int s = u - L; w = (s <= t ? expf((float)(t - s) * lgf) : 0.f) + (s >= t ? expf((float)(s - t) * lgb) : 0.f); }
            wsm[qi][kk] = dot * w; }
        __syncthreads();
        for (int kk = 0; kk < 64; ++kk) { const int u = u0 + kk; const size_t row = u < L ? (size_t)(NTOK + b * L + u) : (size_t)(b * S + (u - L));
            const float v = ldf(Y + row * INW + C_VR + h * 256 + tid);
#pragma unroll
            for (int qi = 0; qi < 16; ++qi) acc[qi] += wsm[qi][kk] * v; }
    }
#pragma unroll
    for (int qi = 0; qi < 16; ++qi) O[(size_t)(b * S + t0 + qi) * D + h * 256 + tid] = acc[qi];
}
__global__ __launch_bounds__(256) void k_gn_gate(const float* O, const bf16_t* Y, float* A1) {
    __shared__ float red[8];
    const int m = blockIdx.x, tid = threadIdx.x;
    for (int h = 0; h < RH; ++h) {
        const float o = O[(size_t)m * D + h * 256 + tid];
        const float mu = block_sum256(o, red) * (1.0f / 256.0f);
        const float dlt = o - mu;
        const float var = block_sum256(dlt * dlt, red) * (1.0f / 256.0f);
        const float g = ldf(Y + (size_t)m * INW + C_GR + h * 256 + tid);
        A1[(size_t)m * D + h * 256 + tid] = siluf_(g) * dlt * rsqrtf(var + 1e-5f);
    }
}
__global__ __launch_bounds__(256) void k_na(const bf16_t* Y, const float* rpb, float* NAO) {
    __shared__ float qs[128];
    __shared__ float sc[384];
    __shared__ float red[8];
    __shared__ float part[128];
    const int t = blockIdx.x, h = blockIdx.y, b = blockIdx.z, tid = threadIdx.x, lane = tid & 63, w = tid >> 6;
    const int r = t >> 6, qc = t & 63;
    const int rs = min(max(r - 4, 0), 56), cs = min(max(qc - 8, 0), 48);
    if (tid < 128) qs[tid] = ldf(Y + (size_t)(b * S + t) * INW + C_QN + h * 128 + tid);
    __syncthreads();
    for (int key = w; key < 384; key += 4) {
        size_t row; float bias = 0.f;
        if (key < 128) { const int kr = key >> 4, kc = key & 15; row = (size_t)(b * S + (rs + kr) * 64 + cs + kc); bias = rpb[(h * 15 + (rs + kr - r + 7)) * 31 + (cs + kc - qc + 15)]; }
        else row = (size_t)(NTOK + b * L + (key - 128));
        const bf16_t* kp = Y + row * INW + C_KN + h * 128;
        float d = qs[lane] * ldf(kp + lane) + qs[lane + 64] * ldf(kp + lane + 64);
#pragma unroll
        for (int o = 32; o >= 1; o >>= 1) d += __shfl_xor(d, o);
        if (lane == 0) sc[key] = d + bias;
    }
    __syncthreads();
    float mx = -1e30f;
    for (int i = tid; i < 384; i += 256) mx = fmaxf(mx, sc[i]);
    mx = block_max256(mx, red);
    float sm = 0.f;
    for (int i = tid; i < 384; i += 256) { float e = expf(sc[i] - mx); sc[i] = e; sm += e; }
    sm = block_sum256(sm, red);
    const int d = tid & 127, half = tid >> 7;
    float acc = 0.f;
    for (int key = half * 192; key < half * 192 + 192; ++key) {
        size_t row;
        if (key < 128) { const int kr = key >> 4, kc = key & 15; row = (size_t)(b * S + (rs + kr) * 64 + cs + kc); }
        else row = (size_t)(NTOK + b * L + (key - 128));
        acc += sc[key] * ldf(Y + row * INW + C_VN + h * 128 + d);
    }
    if (half == 1) part[d] = acc;
    __syncthreads();
    if (half == 0) NAO[(size_t)(b * S + t) * D + h * 128 + d] = (acc + part[d]) / sm;
}
__global__ __launch_bounds__(256) void k_route(const float* X1, const float* g, const float* mod, const float* Wr, const float* br, float* H2,
                                               unsigned* counts, int* asg_e, int* asg_pos, float* asg_w) {
    __shared__ float red[8];
    __shared__ float hs[D];
    __shared__ float lg[32];
    const int m = blockIdx.x, tid = threadIdx.x, mr = m / S;
    float v[8]; float ss = 0.f;
#pragma unroll
    for (int i = 0; i < 8; ++i) { v[i] = X1[(size_t)m * D + tid + 256 * i]; ss += v[i] * v[i]; }
    ss = block_sum256(ss, red);
    const float rstd = rsqrtf(ss * (1.0f / D) + 1e-6f);
#pragma unroll
    for (int i = 0; i < 8; ++i) { int k = tid + 256 * i; float y = v[i] * rstd * g[k]; float hv = y * (1.0f + mod[mr * MODW + 4 * D + k]) + mod[mr * MODW + 3 * D + k]; hs[k] = hv; H2[(size_t)m * D + k] = hv; }
    __syncthreads();
    { const int e = tid >> 3, part = tid & 7; float d = 0.f;
      for (int k = part * 256; k < part * 256 + 256; ++k) d += hs[k] * Wr[k * 32 + e];
      d += __shfl_xor(d, 1); d += __shfl_xor(d, 2); d += __shfl_xor(d, 4);
      if (part == 0) lg[e] = d + br[e]; }
    __syncthreads();
    if (tid == 0) {
        int sel[4]; float val[4]; unsigned used = 0u;
#pragma unroll
        for (int k = 0; k < 4; ++k) { int bi = -1; float bv = 0.f;
            for (int e = 0; e < 32; ++e) { if ((used >> e) & 1u) continue; const float x = lg[e]; if (bi < 0 || x > bv) { bi = e; bv = x; } }
            used |= 1u << bi; sel[k] = bi; val[k] = bv; }
        float den = 0.f, ex[4];
#pragma unroll
        for (int k = 0; k < 4; ++k) { ex[k] = expf(val[k] - val[0]); den += ex[k]; }
#pragma unroll
        for (int k = 0; k < 4; ++k) { const unsigned pos = atomicAdd(&counts[sel[k]], 1u); asg_e[m * 4 + k] = sel[k]; asg_pos[m * 4 + k] = (int)pos; asg_w[m * 4 + k] = ex[k] / den; }
    }
}
__global__ void k_route_prefix(const unsigned* counts, int* pstart, int* blk_e, int pad) {
    __shared__ int ps[33];
    if (threadIdx.x == 0) { int a = 0; for (int e = 0; e < 32; ++e) { ps[e] = a; a += ((int)counts[e] + pad - 1) / pad * pad; } ps[32] = a; }
    __syncthreads();
    if (threadIdx.x < 33) pstart[threadIdx.x] = ps[threadIdx.x];
    for (int blk = threadIdx.x; blk < 544; blk += blockDim.x) { int e = -1; for (int q = 0; q < 32; ++q) if (blk * 128 >= ps[q] && blk * 128 < ps[q + 1]) e = q; blk_e[blk] = e; }
}
__global__ void k_route_fill(const int* asg_e, const int* asg_pos, const int* pstart, int* asg_slot, int* slot_tok) {
    const int a = blockIdx.x * blockDim.x + threadIdx.x;
    if (a < NTOK * 4) { const int slot = pstart[asg_e[a]] + asg_pos[a]; asg_slot[a] = slot; if (slot_tok) slot_tok[slot] = a >> 2; }
}
template <class T> __global__ __launch_bounds__(256) void k_final(float* out, const T* YS, const int* asg_slot, const float* asg_w, const float* mod, const float* fg) {
    __shared__ float red[8];
    const int m = blockIdx.x, tid = threadIdx.x, mr = m / S;
    int sl[4]; float w[4];
#pragma unroll
    for (int k = 0; k < 4; ++k) { sl[k] = asg_slot[m * 4 + k]; w[k] = asg_w[m * 4 + k]; }
    float v[8]; float ss = 0.f;
#pragma unroll
    for (int i = 0; i < 8; ++i) { const int n = tid + 256 * i; float y = 0.f;
#pragma unroll
        for (int k = 0; k < 4; ++k) y += w[k] * ldf(YS + (size_t)sl[k] * D + n);
        v[i] = out[(size_t)m * D + n] + mod[mr * MODW + 5 * D + n] * y; ss += v[i] * v[i]; }
    ss = block_sum256(ss, red);
    const float rstd = rsqrtf(ss * (1.0f / D) + 1e-6f);
#pragma unroll
    for (int i = 0; i < 8; ++i) { const int n = tid + 256 * i; out[(size_t)m * D + n] = v[i] * rstd * fg[n]; }
}
}

extern "C" void kernel_launch(void* const* d_in, const int* in_sizes, int n_in, void* d_out, int out_size, void* d_ws, size_t ws_size, hipStream_t stream) {
    using namespace mk;
    (void)in_sizes; (void)n_in; (void)out_size; (void)ws_size;
    static int grid = 0;
    if (grid == 0) {
        int dev = 0, cus = 0, per_cu = 0;
        if (hipGetDevice(&dev) != hipSuccess || hipDeviceGetAttribute(&cus, hipDeviceAttributeMultiprocessorCount, dev) != hipSuccess) { grid = -1; return; }
        if (hipFuncSetAttribute((const void*)mk_fwd, hipFuncAttributeMaxDynamicSharedMemorySize, LDS_BYTES) != hipSuccess) { fprintf(stderr, "kernel_launch: hipFuncSetAttribute failed\n"); grid = -1; return; }
        if (hipOccupancyMaxActiveBlocksPerMultiprocessor(&per_cu, (const void*)mk_fwd, 512, LDS_BYTES) != hipSuccess || per_cu < 1) fprintf(stderr, "kernel_launch: occupancy query reports %d\n", per_cu);
        (void)hipGetLastError();
        grid = cus;
    }
    if (grid < 0) return;
    unsigned char* ws = (unsigned char*)d_ws;
    (void)hipMemsetAsync(ws + WS_CTL, 0, CTL_ZERO_BYTES, stream);
    Args a{};
    for (int i = 0; i < 24; ++i) a.in[i] = (const float*)d_in[i];
    a.out = (float*)d_out; a.ws = ws;
    auto run = [&](int lo, int hi) { a.ph_lo = lo; a.ph_hi = hi; hipLaunchKernelGGL(mk_fwd, dim3(grid), dim3(512), LDS_BYTES, stream, a); };
#if MK_STAGE >= 7
    run(0, NPH);
#else
    using namespace nv;
    const float* x = a.in[0]; float* out = a.out; const float* mod = (const float*)(ws + WS_MOD);
    const bf16_t* YB = (const bf16_t*)(ws + WS_YB);
    float* O = (float*)(ws + 104 * MiB); float* NAO = (float*)(ws + 232 * MiB); float* T1 = (float*)(ws + 360 * MiB); float* H2 = (float*)(ws + 488 * MiB); float* A1 = (float*)(ws + 616 * MiB);
    float* G = (float*)(ws + 940 * MiB); float* ACT = (float*)(ws + 1484 * MiB); float* YS = G;
    int* pstart = (int*)(ws + 8 * MiB); int* blk_e = (int*)(ws + 9 * MiB); int* asg_slot = (int*)(ws + 10 * MiB); int* slot_tok = (int*)(ws + 11 * MiB);
    unsigned* counts = (unsigned*)(ws + WS_CTL) + CW_CNT; int* asg_e = (int*)(ws + WS_ASG_E); int* asg_pos = (int*)(ws + WS_ASG_POS); float* asg_w = (float*)(ws + WS_ASG_W);
    run(0, 1); run(1, 2); run(2, 3);
#if MK_STAGE >= 2
    run(3, 4); run(4, 5);
#else
    hipLaunchKernelGGL(k_ret, dim3(S / 16, RH, NB), dim3(256), 0, stream, YB, a.in[12], a.in[13], O);
    hipLaunchKernelGGL(k_gn_gate, dim3(NTOK), dim3(256), 0, stream, O, YB, A1);
    hipLaunchKernelGGL(k_na, dim3(S, NH, NB), dim3(256), 0, stream, YB, a.in[14], NAO);
#endif
#if MK_STAGE >= 3
    run(5, 6); run(6, 7);
#else
#if MK_STAGE >= 2
    hipLaunchKernelGGL((sgemm128<ARows<bf16_t>, BOne, ERetGate<bf16_t>>), dim3(D / 128, NTOK / 128), dim3(256), 0, stream, D, D, ARows<bf16_t>{(const bf16_t*)(ws + WS_HB), D}, BOne{a.in[9]}, ERetGate<bf16_t>{T1, YB});
    hipLaunchKernelGGL((sgemm128<ARows<bf16_t>, BOne, ENaGate<bf16_t>>), dim3(D / 128, NTOK / 128), dim3(256), 0, stream, D, D, ARows<bf16_t>{(const bf16_t*)(ws + WS_NAOB), D}, BOne{a.in[10]}, ENaGate<bf16_t>{T1, YB});
#else
    hipLaunchKernelGGL((sgemm128<ARows<float>, BOne, ERetGate<bf16_t>>), dim3(D / 128, NTOK / 128), dim3(256), 0, stream, D, D, ARows<float>{A1, D}, BOne{a.in[9]}, ERetGate<bf16_t>{T1, YB});
    hipLaunchKernelGGL((sgemm128<ARows<float>, BOne, ENaGate<bf16_t>>), dim3(D / 128, NTOK / 128), dim3(256), 0, stream, D, D, ARows<float>{NAO, D}, BOne{a.in[10]}, ENaGate<bf16_t>{T1, YB});
#endif
    hipLaunchKernelGGL((sgemm128<ARows<float>, BOne, EResid>), dim3(D / 128, NTOK / 128), dim3(256), 0, stream, D, D, ARows<float>{T1, D}, BOne{a.in[11]}, EResid{out, x, mod});
#endif
#if MK_STAGE >= 4
    run(7, 8);
#else
    hipLaunchKernelGGL(k_route, dim3(NTOK), dim3(256), 0, stream, out, a.in[7], mod, a.in[15], a.in[16], H2, counts, asg_e, asg_pos, asg_w);
#endif
#if MK_STAGE >= 5
    run(8, 9); run(9, 10); run(10, 11);
#else
    (void)hipMemsetAsync(slot_tok, 0xFF, (size_t)NSLOT * 4, stream);
    hipLaunchKernelGGL(k_route_prefix, dim3(1), dim3(64), 0, stream, counts, pstart, blk_e, 128);
    hipLaunchKernelGGL(k_route_fill, dim3(NTOK * 4 / 256), dim3(256), 0, stream, asg_e, asg_pos, pstart, asg_slot, slot_tok);
#if MK_STAGE >= 4
    hipLaunchKernelGGL((sgemm128<AGather<bf16_t>, BExpert, EGate>), dim3(FF / 128, NSLOT / 128), dim3(256), 0, stream, FF, D, AGather<bf16_t>{(const bf16_t*)(ws + WS_HB), D, slot_tok}, BExpert{a.in[17], (size_t)D * FF, blk_e}, EGate{G, a.in[18], blk_e});
    hipLaunchKernelGGL((sgemm128<AGather<bf16_t>, BExpert, EUp>), dim3(FF / 128, NSLOT / 128), dim3(256), 0, stream, FF, D, AGather<bf16_t>{(const bf16_t*)(ws + WS_HB), D, slot_tok}, BExpert{a.in[19], (size_t)D * FF, blk_e}, EUp{ACT, G, a.in[20], blk_e});
#else
    hipLaunchKernelGGL((sgemm128<AGather<float>, BExpert, EGate>), dim3(FF / 128, NSLOT / 128), dim3(256), 0, stream, FF, D, AGather<float>{H2, D, slot_tok}, BExpert{a.in[17], (size_t)D * FF, blk_e}, EGate{G, a.in[18], blk_e});
    hipLaunchKernelGGL((sgemm128<AGather<float>, BExpert, EUp>), dim3(FF / 128, NSLOT / 128), dim3(256), 0, stream, FF, D, AGather<float>{H2, D, slot_tok}, BExpert{a.in[19], (size_t)D * FF, blk_e}, EUp{ACT, G, a.in[20], blk_e});
#endif
    hipLaunchKernelGGL((sgemm128<ARows<float>, BExpert, EDown>), dim3(D / 128, NSLOT / 128), dim3(256), 0, stream, D, FF, ARows<float>{ACT, FF}, BExpert{a.in[21], (size_t)FF * D, blk_e}, EDown{YS, a.in[22], blk_e});
#endif
#if MK_STAGE >= 6
    run(11, 12);
#elif MK_STAGE >= 5
    hipLaunchKernelGGL(k_route_prefix, dim3(1), dim3(64), 0, stream, counts, pstart, blk_e, 256);
    hipLaunchKernelGGL(k_route_fill, dim3(NTOK * 4 / 256), dim3(256), 0, stream, asg_e, asg_pos, pstart, asg_slot, (int*)nullptr);
    hipLaunchKernelGGL(k_final<bf16_t>, dim3(NTOK), dim3(256), 0, stream, out, (const bf16_t*)(ws + WS_XB), asg_slot, asg_w, mod, a.in[23]);
#else
    hipLaunchKernelGGL(k_final<float>, dim3(NTOK), dim3(256), 0, stream, out, YS, asg_slot, asg_w, mod, a.in[23]);
#endif
#endif
}
```

```cpp
#include <hip/hip_runtime.h>
#include <stdint.h>
#include <stdio.h>

#define MK_REPMASK 0x0
#ifndef MK_SPLIT
#define MK_SPLIT 1
#endif
#ifndef MK_SPLIT_NCG
#define MK_SPLIT_NCG 10
#endif
#ifndef MK_SPLIT_A
#define MK_SPLIT_A 11520
#endif
#ifndef MK_TPROBE_FINE
#define MK_TPROBE_FINE 1
#endif
#ifndef MK_TPROBE
#define MK_TPROBE -1
#endif
#ifndef MK_FP8_PROJ
#define MK_FP8_PROJ 1
#endif
#ifndef MK_FP8_INPROJ
#define MK_FP8_INPROJ 1
#endif

namespace pg8 {
#define PG8_LAS __attribute__((address_space(3)))
__device__ __forceinline__ int lane_id() { int l; asm volatile("v_mbcnt_lo_u32_b32 %0, -1, 0\n\tv_mbcnt_hi_u32_b32 %0, -1, %0" : "=v"(l)); return l; }
typedef unsigned short bf16_t;
typedef short bf16x8 __attribute__((ext_vector_type(8)));
typedef float f32x4 __attribute__((ext_vector_type(4)));
typedef unsigned u32x4 __attribute__((ext_vector_type(4)));
typedef unsigned u32x2 __attribute__((ext_vector_type(2)));
constexpr int BM = 256, BK = 64, HALF = 128, HTB = HALF * BK * 2, STAGE_BYTES = 8 * HTB, NXCD = 8, WGM = 8;

__host__ __device__ __forceinline__ int lds_byte(int r, int c) { const int st = (r >> 4) * 2 + (c >> 5), rr = r & 15, cc = c & 31, ob = rr * 64 + cc * 2; return st * 1024 + (ob ^ (((ob >> 9) & 1) << 5)); }
__host__ __device__ __forceinline__ void stage_rc(int b, int& R, int& C) { const int st = b / 1024, sb = b % 1024, swz = sb ^ (((sb >> 9) & 1) << 5); R = (st >> 1) * 16 + swz / 64; C = (st & 1) * 32 + (swz % 64) / 2; }
__host__ __device__ __forceinline__ int perm32(int rho) { const int n = rho >> 4, i = rho & 15; return 8 * (i >> 2) + 4 * n + (i & 3); }

struct Unit { int pm, pn, pb, e, half; };
struct Gemm { const bf16_t* A; const bf16_t* Bt; int K; const bf16_t* A2; const bf16_t* Bt2; const unsigned short* list; };

struct StaticOrder {
    int nM, nN, nwg, G, c;
    __device__ void init(int M, int N, int G_, int c_) { nM = M / BM; nN = N / BM; nwg = nM * nN; G = G_; c = c_; }
    __device__ bool next(int i, Unit& u) const {
        const long L = (long)i * G + c; if (L >= nwg) return false;
        int wgid = (int)L; { const int q = nwg / NXCD, r = nwg % NXCD, xcd = wgid % NXCD, off = wgid / NXCD; wgid = (xcd < r ? xcd * (q + 1) : r * (q + 1) + (xcd - r) * q) + off; }
        const int nig = WGM * nN, gid = wgid / nig, fm = gid * WGM, gsz = (nM - fm) < WGM ? (nM - fm) : WGM;
        u.pm = fm + ((wgid % nig) % gsz); u.pn = (wgid % nig) / gsz; u.pb = u.pn; u.e = 0; u.half = 0; return true;
    }
};
struct ChainOrder : StaticOrder {
    __device__ bool next(int i, Unit& u) const { if (!StaticOrder::next(i >> 1, u)) return false; u.half = i & 1; return true; }
};
struct GroupedOrder {
    int NP, G, c, U, nu; const PG8_LAS int* tp; PG8_LAS int* ul;
    __device__ bool calc(int i, Unit& u) const {
        const int L = i * G + c; if (L >= U) return false;
        int w; { const int q = U / NXCD, r = U % NXCD, xcd = L % NXCD, off = L / NXCD; w = (xcd < r ? xcd * (q + 1) : r * (q + 1) + (xcd - r) * q) + off; }
        int e = 0; while (e < 31 && NP * tp[e + 1] <= w) ++e;
        const int local = w - NP * tp[e], nrt = tp[e + 1] - tp[e];
        const int pn = local / nrt, rt = tp[e] + (local - pn * nrt);
        u.pm = rt; u.pn = pn; u.pb = e * NP + pn; u.e = e; u.half = 0; return true;
    }
    __device__ void init(int NP_, int G_, int c_, const PG8_LAS int* tp_, PG8_LAS int* ul_, int tid_) { NP = NP_; G = G_; c = c_; tp = tp_; ul = ul_; U = __builtin_amdgcn_readfirstlane(NP_ * tp_[32]);
        nu = U > c ? (U - c + G - 1) / G : 0;
        __syncthreads();
        if (tid_ < nu && tid_ < 32) { Unit u; calc(tid_, u); ul[4 * tid_] = u.pm; ul[4 * tid_ + 1] = u.pn; ul[4 * tid_ + 2] = u.pb; ul[4 * tid_ + 3] = u.e; }
        __syncthreads(); }
    __device__ bool next(int i, Unit& u) const {
        if (i >= nu) return false;
        u.pm = __builtin_amdgcn_readfirstlane(ul[4 * i]); u.pn = __builtin_amdgcn_readfirstlane(ul[4 * i + 1]); u.pb = __builtin_amdgcn_readfirstlane(ul[4 * i + 2]); u.e = __builtin_amdgcn_readfirstlane(ul[4 * i + 3]); u.half = 0; return true;
    }
};

__device__ __forceinline__ unsigned cvt_pk_bf16(float lo, float hi) { unsigned r; asm volatile("v_cvt_pk_bf16_f32 %0, %1, %2" : "=v"(r) : "v"(lo), "v"(hi)); return r; }
__device__ __forceinline__ float bf_lo(unsigned w) { return __uint_as_float(w << 16); }
__device__ __forceinline__ float bf_hi(unsigned w) { return __uint_as_float(w & 0xffff0000u); }
__device__ __forceinline__ float sigm(float x) { return __builtin_amdgcn_rcpf(1.0f + __expf(-x)); }
__device__ __forceinline__ float clamp448(float v) { return fminf(fmaxf(v, -448.0f), 448.0f); }
typedef float f32x2d __attribute__((ext_vector_type(2)));
__device__ __forceinline__ void dec8(unsigned w, float (&o)[4]) { const f32x2d lo = __builtin_amdgcn_cvt_pk_f32_fp8((int)w, false), hi = __builtin_amdgcn_cvt_pk_f32_fp8((int)w, true); o[0] = lo.x; o[1] = lo.y; o[2] = hi.x; o[3] = hi.y; }

struct EpiBf16B {
    static constexpr bool PERM = true, CHAIN = false;
    bf16_t* O; int ldc; const float* bias; int bias_stride; float scale;
    __device__ __forceinline__ void operator()(const f32x4 (&acc)[2][2][4][2], const Unit& u, int wr, int wc, int fr, int fq) const {
        asm volatile("" : "+v"(fr), "+v"(fq));
        const int row0 = u.pm * BM + wr * 64 + fr, col0 = u.pn * BM + wc * 32 + 8 * fq;
        f32x4 bv[2][2];
#pragma unroll
        for (int bj = 0; bj < 2; ++bj)
#pragma unroll
            for (int n = 0; n < 2; ++n) bv[bj][n] = bias ? *(const f32x4*)(bias + (size_t)u.e * bias_stride + col0 + bj * HALF + 4 * n) : (f32x4){0.f, 0.f, 0.f, 0.f};
#pragma unroll
        for (int ai = 0; ai < 2; ++ai)
#pragma unroll
            for (int m = 0; m < 4; ++m) { bf16_t* rowp = O + (size_t)(row0 + ai * HALF + m * 16) * ldc + col0;
#pragma unroll
                for (int bj = 0; bj < 2; ++bj) { const f32x4 v0 = acc[ai][bj][m][0] * scale + bv[bj][0], v1 = acc[ai][bj][m][1] * scale + bv[bj][1];
                    u32x4 w; w.x = cvt_pk_bf16(v0[0], v0[1]); w.y = cvt_pk_bf16(v0[2], v0[3]); w.z = cvt_pk_bf16(v1[0], v1[1]); w.w = cvt_pk_bf16(v1[2], v1[3]);
                    *(u32x4*)(rowp + bj * HALF) = w; } }
    }
};
struct EpiInProj {
    static constexpr bool PERM = true, CHAIN = false;
    bf16_t* O; int ldc; float scale; int rope_pn, rope_pm; unsigned char* G8; float gscale; bf16_t* KV;
    __device__ __forceinline__ void operator()(const f32x4 (&acc)[2][2][4][2], const Unit& u, int wr, int wc, int fr, int fq) const {
        asm volatile("" : "+v"(fr), "+v"(fq));
        const int row0 = u.pm * BM + wr * 64 + fr, col0 = u.pn * BM + wc * 32 + 8 * fq;
        const bool rope = u.pn < rope_pn && u.pm < rope_pm;
        const int gt = u.pn >= 48 ? u.pn - 40 : -1;
        if (gt >= 0) {
            if (u.pm >= rope_pm) return;
            const float gs = scale * gscale; const int gc0 = gt * BM + wc * 32 + 8 * fq;
#pragma unroll
            for (int ai = 0; ai < 2; ++ai)
#pragma unroll
                for (int m = 0; m < 4; ++m) { unsigned char* rowp = G8 + (size_t)(row0 + ai * HALF + m * 16) * 6144 + gc0;
#pragma unroll
                    for (int bj = 0; bj < 2; ++bj) { const f32x4 v0 = acc[ai][bj][m][0] * gs, v1 = acc[ai][bj][m][1] * gs; u32x2 w8;
                        int p = __builtin_amdgcn_cvt_pk_fp8_f32(clamp448(v0[0]), clamp448(v0[1]), 0, false); p = __builtin_amdgcn_cvt_pk_fp8_f32(clamp448(v0[2]), clamp448(v0[3]), p, true); w8.x = (unsigned)p;
                        p = __builtin_amdgcn_cvt_pk_fp8_f32(clamp448(v1[0]), clamp448(v1[1]), 0, false); p = __builtin_amdgcn_cvt_pk_fp8_f32(clamp448(v1[2]), clamp448(v1[3]), p, true); w8.y = (unsigned)p;
                        *(u32x2*)(rowp + bj * HALF) = w8; } }
            return; }
        const bool kv = u.pn >= 32 && u.pn < 48;
        const int kb_ = u.pm < 64 ? u.pm >> 4 : u.pm - 64, ktok0 = u.pm < 64 ? (u.pm & 15) * 256 : 4096;
        bf16_t* kvb = KV + ((size_t)((kb_ * 16 + 2 * (u.pn & 7)) * 4352 + ktok0) * 256 + (u.pn >= 40 ? 128 : 0));
        const size_t bjs = kv ? (size_t)4352 * 256 : (size_t)HALF;
        int fqz = fq;
        float invrev[4];
#pragma unroll
        for (int i = 0; i < 4; ++i) invrev[i] = __builtin_amdgcn_exp2f(-(float)(16 * (wc & 1) + 4 * fqz + i) * (13.287712379549449f / 32.0f)) * 0.15915494309189535f;
#pragma unroll
        for (int ai = 0; ai < 2; ++ai)
#pragma unroll
            for (int m = 0; m < 4; ++m) { bf16_t* rowp = kv ? kvb + (size_t)(wr * 64 + fr + ai * HALF + m * 16) * 256 + wc * 32 + 8 * fq : O + (size_t)(row0 + ai * HALF + m * 16) * ldc + col0;
                float cs[4], sn[4];
                if (rope) { const float pos = (float)((wc >> 1) ? (m * 16 + fr) : ((u.pm * 4 + ai * 2 + wr) & 63));
#pragma unroll
                    for (int i = 0; i < 4; ++i) { const float rev = pos * invrev[i]; cs[i] = __builtin_amdgcn_cosf(rev); sn[i] = __builtin_amdgcn_sinf(rev); } }
#pragma unroll
                for (int bj = 0; bj < 2; ++bj) { f32x4 v0 = acc[ai][bj][m][0] * scale, v1 = acc[ai][bj][m][1] * scale;
                    if (rope) { const f32x4 a = v0, b = v1;
                        v0[0] = a[0] * cs[0] - a[1] * sn[0]; v0[1] = a[1] * cs[0] + a[0] * sn[0]; v0[2] = a[2] * cs[1] - a[3] * sn[1]; v0[3] = a[3] * cs[1] + a[2] * sn[1];
                        v1[0] = b[0] * cs[2] - b[1] * sn[2]; v1[1] = b[1] * cs[2] + b[0] * sn[2]; v1[2] = b[2] * cs[3] - b[3] * sn[3]; v1[3] = b[3] * cs[3] + b[2] * sn[3]; }
                    u32x4 w; w.x = cvt_pk_bf16(v0[0], v0[1]); w.y = cvt_pk_bf16(v0[2], v0[3]); w.z = cvt_pk_bf16(v1[0], v1[1]); w.w = cvt_pk_bf16(v1[2], v1[3]);
                    *(u32x4*)(rowp + (size_t)bj * bjs) = w; } }
    }
};
template <bool ADD, bool OUT8 = false> struct EpiGate {
    static constexpr bool PERM = true, CHAIN = false;
    bf16_t* T; int ldc; const bf16_t* gate; int gld; float scale; unsigned char* O8; float out_scale;
    __device__ __forceinline__ void operator()(const f32x4 (&acc)[2][2][4][2], const Unit& u, int wr, int wc, int fr, int fq) const {
        asm volatile("" : "+v"(fr), "+v"(fq));
        const int row0 = u.pm * BM + wr * 64 + fr, col0 = u.pn * BM + wc * 32 + 8 * fq;
#pragma unroll
        for (int ai = 0; ai < 2; ++ai)
#pragma unroll
            for (int m = 0; m < 4; ++m) { const size_t r = (size_t)(row0 + ai * HALF + m * 16); bf16_t* rowp = T + r * ldc + col0; const bf16_t* gp = gate + r * gld + col0;
#pragma unroll
                for (int bj = 0; bj < 2; ++bj) { const u32x4 g = *(const u32x4*)(gp + bj * HALF); const f32x4 a0 = acc[ai][bj][m][0] * scale, a1 = acc[ai][bj][m][1] * scale;
                    float o[8];
                    o[0] = sigm(bf_lo(g.x)) * a0[0]; o[1] = sigm(bf_hi(g.x)) * a0[1]; o[2] = sigm(bf_lo(g.y)) * a0[2]; o[3] = sigm(bf_hi(g.y)) * a0[3];
                    o[4] = sigm(bf_lo(g.z)) * a1[0]; o[5] = sigm(bf_hi(g.z)) * a1[1]; o[6] = sigm(bf_lo(g.w)) * a1[2]; o[7] = sigm(bf_hi(g.w)) * a1[3];
                    if (ADD) { const u32x4 t = *(const u32x4*)(rowp + bj * HALF);
                        o[0] += bf_lo(t.x); o[1] += bf_hi(t.x); o[2] += bf_lo(t.y); o[3] += bf_hi(t.y); o[4] += bf_lo(t.z); o[5] += bf_hi(t.z); o[6] += bf_lo(t.w); o[7] += bf_hi(t.w); }
                    if (OUT8) { u32x2 w8; int p = __builtin_amdgcn_cvt_pk_fp8_f32(clamp448(o[0] * out_scale), clamp448(o[1] * out_scale), 0, false); p = __builtin_amdgcn_cvt_pk_fp8_f32(clamp448(o[2] * out_scale), clamp448(o[3] * out_scale), p, true); w8.x = (unsigned)p;
                        p = __builtin_amdgcn_cvt_pk_fp8_f32(clamp448(o[4] * out_scale), clamp448(o[5] * out_scale), 0, false); p = __builtin_amdgcn_cvt_pk_fp8_f32(clamp448(o[6] * out_scale), clamp448(o[7] * out_scale), p, true); w8.y = (unsigned)p;
                        *(u32x2*)(O8 + r * ldc + col0 + bj * HALF) = w8; }
                    else { u32x4 w; w.x = cvt_pk_bf16(o[0], o[1]); w.y = cvt_pk_bf16(o[2], o[3]); w.z = cvt_pk_bf16(o[4], o[5]); w.w = cvt_pk_bf16(o[6], o[7]);
                        *(u32x4*)(rowp + bj * HALF) = w; } } }
    }
};
struct EpiMerge8 {
    static constexpr bool PERM = true, CHAIN = true;
    unsigned char* O8; int ldc; const unsigned char* ga; const unsigned char* gb; int gld; float scale, out_scale, ginv;
    __device__ __forceinline__ void mid(f32x4 (&acc)[2][2][4][2], const Unit& u, int wr, int wc, int fr, int fq) const {
        asm volatile("" : "+v"(fr), "+v"(fq));
        const int row0 = u.pm * BM + wr * 64 + fr, col0 = u.pn * BM + wc * 32 + 8 * fq;
#pragma unroll
        for (int ai = 0; ai < 2; ++ai)
#pragma unroll
            for (int m = 0; m < 4; ++m) { const size_t r = (size_t)(row0 + ai * HALF + m * 16);
#pragma unroll
                for (int bj = 0; bj < 2; ++bj) { const u32x2 a = *(const u32x2*)(ga + r * gld + col0 + bj * HALF), b = *(const u32x2*)(gb + r * gld + col0 + bj * HALF);
                    float av[8], bv[8]; { float t4[4]; dec8(a.x, t4); av[0] = t4[0]; av[1] = t4[1]; av[2] = t4[2]; av[3] = t4[3]; dec8(a.y, t4); av[4] = t4[0]; av[5] = t4[1]; av[6] = t4[2]; av[7] = t4[3];
                        dec8(b.x, t4); bv[0] = t4[0]; bv[1] = t4[1]; bv[2] = t4[2]; bv[3] = t4[3]; dec8(b.y, t4); bv[4] = t4[0]; bv[5] = t4[1]; bv[6] = t4[2]; bv[7] = t4[3]; }
#pragma unroll
                    for (int t = 0; t < 8; ++t) {
                        const float r0 = (1.0f + __expf(-bv[t] * ginv)) * __builtin_amdgcn_rcpf(1.0f + __expf(-av[t] * ginv));
                        acc[ai][bj][m][t >> 2][t & 3] *= r0; } } }
    }
    __device__ __forceinline__ void operator()(const f32x4 (&acc)[2][2][4][2], const Unit& u, int wr, int wc, int fr, int fq) const {
        asm volatile("" : "+v"(fr), "+v"(fq));
        const int row0 = u.pm * BM + wr * 64 + fr, col0 = u.pn * BM + wc * 32 + 8 * fq; const float sc = scale * out_scale;
#pragma unroll
        for (int ai = 0; ai < 2; ++ai)
#pragma unroll
            for (int m = 0; m < 4; ++m) { const size_t r = (size_t)(row0 + ai * HALF + m * 16);
#pragma unroll
                for (int bj = 0; bj < 2; ++bj) { const u32x2 b = *(const u32x2*)(gb + r * gld + col0 + bj * HALF); float bv[8], o[8]; { float t4[4]; dec8(b.x, t4); bv[0] = t4[0]; bv[1] = t4[1]; bv[2] = t4[2]; bv[3] = t4[3]; dec8(b.y, t4); bv[4] = t4[0]; bv[5] = t4[1]; bv[6] = t4[2]; bv[7] = t4[3]; }
#pragma unroll
                    for (int t = 0; t < 8; ++t) o[t] = clamp448(acc[ai][bj][m][t >> 2][t & 3] * sc * __builtin_amdgcn_rcpf(1.0f + __expf(-bv[t] * ginv)));
                    u32x2 w8; int p = __builtin_amdgcn_cvt_pk_fp8_f32(o[0], o[1], 0, false); p = __builtin_amdgcn_cvt_pk_fp8_f32(o[2], o[3], p, true); w8.x = (unsigned)p;
                    p = __builtin_amdgcn_cvt_pk_fp8_f32(o[4], o[5], 0, false); p = __builtin_amdgcn_cvt_pk_fp8_f32(o[6], o[7], p, true); w8.y = (unsigned)p;
                    *(u32x2*)(O8 + r * ldc + col0 + bj * HALF) = w8; } }
    }
};
struct EpiResid {
    static constexpr bool PERM = true, CHAIN = false;
    const float* x; bf16_t* out; int ldc; const float* gvec; int gstride; int rows_per_batch; float scale;
    __device__ __forceinline__ void operator()(const f32x4 (&acc)[2][2][4][2], const Unit& u, int wr, int wc, int fr, int fq) const {
        asm volatile("" : "+v"(fr), "+v"(fq));
        const int row0 = u.pm * BM + wr * 64 + fr, col0 = u.pn * BM + wc * 32 + 8 * fq;
        const float* gp = gvec + (size_t)((u.pm * BM) / rows_per_batch) * gstride + col0;
        f32x4 gv[2][2];
#pragma unroll
        for (int bj = 0; bj < 2; ++bj)
#pragma unroll
            for (int n = 0; n < 2; ++n) gv[bj][n] = *(const f32x4*)(gp + bj * HALF + 4 * n) * scale;
#pragma unroll
        for (int ai = 0; ai < 2; ++ai)
#pragma unroll
            for (int m = 0; m < 4; ++m) { const size_t off = (size_t)(row0 + ai * HALF + m * 16) * ldc + col0;
#pragma unroll
                for (int bj = 0; bj < 2; ++bj) { const f32x4 x0 = __builtin_nontemporal_load((const f32x4*)(x + off + bj * HALF)), x1 = __builtin_nontemporal_load((const f32x4*)(x + off + bj * HALF + 4));
                    const f32x4 r0 = x0 + gv[bj][0] * acc[ai][bj][m][0], r1 = x1 + gv[bj][1] * acc[ai][bj][m][1];
                    u32x4 w; w.x = cvt_pk_bf16(r0[0], r0[1]); w.y = cvt_pk_bf16(r0[2], r0[3]); w.z = cvt_pk_bf16(r1[0], r1[1]); w.w = cvt_pk_bf16(r1[2], r1[3]);
                    *(u32x4*)(out + off + bj * HALF) = w; } }
    }
};
struct EpiSwiglu {
    static constexpr bool PERM = true, CHAIN = false;
    bf16_t* O; int ldc; const float* bgate; const float* bup; int bias_stride;
    __device__ __forceinline__ void operator()(const f32x4 (&acc)[2][2][4][2], const Unit& u, int wr, int wc, int fr, int fq) const {
        asm volatile("" : "+v"(fr), "+v"(fq));
        const int row0 = u.pm * BM + wr * 64 + fr, col0 = u.pn * HALF + wc * 32 + 8 * fq;
        f32x4 bg[2], bu[2];
#pragma unroll
        for (int n = 0; n < 2; ++n) { bg[n] = *(const f32x4*)(bgate + (size_t)u.e * bias_stride + col0 + 4 * n); bu[n] = *(const f32x4*)(bup + (size_t)u.e * bias_stride + col0 + 4 * n); }
#pragma unroll
        for (int ai = 0; ai < 2; ++ai)
#pragma unroll
            for (int m = 0; m < 4; ++m) { float o[8];
#pragma unroll
                for (int n = 0; n < 2; ++n)
#pragma unroll
                    for (int j = 0; j < 4; ++j) { const float gt = fminf(acc[ai][0][m][n][j] + bg[n][j], 7.0f), up = fminf(fmaxf(acc[ai][1][m][n][j] + bu[n][j], -7.0f), 7.0f);
                        o[4 * n + j] = gt * sigm(1.702f * gt) * (up + 1.0f); }
                u32x4 w; w.x = cvt_pk_bf16(o[0], o[1]); w.y = cvt_pk_bf16(o[2], o[3]); w.z = cvt_pk_bf16(o[4], o[5]); w.w = cvt_pk_bf16(o[6], o[7]);
                *(u32x4*)(O + (size_t)(row0 + ai * HALF + m * 16) * ldc + col0) = w; }
    }
};

struct EpiSwiglu8 {
    static constexpr bool PERM = true, CHAIN = false;
    unsigned char* O; int ldc; const float* bgate; const float* bup; int bias_stride; float in_scale, out_scale;
    __device__ __forceinline__ void operator()(const f32x4 (&acc)[2][2][4][2], const Unit& u, int wr, int wc, int fr, int fq) const {
        asm volatile("" : "+v"(fr), "+v"(fq));
        const int row0 = u.pm * BM + wr * 64 + fr, col0 = u.pn * HALF + wc * 32 + 8 * fq;
        f32x4 bg[2], bu[2];
#pragma unroll
        for (int n = 0; n < 2; ++n) { bg[n] = *(const f32x4*)(bgate + (size_t)u.e * bias_stride + col0 + 4 * n); bu[n] = *(const f32x4*)(bup + (size_t)u.e * bias_stride + col0 + 4 * n); }
#pragma unroll
        for (int ai = 0; ai < 2; ++ai)
#pragma unroll
            for (int m = 0; m < 4; ++m) { float o[8];
#pragma unroll
                for (int n = 0; n < 2; ++n)
#pragma unroll
                    for (int j = 0; j < 4; ++j) { const float gt = fminf(acc[ai][0][m][n][j] * in_scale + bg[n][j], 7.0f), up = fminf(fmaxf(acc[ai][1][m][n][j] * in_scale + bu[n][j], -7.0f), 7.0f);
                        const float sg = __builtin_amdgcn_rcpf(1.0f + __builtin_amdgcn_exp2f(gt * (-1.702f * 1.4426950408889634f)));
                        o[4 * n + j] = (gt * sg) * (up * out_scale + out_scale); }
                u32x2 w; int p = __builtin_amdgcn_cvt_pk_fp8_f32(o[0], o[1], 0, false); p = __builtin_amdgcn_cvt_pk_fp8_f32(o[2], o[3], p, true); w.x = (unsigned)p;
                p = __builtin_amdgcn_cvt_pk_fp8_f32(o[4], o[5], 0, false); p = __builtin_amdgcn_cvt_pk_fp8_f32(o[6], o[7], p, true); w.y = (unsigned)p;
                *(u32x2*)(O + (size_t)(row0 + ai * HALF + m * 16) * ldc + col0) = w; }
    }
};

typedef int i32x4 __attribute__((ext_vector_type(4)));
typedef int i32x8 __attribute__((ext_vector_type(8)));
__device__ __forceinline__ i32x8 cat32(bf16x8 a, bf16x8 b) { const i32x4 x = __builtin_bit_cast(i32x4, a), y = __builtin_bit_cast(i32x4, b); return __builtin_shufflevector(x, y, 0, 1, 2, 3, 4, 5, 6, 7); }
template <class Epi, class Sched, bool ALIGN_EPI = false, bool SP2 = false, bool FP8 = false, int KREP = 1, bool GATHER = false>
__device__ __forceinline__ void gemm_phase(PG8_LAS unsigned char* lds, const Gemm g, const Sched& S, const Epi& E, int wave_) {
    const int wid = wave_, lane = lane_id(), tid = wid * 64 + lane, wr = wid >> 2, wc = wid & 3, fr = lane & 15, fq = lane >> 4;
    constexpr int KD = 2048;
    constexpr int RB = FP8 ? KD : KD * 2, nt = RB / 128;
    unsigned voffA[2], voffB[2];
#pragma unroll
    for (int i = 0; i < 2; ++i) { int R, C; stage_rc(tid * 16 + i * 8192, R, C); const int Rb = Epi::PERM ? ((R & ~31) + perm32(R & 31)) : R;
        voffA[i] = (unsigned)(R * RB + C * 2); voffB[i] = (unsigned)(Rb * RB + C * 2); }
    constexpr size_t kstep = (size_t)(BK * 2);
    constexpr size_t hstep = (size_t)HALF * RB;
    constexpr size_t tstep = 2 * hstep;
    const unsigned ldsw = (unsigned)wid * 1024u;
    const int aoff = lds_byte(wr * 64 + fr, fq * 8), boff = lds_byte(wc * 32 + fr, fq * 8);
#define PG8_SA(b, h) (((b) * 2 + (h)) * HTB)
#define PG8_SB(b, h) ((4 + (b) * 2 + (h)) * HTB)
#define PG8_STAGE(bufoff, gbase, voff) do { _Pragma("unroll") for (int _i = 0; _i < 2; ++_i) { unsigned _o = (voff)[_i]; asm volatile("" : "+v"(_o));   \
        __builtin_amdgcn_global_load_lds((const unsigned*)((const char*)(gbase) + _o), (PG8_LAS unsigned*)(lds + (bufoff) + ldsw + _i * 8192), 16, 0, 0); } } while (0)
#define PG8_STAGE_G(bufoff, gbase, tkw) do { { unsigned _o = (((tkw) << 11) & 0x01fff800u) | cbA; asm volatile("" : "+v"(_o)); \
        __builtin_amdgcn_global_load_lds((const unsigned*)((const char*)(gbase) + _o), (PG8_LAS unsigned*)(lds + (bufoff) + ldsw), 16, 0, 0); } \
      { unsigned _o = (((tkw) >> 5) & 0x01fff800u) | cbA; asm volatile("" : "+v"(_o)); \
        __builtin_amdgcn_global_load_lds((const unsigned*)((const char*)(gbase) + _o), (PG8_LAS unsigned*)(lds + (bufoff) + ldsw + 8192), 16, 0, 0); } } while (0)
#define PG8_STAGE_A(bufoff, gbase, h) do { if constexpr (GATHER) PG8_STAGE_G(bufoff, gbase, tk[h]); else PG8_STAGE(bufoff, (gbase) + (h) * hstep, voffA); } while (0)
#define PG8_LD32(p) cat32(*(const PG8_LAS bf16x8*)(p), *(const PG8_LAS bf16x8*)((p) + 1024))
#define PG8_LDA(dst, b, h) do { _Pragma("unroll") for (int m = 0; m < 4; ++m) dst[m] = PG8_LD32(lds + PG8_SA(b, h) + aoff + m * 2048); } while (0)
#define PG8_LDB(dst, b, h) do { _Pragma("unroll") for (int n = 0; n < 2; ++n) dst[n] = PG8_LD32(lds + PG8_SB(b, h) + boff + n * 2048); } while (0)
#define PG8_LO(v) __builtin_bit_cast(bf16x8, __builtin_shufflevector(v, v, 0, 1, 2, 3))
#define PG8_HI(v) __builtin_bit_cast(bf16x8, __builtin_shufflevector(v, v, 4, 5, 6, 7))
#define PG8_MMA(ai, bj, At, Bt) do { __builtin_amdgcn_s_setprio(1); _Pragma("unroll") for (int m = 0; m < 4; ++m) _Pragma("unroll") for (int n = 0; n < 2; ++n) { \
        if constexpr (FP8) acc[ai][bj][m][n] = __builtin_amdgcn_mfma_scale_f32_16x16x128_f8f6f4(Bt[n], At[m], acc[ai][bj][m][n], 0, 0, 0, 0, 0, 0); \
        else { acc[ai][bj][m][n] = __builtin_amdgcn_mfma_f32_16x16x32_bf16(PG8_LO(Bt[n]), PG8_LO(At[m]), acc[ai][bj][m][n], 0, 0, 0); \
               acc[ai][bj][m][n] = __builtin_amdgcn_mfma_f32_16x16x32_bf16(PG8_HI(Bt[n]), PG8_HI(At[m]), acc[ai][bj][m][n], 0, 0, 0); } } \
        __builtin_amdgcn_s_setprio(0); } while (0)
#define PG8_WAIT_V(n) asm volatile("s_waitcnt vmcnt(" #n ")" ::: "memory")
#define PG8_WAIT_L(n) asm volatile("s_waitcnt lgkmcnt(" #n ")" ::: "memory")
#define PG8_BAR __builtin_amdgcn_s_barrier()
#define PG8_SCHED __builtin_amdgcn_sched_barrier(0)
    Unit cur, nxt; int ui = 0;
    if (!S.next(0, cur)) return;
    f32x4 acc[2][2][4][2];
#pragma unroll
    for (int a = 0; a < 2; ++a)
#pragma unroll
        for (int b = 0; b < 2; ++b)
#pragma unroll
            for (int m = 0; m < 4; ++m)
#pragma unroll
                for (int n = 0; n < 2; ++n) acc[a][b][m][n] = (f32x4){0.f, 0.f, 0.f, 0.f};
    i32x8 At[4], B0[2], B1[2];
    unsigned tk[2] = {0u, 0u}; unsigned cbA = 0u;
    if constexpr (GATHER) {
        { int R0_, C0_; stage_rc(tid * 16, R0_, C0_); cbA = (unsigned)(C0_ * 2); }
        unsigned tv[8];
#pragma unroll
        for (int k = 0; k < 8; ++k) { const int i = (tid >> 7) + 4 * k; tv[k] = 0u;
            if (i < S.nu) { const int pm_ = S.ul[4 * i], e_ = S.ul[4 * i + 3]; tv[k] = ((const unsigned*)g.list)[(size_t)(e_ * 64 + (pm_ - S.tp[e_])) * 128 + (tid & 127)] & 0x3fff3fffu; } }
#pragma unroll
        for (int k = 0; k < 8; ++k) { const int i = (tid >> 7) + 4 * k; if (i < S.nu) *(PG8_LAS unsigned*)(lds + 131072 + 512 * i + 4 * (tid & 127)) = tv[k]; }
        __syncthreads();
        { int R0_, C0_; stage_rc(tid * 16, R0_, C0_); const u32x2 t_ = *(const PG8_LAS u32x2*)(lds + 131072 + 8 * R0_); tk[0] = t_.x; tk[1] = t_.y; }
    }
    const char* cA = GATHER ? (const char*)g.A : (const char*)(cur.half ? g.A2 : g.A) + (size_t)cur.pm * tstep; const char* cB = (const char*)(cur.half ? g.Bt2 : g.Bt) + (size_t)cur.pb * tstep;
    if constexpr (SP2) {
        PG8_STAGE(PG8_SB(0, 0), cB, voffB); PG8_STAGE(PG8_SB(0, 1), cB + hstep, voffB); PG8_STAGE_A(PG8_SA(0, 0), cA, 0); PG8_STAGE_A(PG8_SA(0, 1), cA, 1);
        if (wr == 1) PG8_BAR;
        PG8_WAIT_V(2); PG8_BAR;
        PG8_STAGE(PG8_SB(1, 0), cB + kstep, voffB); PG8_STAGE(PG8_SB(1, 1), cB + hstep + kstep, voffB);
        PG8_WAIT_V(6); PG8_BAR;
    } else {
        PG8_STAGE(PG8_SB(0, 0), cB, voffB); PG8_STAGE(PG8_SA(0, 0), cA, voffA); PG8_STAGE(PG8_SB(0, 1), cB + hstep, voffB); PG8_STAGE(PG8_SA(0, 1), cA + hstep, voffA);
        if (wr == 1) PG8_BAR;
        PG8_WAIT_V(4); PG8_BAR;
        PG8_STAGE(PG8_SB(1, 0), cB + kstep, voffB); PG8_STAGE(PG8_SA(1, 0), cA + kstep, voffA); PG8_STAGE(PG8_SB(1, 1), cB + hstep + kstep, voffB);
        PG8_WAIT_V(6); PG8_BAR;
    }
    for (;;) {
        const bool has_next = S.next(ui + 1, nxt);
        const char* nA = GATHER ? cA : (has_next ? (const char*)(nxt.half ? g.A2 : g.A) + (size_t)nxt.pm * tstep : cA); const char* nB = has_next ? (const char*)(nxt.half ? g.Bt2 : g.Bt) + (size_t)nxt.pb * tstep : cB;
        for (int tt = 0; tt < nt * KREP; tt += 2) {
            const int t = KREP == 1 ? tt : tt % nt;
            const bool last = (t == nt - 2);
            const bool lastrep = KREP == 1 || tt >= nt * (KREP - 1);
            const char* a1 = cA + (size_t)(t + 1) * kstep;
            const char* a2 = last ? (lastrep ? nA : cA) : cA + (size_t)(t + 2) * kstep; const char* b2 = last ? (lastrep ? nB : cB) : cB + (size_t)(t + 2) * kstep;
            const char* a3 = a2 + kstep; const char* b3 = b2 + kstep;
            if constexpr (SP2) {
            PG8_LDB(B0, 0, 0); PG8_LDB(B1, 0, 1); PG8_SCHED; PG8_LDA(At, 0, 0); PG8_STAGE_A(PG8_SA(1, 0), a1, 0); PG8_STAGE_A(PG8_SA(1, 1), a1, 1);
            if constexpr (GATHER) { if (last && lastrep && has_next) { int R0_, C0_; stage_rc(tid * 16, R0_, C0_); asm volatile("" : "+v"(R0_)); const u32x2 t_ = *(const PG8_LAS u32x2*)(lds + 131072 + 512 * (ui + 1) + 8 * R0_); tk[0] = t_.x; tk[1] = t_.y; } }
            PG8_WAIT_V(8); PG8_WAIT_L(0); PG8_BAR; PG8_MMA(0, 0, At, B0); PG8_MMA(0, 1, At, B1); PG8_BAR; PG8_SCHED;
            PG8_LDA(At, 0, 1); PG8_STAGE(PG8_SB(0, 0), b2, voffB); PG8_STAGE(PG8_SB(0, 1), b2 + hstep, voffB);
            PG8_WAIT_V(6); PG8_WAIT_L(0); PG8_BAR; PG8_MMA(1, 0, At, B0); PG8_MMA(1, 1, At, B1); PG8_BAR; PG8_SCHED;
            PG8_LDB(B0, 1, 0); PG8_LDB(B1, 1, 1); PG8_SCHED; PG8_LDA(At, 1, 0); PG8_STAGE_A(PG8_SA(0, 0), a2, 0); PG8_STAGE_A(PG8_SA(0, 1), a2, 1);
            PG8_WAIT_V(8); PG8_WAIT_L(0); PG8_BAR; PG8_MMA(0, 0, At, B0); PG8_MMA(0, 1, At, B1); PG8_BAR; PG8_SCHED;
            PG8_LDA(At, 1, 1); PG8_STAGE(PG8_SB(1, 0), b3, voffB); PG8_STAGE(PG8_SB(1, 1), b3 + hstep, voffB);
            PG8_WAIT_V(6); PG8_WAIT_L(0); PG8_BAR; PG8_MMA(1, 0, At, B0); PG8_MMA(1, 1, At, B1); PG8_BAR; PG8_SCHED;
            } else {
            PG8_LDB(B0, 0, 0); PG8_SCHED; PG8_LDA(At, 0, 0); PG8_STAGE(PG8_SA(1, 1), a1 + hstep, voffA);
            PG8_WAIT_L(8); PG8_BAR; PG8_WAIT_L(0); PG8_MMA(0, 0, At, B0); PG8_BAR; PG8_SCHED;
            PG8_LDB(B1, 0, 1); PG8_STAGE(PG8_SB(0, 0), b2, voffB);
            PG8_BAR; PG8_WAIT_L(0); PG8_MMA(0, 1, At, B1); PG8_BAR;
            PG8_LDA(At, 0, 1); PG8_STAGE(PG8_SA(0, 0), a2, voffA);
            PG8_BAR; PG8_WAIT_L(0); PG8_MMA(1, 0, At, B0); PG8_BAR; PG8_SCHED;
            PG8_STAGE(PG8_SB(0, 1), b2 + hstep, voffB);
            PG8_WAIT_V(6); PG8_BAR; PG8_MMA(1, 1, At, B1); PG8_BAR;
            PG8_LDB(B0, 1, 0); PG8_SCHED; PG8_LDA(At, 1, 0); PG8_STAGE(PG8_SA(0, 1), a2 + hstep, voffA);
            PG8_WAIT_L(8); PG8_BAR; PG8_WAIT_L(0); PG8_MMA(0, 0, At, B0); PG8_BAR; PG8_SCHED;
            PG8_LDB(B1, 1, 1); PG8_STAGE(PG8_SB(1, 0), b3, voffB);
            PG8_BAR; PG8_WAIT_L(0); PG8_MMA(0, 1, At, B1); PG8_BAR;
            PG8_LDA(At, 1, 1); PG8_STAGE(PG8_SA(1, 0), a3, voffA);
            PG8_BAR; PG8_WAIT_L(0); PG8_MMA(1, 0, At, B0); PG8_BAR; PG8_SCHED;
            PG8_STAGE(PG8_SB(1, 1), b3 + hstep, voffB);
            PG8_WAIT_V(6); PG8_BAR; PG8_MMA(1, 1, At, B1); PG8_BAR;
            }
        }
        if constexpr (ALIGN_EPI) { if (wr == 0) PG8_BAR; }
        bool keep = false;
        if constexpr (Epi::CHAIN) { if (cur.half == 0) { E.mid(acc, cur, wr, wc, fr, fq); keep = true; } else E(acc, cur, wr, wc, fr, fq); }
        else E(acc, cur, wr, wc, fr, fq);
        if (!has_next) break;
        if (!keep) {
#pragma unroll
        for (int a = 0; a < 2; ++a)
#pragma unroll
            for (int b = 0; b < 2; ++b)
#pragma unroll
                for (int m = 0; m < 4; ++m)
#pragma unroll
                    for (int n = 0; n < 2; ++n) acc[a][b][m][n] = (f32x4){0.f, 0.f, 0.f, 0.f};
        }
        cur = nxt; cA = nA; cB = nB; ++ui;
        if constexpr (ALIGN_EPI) { if (wr == 1) PG8_BAR; }
    }
    PG8_WAIT_V(0);
    if constexpr (!ALIGN_EPI) { if (wr == 0) PG8_BAR; }
    PG8_BAR;
#undef PG8_SA
#undef PG8_SB
#undef PG8_STAGE
#undef PG8_STAGE_G
#undef PG8_STAGE_A
#undef PG8_LDA
#undef PG8_LD32
#undef PG8_LO
#undef PG8_HI
#undef PG8_LDB
#undef PG8_MMA
#undef PG8_WAIT_V
#undef PG8_WAIT_L
#undef PG8_BAR
#undef PG8_SCHED
}
}

namespace mk {
using pg8::bf16_t; using pg8::bf16x8; using pg8::f32x4; using pg8::u32x4; using pg8::u32x2; using pg8::cvt_pk_bf16; using pg8::bf_lo; using pg8::bf_hi;
constexpr int D = 2048, NB = 4, S = 4096, L = 256, NTOK = NB * S, NCTX = NB * L, MR = NTOK + NCTX;
constexpr int INW = 16384, MODW = 12288;
constexpr int RH = 8, NH = 16;
constexpr int NE = 32, FF = 2048, NSLOT256 = 288 * 256;
constexpr int C_QR = 0, C_KR = 1024, C_VR = 2048, C_GR = 4096, C_QN = 6144, C_KN = 8192, C_VN = 10240, C_GA = 12288, C_GB = 14336;
constexpr float QK_SCALE = 0.08838834764831845f, LOG2E = 1.4426950408889634f;
constexpr int CONV_P3_MATS_ = 0;
constexpr float W8_SCALE = 256.0f, H8_SCALE = 16.0f, A8_SCALE = 4.0f;
constexpr size_t MiB = 1u << 20;
constexpr size_t WS_CTL = 0, CTL_ZERO_BYTES = 1 * MiB;
constexpr size_t WS_MOD = 1 * MiB;
constexpr size_t WS_ASG_E = 2 * MiB, WS_ASG_POS = 3 * MiB, WS_ASG_W = 4 * MiB;
constexpr size_t WS_TOKL = 5 * MiB;
constexpr size_t WS_WIN = 16 * MiB;
constexpr size_t WS_WPA = 80 * MiB, WS_WPB = 88 * MiB, WS_WO = 96 * MiB;
constexpr size_t WS_WGU = 104 * MiB;
constexpr size_t WS_WDN = 616 * MiB;
constexpr size_t WS_HB = 872 * MiB;
constexpr size_t WS_YB = 940 * MiB;
constexpr size_t WS_XB = 940 * MiB, WS_ACTB = 1228 * MiB;
constexpr size_t WS_OF = 1484 * MiB, WS_OB = 1548 * MiB, WS_NAOB = 1612 * MiB, WS_T1 = 1676 * MiB;
constexpr size_t WS_X1B = 1676 * MiB;
constexpr size_t WS_KV = 1840 * MiB;
constexpr size_t WS_G8 = 1744 * MiB;
constexpr int G8W = 6144;
constexpr int CW_CNT = 64, CW_CNT_STRIDE = 64;
constexpr int CW_BAR = 4096;
constexpr int LDS_BYTES = 155648, MISC_OFF = 153600;

#define GAS __attribute__((address_space(1)))
#define LAS __attribute__((address_space(3)))
typedef GAS unsigned gu32;
#define RLX_AGENT __ATOMIC_RELAXED, __HIP_MEMORY_SCOPE_AGENT

__device__ __forceinline__ unsigned f2bf(float f) { unsigned u = __float_as_uint(f); return (u + 0x7fffu + ((u >> 16) & 1u)) >> 16; }
typedef __bf16 bf16x2_hw __attribute__((ext_vector_type(2)));
typedef float f32x2_hw __attribute__((ext_vector_type(2)));
__device__ __forceinline__ unsigned pk2(float lo, float hi) { const f32x2_hw v = {lo, hi}; const bf16x2_hw b = __builtin_convertvector(v, bf16x2_hw); return __builtin_bit_cast(unsigned, b); }
__device__ __forceinline__ float ex2(float x) { return __builtin_amdgcn_exp2f(x); }
__device__ __forceinline__ float wave_sum(float v) {
#pragma unroll
    for (int o = 1; o < 64; o <<= 1) v += __shfl_xor(v, o);
    return v;
}

#define XB_TMO      128
#define XB_XCNT(j)  (256  + 64 * (j))
#define XB_XSUB(j)  (1280 + 64 * (j))
#define XB_XGEN(j)  (2304 + 64 * (j))
#define XB_TOP      3328
#define XB_TOPGEN   3392
#define XCD_BAR_WORDS 3456
#define XB_SPIN_CAP (1u << 18)
__device__ __forceinline__ unsigned xb_ld(unsigned* p)              { return __hip_atomic_load(p, __ATOMIC_RELAXED, __HIP_MEMORY_SCOPE_AGENT); }
__device__ __forceinline__ unsigned xb_add(unsigned* p, unsigned v) { return __hip_atomic_fetch_add(p, v, __ATOMIC_RELAXED, __HIP_MEMORY_SCOPE_AGENT); }
__device__ __forceinline__ unsigned xb_xcc_id() { return (unsigned)__builtin_amdgcn_s_getreg((3 << 11) | 20) & 0xFu; }
#define XB_SPIN(cond, bar) do { unsigned _sp = 0; while (cond) { __builtin_amdgcn_s_sleep(1); \
    if ((++_sp & 255u) == 0u) { if (xb_ld(&(bar)[XB_TMO])) break; if (_sp > XB_SPIN_CAP) { atomicAdd(&(bar)[XB_TMO], 1u); break; } } } } while (0)
struct XcdBarrier { unsigned* bar; unsigned x; volatile LAS unsigned* st; };
__device__ __forceinline__ XcdBarrier xcd_barrier_post(unsigned* bar, volatile LAS unsigned* st, int tid_) {
    XcdBarrier b; b.bar = bar; b.x = xb_xcc_id(); b.st = st;
    if (tid_ == 0) (void)xb_add(&bar[XB_XCNT(b.x)], 1u);
    return b;
}
__device__ __forceinline__ void xcd_barrier_complete(unsigned* bar, unsigned x, unsigned& nloc, unsigned& nx) {
    const unsigned G = gridDim.x * gridDim.y * gridDim.z;
    unsigned sum, cnt, mine, sp = 0u;
    for (;;) {
        sum = 0u; cnt = 0u; mine = 0u;
#pragma unroll
        for (unsigned j = 0; j < 16; ++j) { const unsigned c = xb_ld(&bar[XB_XCNT(j)]); sum += c; cnt += (c > 0u) ? 1u : 0u; mine = (j == x) ? c : mine; }
        if (sum == G) break;
        __builtin_amdgcn_s_sleep(1);
        if ((++sp & 255u) == 0u) { if (xb_ld(&bar[XB_TMO])) break; if (sp > XB_SPIN_CAP) { atomicAdd(&bar[XB_TMO], 1u); break; } }
    }
    nloc = mine > 0u ? mine : 1u; nx = cnt > 0u ? cnt : 1u;
}
__device__ __forceinline__ void xcd_barrier(const XcdBarrier& b, int tid_) {
    asm volatile("s_waitcnt vmcnt(0)" ::: "memory");
    __syncthreads();
    if (tid_ == 0) {
        unsigned* bar = b.bar;
        __builtin_amdgcn_s_waitcnt(0);
        unsigned nloc = b.st[0], nx = b.st[1];
        if (nloc == 0u) { xcd_barrier_complete(bar, b.x, nloc, nx); b.st[0] = nloc; b.st[1] = nx; }
        const unsigned old = xb_add(&bar[XB_XSUB(b.x)], 1u);
        const unsigned gen = old / nloc;
        if (old + 1u == (gen + 1u) * nloc) {
            __builtin_amdgcn_fence(__ATOMIC_RELEASE, "agent");
            asm volatile("s_waitcnt vmcnt(0)" ::: "memory");
            const unsigned og = xb_add(&bar[XB_TOP], 1u);
            const unsigned tg = og / nx;
            if (og + 1u == (tg + 1u) * nx) xb_add(&bar[XB_TOPGEN], 1u);
            else XB_SPIN(xb_ld(&bar[XB_TOPGEN]) == tg, bar);
            __builtin_amdgcn_fence(__ATOMIC_ACQUIRE, "agent");
            xb_add(&bar[XB_XGEN(b.x)], 1u);
            asm volatile("s_waitcnt vmcnt(0)" ::: "memory");
        } else {
            XB_SPIN(xb_ld(&bar[XB_XGEN(b.x)]) == gen, bar);
            __builtin_amdgcn_fence(__ATOMIC_ACQUIRE, "agent");
            asm volatile("s_waitcnt vmcnt(0)" ::: "memory");
        }
    }
    __syncthreads();
}

typedef const float* fptr_t;
struct Frame {
    LAS unsigned char* lds;
    volatile LAS unsigned* MISC;
    unsigned* ctl;
    unsigned char* ws;
    int tid, lane, wave, G, bx;
    const __attribute__((address_space(4))) fptr_t* in;
    float* out;
};
#define LDS_WAIT() asm volatile("s_waitcnt lgkmcnt(0)" ::: "memory")

__device__ __forceinline__ void p0_transpose_item(const float* W, int K, int N, bf16_t* WT, int k0, int n0, size_t drow0, float scale, LAS float* scr, int lane, int rstride = 1) {
#pragma unroll 8
    for (int i = 0; i < 32; ++i) { const int kk = 2 * i + (lane >> 5); scr[kk * 33 + (lane & 31)] = W[(size_t)(k0 + kk) * N + n0 + (lane & 31)]; }
    LDS_WAIT(); asm volatile("" ::: "memory");
    const int c = lane & 7;
#pragma unroll
    for (int j = 0; j < 4; ++j) { const int n = (lane >> 3) + 8 * j; const LAS float* s = scr + (8 * c) * 33 + n;
        u32x4 o; o.x = pk2(s[0 * 33] * scale, s[1 * 33] * scale); o.y = pk2(s[2 * 33] * scale, s[3 * 33] * scale); o.z = pk2(s[4 * 33] * scale, s[5 * 33] * scale); o.w = pk2(s[6 * 33] * scale, s[7 * 33] * scale);
        *(u32x4*)(WT + (drow0 + (size_t)(n * rstride)) * (size_t)K + k0 + 8 * c) = o; }
    LDS_WAIT(); asm volatile("" ::: "memory");
}

__device__ __forceinline__ void p0_transpose_item8(const float* W, int K, int N, unsigned char* WT, int k0, int n0, size_t drow0, float scale, LAS float* scr, int lane, int rstride = 1) {
#pragma unroll 8
    for (int i = 0; i < 64; ++i) { const int kk = 2 * i + (lane >> 5); scr[kk * 33 + (lane & 31)] = W[(size_t)(k0 + kk) * N + n0 + (lane & 31)]; }
    LDS_WAIT(); asm volatile("" ::: "memory");
    const int c = lane & 7;
#pragma unroll
    for (int j = 0; j < 4; ++j) { const int n = (lane >> 3) + 8 * j; const LAS float* s = scr + (16 * c) * 33 + n; unsigned o[4];
#pragma unroll
        for (int q = 0; q < 4; ++q) { int p = __builtin_amdgcn_cvt_pk_fp8_f32(pg8::clamp448(s[(4 * q) * 33] * scale), pg8::clamp448(s[(4 * q + 1) * 33] * scale), 0, false);
            p = __builtin_amdgcn_cvt_pk_fp8_f32(pg8::clamp448(s[(4 * q + 2) * 33] * scale), pg8::clamp448(s[(4 * q + 3) * 33] * scale), p, true); o[q] = (unsigned)p; }
        *(u32x4*)(WT + (drow0 + (size_t)(n * rstride)) * (size_t)K + k0 + 16 * c) = (u32x4){o[0], o[1], o[2], o[3]}; }
    LDS_WAIT(); asm volatile("" ::: "memory");
}

__device__ __forceinline__ void p0_mod_slab(Frame& F, int slab) {
    LAS float* sv = (LAS float*)F.lds;
    LAS float* red = (LAS float*)(F.lds + 40960);
    const float* c = F.in[1]; const float* cc = F.in[3]; const float* W = F.in[4]; const float* bias = F.in[5];
    for (int i = F.tid; i < 5 * D; i += 512) { const int r = i / D, k = i % D; const float v = r < 4 ? c[r * D + k] : cc[k]; sv[i] = v / (1.0f + __expf(-v)); }
    __syncthreads();
    const int rr = F.tid >> 4, cq = F.tid & 15, col0 = slab * 64 + 4 * cq;
    f32x4 a[5];
#pragma unroll
    for (int r = 0; r < 5; ++r) a[r] = (f32x4){0.f, 0.f, 0.f, 0.f};
#pragma unroll 4
    for (int it = 0; it < 64; ++it) { const int k = rr + 32 * it; const f32x4 w = *(const f32x4*)(W + (size_t)k * MODW + col0);
#pragma unroll
        for (int r = 0; r < 5; ++r) a[r] += w * sv[r * D + k]; }
#pragma unroll
    for (int r = 0; r < 5; ++r) *(LAS f32x4*)(red + (rr * 5 + r) * 64 + 4 * cq) = a[r];
    __syncthreads();
    if (F.tid < 320) { const int r = F.tid >> 6, cl = F.tid & 63; float s = 0.f;
        for (int q = 0; q < 32; ++q) s += red[(q * 5 + r) * 64 + cl];
        ((float*)(F.ws + WS_MOD))[r * MODW + slab * 64 + cl] = s + bias[slab * 64 + cl]; }
    __syncthreads();
}

__device__ __forceinline__ void p0_prologue(Frame& F, bool conv_moe) {
    __syncthreads();
    if (F.bx < 192) p0_mod_slab(F, F.bx);
    LAS float* scr = (LAS float*)(F.lds + F.wave * 16896);
    const int gw = F.bx * 8 + F.wave, NGW = F.G * 8;
    constexpr int I_IN = (D / (MK_FP8_INPROJ ? 128 : 64)) * (INW / 32), I_SQ = (D / 64) * (D / 32);
    const int NIT = I_IN + 3 * (MK_FP8_PROJ ? I_SQ / 2 : I_SQ) + (conv_moe ? (96 - CONV_P3_MATS_) * (I_SQ / 2) : 0);
    LAS float* scr8 = (LAS float*)(F.lds + F.wave * 16896);
    for (int it = gw; it < NIT; it += NGW) {
        int r = it;
        if (r < I_IN) { const int kb = r / (INW / 32), nb = r % (INW / 32), n0 = nb * 32; const float wsc = (n0 >= C_KR && n0 < C_VR) ? QK_SCALE : ((n0 >= C_QN && n0 < C_KN) ? QK_SCALE * LOG2E : 1.0f);
            const bool rp = n0 < C_VR; const int d0 = n0 & 127; const size_t drow = rp ? (size_t)(n0 - d0 + (d0 >> 6) * 64 + ((d0 >> 5) & 1)) : (size_t)n0; const int rst = rp ? 2 : 1;
#if MK_FP8_INPROJ
            p0_transpose_item8(F.in[8], D, INW, F.ws + WS_WIN, kb * 128, n0, drow, wsc * W8_SCALE, scr8, F.lane, rst); continue; }
#else
            p0_transpose_item(F.in[8], D, INW, (bf16_t*)(F.ws + WS_WIN), kb * 64, n0, drow, wsc, scr, F.lane, rst); continue; }
#endif
        r -= I_IN;
#if MK_FP8_PROJ
        if (r < 3 * (I_SQ / 2)) { const int mtx = r / (I_SQ / 2), q = r % (I_SQ / 2), kb = q / 64, nb = q % 64;
            p0_transpose_item8(mtx == 0 ? F.in[9] : (mtx == 1 ? F.in[10] : F.in[11]), D, D, F.ws + WS_WPA + (size_t)mtx * 8 * MiB, kb * 128, nb * 32, (size_t)nb * 32, W8_SCALE, scr8, F.lane); continue; }
        r -= 3 * (I_SQ / 2);
#else
        if (r < 3 * I_SQ) { const int mtx = r / I_SQ, q = r % I_SQ, kb = q / 64, nb = q % 64;
            p0_transpose_item(mtx == 0 ? F.in[9] : (mtx == 1 ? F.in[10] : F.in[11]), D, D, (bf16_t*)(F.ws + WS_WPA + (size_t)mtx * 8 * MiB), kb * 64, nb * 32, (size_t)nb * 32, 1.0f, scr, F.lane); continue; }
        r -= 3 * I_SQ;
#endif
        { constexpr int I_8 = I_SQ / 2;
          const int m = CONV_P3_MATS_ + r / I_8, q2 = r % I_8, kind = m >> 5, e = m & 31, kb = q2 / 64, nb = q2 % 64, n0 = nb * 32;
          if (kind < 2) { const float* src = (kind == 0 ? F.in[17] : F.in[19]) + (size_t)e * D * FF;
              const size_t drow = (size_t)e * 4096 + (size_t)(n0 >> 7) * 256 + (size_t)(kind * 128) + (size_t)(n0 & 127);
              p0_transpose_item8(src, D, FF, F.ws + WS_WGU, kb * 128, n0, drow, W8_SCALE, scr8, F.lane); }
          else { const float* src = F.in[21] + (size_t)e * FF * D;
              p0_transpose_item8(src, FF, D, F.ws + WS_WDN, kb * 128, n0, (size_t)e * 2048 + n0, W8_SCALE, scr8, F.lane); } }
    }
}

__device__ __forceinline__ void p0_item8_fast(const float* W, int N, unsigned char* WT, int K, int k0, int n0, size_t drow0, float scale, LAS unsigned char* t8, int lane) {
    const int c = lane & 7, kg = lane >> 3;
    f32x4 v[16];
#pragma unroll
    for (int p = 0; p < 4; ++p)
#pragma unroll
        for (int i = 0; i < 4; ++i) v[4 * p + i] = __builtin_nontemporal_load((const f32x4*)(W + (size_t)(k0 + 32 * p + 4 * kg + i) * N + n0 + 4 * c));
#pragma unroll
    for (int p = 0; p < 4; ++p)
#pragma unroll
        for (int j = 0; j < 4; ++j) {
            int w = __builtin_amdgcn_cvt_pk_fp8_f32(pg8::clamp448(v[4 * p][j] * scale), pg8::clamp448(v[4 * p + 1][j] * scale), 0, false);
            w = __builtin_amdgcn_cvt_pk_fp8_f32(pg8::clamp448(v[4 * p + 2][j] * scale), pg8::clamp448(v[4 * p + 3][j] * scale), w, true);
            *(LAS int*)(t8 + (4 * c + j) * 136 + 32 * p + 4 * kg) = w; }
    LDS_WAIT(); asm volatile("" ::: "memory");
#pragma unroll
    for (int jj = 0; jj < 4; ++jj) { const int n = (lane >> 3) + 8 * jj; const LAS unsigned char* sp = t8 + n * 136 + 16 * (lane & 7);
        const u32x2 a = *(const LAS u32x2*)sp, b = *(const LAS u32x2*)(sp + 8);
        __builtin_nontemporal_store((u32x4){a.x, a.y, b.x, b.y}, (u32x4*)(WT + (drow0 + (size_t)n) * (size_t)K + k0 + 16 * (lane & 7))); }
    LDS_WAIT(); asm volatile("" ::: "memory");
}
constexpr int MOE_ITEMS = 96 * 1024;
__device__ __forceinline__ void p0_moe_items(Frame& F, int cw, int NCW, int lo, int hi) {
    LAS float* scr8 = (LAS float*)(F.lds + F.wave * 16896);
    for (int r = lo + cw; r < hi; r += NCW) {
        const int m = r >> 10, q2 = r & 1023, kind = m >> 5, e = m & 31, kb = q2 / 64, nb = q2 % 64, n0 = nb * 32;
        if (kind < 2) { const float* src = (kind == 0 ? F.in[17] : F.in[19]) + (size_t)e * D * FF;
            const size_t drow = (size_t)e * 4096 + (size_t)(n0 >> 7) * 256 + (size_t)(kind * 128) + (size_t)(n0 & 127);
            p0_item8_fast(src, FF, F.ws + WS_WGU, D, kb * 128, n0, drow, W8_SCALE, (LAS unsigned char*)scr8, F.lane); }
        else { const float* src = F.in[21] + (size_t)e * FF * D;
            p0_item8_fast(src, D, F.ws + WS_WDN, FF, kb * 128, n0, (size_t)e * 2048 + n0, W8_SCALE, (LAS unsigned char*)scr8, F.lane); } }
}

__device__ __forceinline__ void p1_rows(Frame& F) {
    const int gw = F.bx * 8 + F.wave, NGW = F.G * 8;
    const float* mod = (const float*)(F.ws + WS_MOD); const float* g = F.in[6];
    bf16_t* HB = (bf16_t*)(F.ws + WS_HB);
    for (int m0 = gw; m0 < MR; m0 += 2 * NGW) {
        f32x4 v[2][8]; float ss[2] = {0.f, 0.f};
#pragma unroll
        for (int u = 0; u < 2; ++u) { const int m = min(m0 + u * NGW, MR - 1); const float* src = m < NTOK ? F.in[0] + (size_t)m * D : F.in[2] + (size_t)(m - NTOK) * D;
#pragma unroll
            for (int j = 0; j < 8; ++j) v[u][j] = *(const f32x4*)(src + 4 * F.lane + 256 * j); }
#pragma unroll
        for (int u = 0; u < 2; ++u)
#pragma unroll
            for (int j = 0; j < 8; ++j) ss[u] += (v[u][j][0] * v[u][j][0] + v[u][j][1] * v[u][j][1]) + (v[u][j][2] * v[u][j][2] + v[u][j][3] * v[u][j][3]);
#pragma unroll
        for (int u = 0; u < 2; ++u) { const int m = m0 + u * NGW; if (m >= MR) break;
            const float* md = mod + (size_t)(m < NTOK ? m / S : 4) * MODW;
            const float rstd = rsqrtf(wave_sum(ss[u]) * (1.0f / D) + 1e-6f);
#pragma unroll
            for (int j = 0; j < 8; ++j) { const int k = 4 * F.lane + 256 * j; const f32x4 gg = *(const f32x4*)(g + k), sh = *(const f32x4*)(md + k), sc = *(const f32x4*)(md + D + k);
                const f32x4 y = v[u][j] * rstd * gg * (sc + 1.0f) + sh;
#if MK_FP8_INPROJ
                int p = __builtin_amdgcn_cvt_pk_fp8_f32(pg8::clamp448(y[0] * H8_SCALE), pg8::clamp448(y[1] * H8_SCALE), 0, false); p = __builtin_amdgcn_cvt_pk_fp8_f32(pg8::clamp448(y[2] * H8_SCALE), pg8::clamp448(y[3] * H8_SCALE), p, true);
                *(int*)((unsigned char*)HB + (size_t)m * D + k) = p; }
#else
                u32x2 o; o.x = pk2(y[0], y[1]); o.y = pk2(y[2], y[3]);
                *(u32x2*)(HB + (size_t)m * D + k) = o; }
#endif
        }
    }
}

static_assert(CONV_P3_MATS_ >= 0, ""); constexpr int CONV_P3_MATS = CONV_P3_MATS_;
constexpr int CONV_TOTAL = CONV_P3_MATS * 32 * 128, CONV_PER_WAVE = CONV_TOTAL / 2048;
__device__ __forceinline__ void conv_issue(Frame& F, int idx, float (&r)[16]) {
    const int kstep = idx & 127, t = idx >> 7, nblk = t & 31, m = t >> 5, e = m & 31, kind = m >> 5;
    const float* src = (kind == 0 ? F.in[17] : (kind == 1 ? F.in[19] : F.in[21])) + (size_t)e * (2048 * 2048) + (size_t)(kstep * 16) * 2048 + nblk * 64 + F.lane;
#pragma unroll
    for (int q = 0; q < 16; ++q) r[q] = __builtin_nontemporal_load(src + q * 2048);
}
__device__ __forceinline__ void conv_commit(Frame& F, int idx, const float (&r)[16]) {
    const int kstep = idx & 127, t = idx >> 7, nblk = t & 31, m = t >> 5, e = m & 31, kind = m >> 5;
    const int n = nblk * 64 + F.lane;
    const size_t drow = kind < 2 ? (size_t)e * 4096 + (size_t)(n >> 7) * 256 + (size_t)(kind * 128) + (size_t)(n & 127) : (size_t)e * 2048 + n;
    unsigned char* dst = F.ws + (kind < 2 ? WS_WGU : WS_WDN) + drow * 2048 + kstep * 16;
    unsigned o[4];
#pragma unroll
    for (int q = 0; q < 4; ++q) { int p = __builtin_amdgcn_cvt_pk_fp8_f32(pg8::clamp448(r[4 * q] * W8_SCALE), pg8::clamp448(r[4 * q + 1] * W8_SCALE), 0, false);
        p = __builtin_amdgcn_cvt_pk_fp8_f32(pg8::clamp448(r[4 * q + 2] * W8_SCALE), pg8::clamp448(r[4 * q + 3] * W8_SCALE), p, true); o[q] = (unsigned)p; }
    *(u32x4*)dst = (u32x4){o[0], o[1], o[2], o[3]};
}
struct ConvCur { int cur, end; };

typedef short v4i16_t __attribute__((ext_vector_type(4)));
__device__ __forceinline__ v4i16_t ds_tr(const LAS unsigned char* p) { return __builtin_amdgcn_ds_read_tr16_b64_v4i16((LAS v4i16_t*)p); }
__device__ __forceinline__ bf16x8 cat8(v4i16_t a, v4i16_t b) { bf16x8 r; r[0] = a[0]; r[1] = a[1]; r[2] = a[2]; r[3] = a[3]; r[4] = b[0]; r[5] = b[1]; r[6] = b[2]; r[7] = b[3]; return r; }
#define MFMA16(a, b, c) __builtin_amdgcn_mfma_f32_16x16x32_bf16((a), (b), (c), 0, 0, 0)

constexpr int R_QS = 0, R_KS = 34816, R_VS = 71680, R_RT = 92160;
constexpr int PQ = 272, PK = 288, PV = 160, PR = 272;

__device__ __forceinline__ void ret_unit(Frame& F, int b, int h, int dir, int dvs, ConvCur& cv) {
    LAS unsigned char* lds = F.lds;
    __syncthreads();
    const int tid = F.tid, w = F.wave;
    const bf16_t* YB = (const bf16_t*)(F.ws + WS_YB);
    bf16_t* OUT = (bf16_t*)(F.ws + (dir ? WS_OB : WS_OF));
    const float dec = (dir ? F.in[13] : F.in[12])[h];
    const float l2g = -log1pf(expf(-dec)) * LOG2E;
    u32x4 rq[2][2], rk[2][2], rv[2];
    f32x4 Racc[2][2];
#pragma unroll
    for (int a = 0; a < 2; ++a)
#pragma unroll
        for (int c = 0; c < 2; ++c) Racc[a][c] = (f32x4){0.f, 0.f, 0.f, 0.f};
    for (int i = tid; i < 64 * PR / 16; i += 512) *(LAS u32x4*)(lds + R_RT + i * 16) = (u32x4){0u, 0u, 0u, 0u};

    auto base_row = [&](int it) -> int { if (it < 2) { const int ci = dir ? 1 - it : it; return NTOK + b * L + ci * 128; } const int ci = dir ? 31 - (it - 2) : (it - 2); return b * S + ci * 128; };
    auto issue = [&](int it, int tz) {
        const int br = base_row(it); const int aj = tz & 7, colq = (aj >> 2) * 64 + 8 * (aj & 3);
#pragma unroll
        for (int i = 0; i < 2; ++i) { const int p = (tz >> 3) + 64 * i; const size_t row = (size_t)(br + (dir ? 127 - p : p));
            const bf16_t* rp = YB + row * INW;
            if (it >= 2) { rq[i][0] = *(const u32x4*)(rp + C_QR + h * 128 + colq); rq[i][1] = *(const u32x4*)(rp + C_QR + h * 128 + colq + 32); }
            rk[i][0] = *(const u32x4*)(rp + C_KR + h * 128 + colq); rk[i][1] = *(const u32x4*)(rp + C_KR + h * 128 + colq + 32);
            rv[i] = *(const u32x4*)(rp + C_VR + h * 256 + dvs * 64 + 8 * aj); }
    };
    auto commit = [&](int it, int tz, float l2z) {
        const bool lat = it >= 2; const int aj = tz & 7, colq = (aj >> 2) * 64 + 8 * (aj & 3);
#pragma unroll
        for (int i = 0; i < 2; ++i) { const int p = (tz >> 3) + 64 * i;
            const float gp = ex2((float)p * l2z), gm = ex2(-(float)p * l2z);
#pragma unroll
            for (int hh = 0; hh < 2; ++hh) { const u32x4 kv = rk[i][hh]; u32x4 zv;
                zv.x = pk2(bf_lo(kv.x) * gm, bf_hi(kv.x) * gm); zv.y = pk2(bf_lo(kv.y) * gm, bf_hi(kv.y) * gm); zv.z = pk2(bf_lo(kv.z) * gm, bf_hi(kv.z) * gm); zv.w = pk2(bf_lo(kv.w) * gm, bf_hi(kv.w) * gm);
                *(LAS u32x4*)(lds + R_KS + p * PK + (colq + 32 * hh) * 2) = zv;
                if (lat) { const u32x4 qv = rq[i][hh]; u32x4 qd;
                    qd.x = pk2(bf_lo(qv.x) * gp, bf_hi(qv.x) * gp); qd.y = pk2(bf_lo(qv.y) * gp, bf_hi(qv.y) * gp); qd.z = pk2(bf_lo(qv.z) * gp, bf_hi(qv.z) * gp); qd.w = pk2(bf_lo(qv.w) * gp, bf_hi(qv.w) * gp);
                    *(LAS u32x4*)(lds + R_QS + p * PQ + (colq + 32 * hh) * 2) = qd; } }
            *(LAS u32x4*)(lds + R_VS + p * PV + aj * 16) = rv[i]; }
    };

    issue(0, tid);
    commit(0, tid, l2g);
    __syncthreads();
    const int wr4 = w >> 1, wc2 = w & 1;
    const int wr2 = w >> 2, wc4 = w & 3;
    for (int it = 0; it < 34; ++it) {
        const bool lat = it >= 2;
        float l2i = l2g; int tz = tid; asm volatile("" : "+v"(l2i), "+v"(tz));
        const int fr = tz & 15, fq = (tz & 63) >> 4;
        const float g1 = ex2(l2i), g127 = ex2(127.0f * l2i);
        if (it + 1 < 34) issue(it + 1, tz);
        const bool cvd = cv.cur < cv.end; float cvr[16];
        if (cvd) conv_issue(F, cv.cur, cvr);
        f32x4 Sacc[2][4], Oacc[2][2];
        if (lat) {
#pragma unroll
            for (int a = 0; a < 2; ++a) {
#pragma unroll
                for (int c = 0; c < 4; ++c) Sacc[a][c] = (f32x4){0.f, 0.f, 0.f, 0.f};
#pragma unroll
                for (int c = 0; c < 2; ++c) Oacc[a][c] = (f32x4){0.f, 0.f, 0.f, 0.f}; }
#pragma unroll
            for (int ks = 0; ks < 4; ++ks) {
                bf16x8 qa[2], kb[4], rb[2];
#pragma unroll
                for (int a = 0; a < 2; ++a) qa[a] = *(const LAS bf16x8*)(lds + R_QS + (32 * wr4 + 16 * a + fr) * PQ + (32 * ks + 8 * fq) * 2);
#pragma unroll
                for (int c = 0; c < 4; ++c) kb[c] = *(const LAS bf16x8*)(lds + R_KS + (64 * wc2 + 16 * c + fr) * PK + (32 * ks + 8 * fq) * 2);
#pragma unroll
                for (int c = 0; c < 2; ++c) rb[c] = *(const LAS bf16x8*)(lds + R_RT + (32 * wc2 + 16 * c + fr) * PR + (32 * ks + 8 * fq) * 2);
#pragma unroll
                for (int a = 0; a < 2; ++a) {
#pragma unroll
                    for (int c = 0; c < 4; ++c) Sacc[a][c] = MFMA16(kb[c], qa[a], Sacc[a][c]);
#pragma unroll
                    for (int c = 0; c < 2; ++c) Oacc[a][c] = MFMA16(rb[c], qa[a], Oacc[a][c]); }
            }
        }
        {
#pragma unroll
            for (int a = 0; a < 2; ++a)
#pragma unroll
                for (int c = 0; c < 2; ++c) Racc[a][c] *= g1;
#pragma unroll
            for (int ks = 0; ks < 4; ++ks) {
                bf16x8 va[2], zb[2];
                const int c0 = 32 * ks + 8 * fq + (fr >> 2);
#pragma unroll
                for (int a = 0; a < 2; ++a) va[a] = cat8(ds_tr(lds + R_VS + c0 * PV + (32 * wr2 + 16 * a + 4 * (fr & 3)) * 2), ds_tr(lds + R_VS + (c0 + 4) * PV + (32 * wr2 + 16 * a + 4 * (fr & 3)) * 2));
#pragma unroll
                for (int c = 0; c < 2; ++c) zb[c] = cat8(ds_tr(lds + R_KS + c0 * PK + (32 * wc4 + 16 * c + 4 * (fr & 3)) * 2), ds_tr(lds + R_KS + (c0 + 4) * PK + (32 * wc4 + 16 * c + 4 * (fr & 3)) * 2));
#pragma unroll
                for (int a = 0; a < 2; ++a)
#pragma unroll
                    for (int c = 0; c < 2; ++c) Racc[a][c] = MFMA16(zb[c], va[a], Racc[a][c]);
            }
        }
        __syncthreads();
        if (lat) {
#pragma unroll
            for (int a = 0; a < 2; ++a)
#pragma unroll
                for (int c = 0; c < 4; ++c) { const int cr = 32 * wr4 + 16 * a + fr, m0 = 64 * wc2 + 16 * c + 4 * fq; float o[4];
#pragma unroll
                    for (int j = 0; j < 4; ++j) o[j] = cr >= m0 + j ? Sacc[a][c][j] : 0.0f;
                    u32x2 wv; wv.x = pk2(o[0], o[1]); wv.y = pk2(o[2], o[3]);
                    *(LAS u32x2*)(lds + R_KS + cr * PK + m0 * 2) = wv; }
        }
#pragma unroll
        for (int a = 0; a < 2; ++a)
#pragma unroll
            for (int c = 0; c < 2; ++c) { Racc[a][c] *= g127; u32x2 wv; wv.x = pk2(Racc[a][c][0], Racc[a][c][1]); wv.y = pk2(Racc[a][c][2], Racc[a][c][3]);
                *(LAS u32x2*)(lds + R_RT + (32 * wr2 + 16 * a + fr) * PR + (32 * wc4 + 16 * c + 4 * fq) * 2) = wv; }
        __syncthreads();
        if (lat) {
#pragma unroll
            for (int a = 0; a < 2; ++a)
#pragma unroll
                for (int c = 0; c < 2; ++c) Oacc[a][c] *= g1;
#pragma unroll
            for (int ks = 0; ks < 4; ++ks) {
                bf16x8 sa[2], vb[2];
                const int c0 = 32 * ks + 8 * fq + (fr >> 2);
#pragma unroll
                for (int a = 0; a < 2; ++a) sa[a] = *(const LAS bf16x8*)(lds + R_KS + (32 * wr4 + 16 * a + fr) * PK + (32 * ks + 8 * fq) * 2);
#pragma unroll
                for (int c = 0; c < 2; ++c) vb[c] = cat8(ds_tr(lds + R_VS + c0 * PV + (32 * wc2 + 16 * c + 4 * (fr & 3)) * 2), ds_tr(lds + R_VS + (c0 + 4) * PV + (32 * wc2 + 16 * c + 4 * (fr & 3)) * 2));
#pragma unroll
                for (int a = 0; a < 2; ++a)
#pragma unroll
                    for (int c = 0; c < 2; ++c) Oacc[a][c] = MFMA16(vb[c], sa[a], Oacc[a][c]);
            }
            const int br = base_row(it);
#pragma unroll
            for (int a = 0; a < 2; ++a) { const int p = 32 * wr4 + 16 * a + fr; const size_t row = (size_t)(br + (dir ? 127 - p : p));
#pragma unroll
                for (int c = 0; c < 2; ++c) { u32x2 wv; wv.x = pk2(Oacc[a][c][0], Oacc[a][c][1]); wv.y = pk2(Oacc[a][c][2], Oacc[a][c][3]);
                    *(u32x2*)(OUT + row * D + h * 256 + dvs * 64 + 32 * wc2 + 16 * c + 4 * fq) = wv; } }
        }
        __syncthreads();
        if (it + 1 < 34) commit(it + 1, tz, l2i);
        if (cvd) { conv_commit(F, cv.cur, cvr); ++cv.cur; }
        __syncthreads();
    }
}

constexpr int N_K = 0, N_V = 34816, NBUF = 71680, N_RPB = 2 * NBUF, NPK_ = 272, NP_ = 288;
struct NaState { f32x4 O[8]; float m_run, l_part; bf16x8 Qf[4]; };
__device__ __forceinline__ int na_unit(Frame& F, int b, int h, int rq, int par, bool first, bool has_next, int nb, int nh, int nrq) {
    LAS unsigned char* lds = F.lds;
    const int tid = F.tid, lane = F.lane, w = F.wave;
    const bf16_t* YB = (const bf16_t*)(F.ws + WS_YB);
    bf16_t* NAOB = (bf16_t*)(F.ws + WS_NAOB); const bf16_t* KVB = (const bf16_t*)(F.ws + WS_KV);
    const int r0 = 4 * rq, qrowA = r0 + 2 * (w >> 2), j = w & 3;
    const int kstart = j == 0 ? 0 : (j == 1 ? 8 : (j == 2 ? 24 : 32));
    const int lo = min(max(r0 - 4, 0), 56), hi = min(max(r0 + 3 - 4, 0), 56) + 7, nloc = hi - lo + 1, nls = (nloc + 1) >> 1, ns = nls + 2;
    NaState sa, sb;
    { const int fr = lane & 15, fq = lane >> 4; const bf16_t* qp = YB + (size_t)(b * S + qrowA * 64 + 16 * j + fr) * INW + C_QN + h * 128 + 8 * fq;
#pragma unroll
      for (int ks = 0; ks < 4; ++ks) { sa.Qf[ks] = *(const bf16x8*)(qp + 32 * ks); sb.Qf[ks] = *(const bf16x8*)(qp + (size_t)64 * INW + 32 * ks); } }
#pragma unroll
    for (int d = 0; d < 8; ++d) { sa.O[d] = (f32x4){0.f, 0.f, 0.f, 0.f}; sb.O[d] = sa.O[d]; }
    sa.m_run = -1e30f; sa.l_part = 0.f; sb.m_run = -1e30f; sb.l_part = 0.f;
    u32x4 rk[4], rv[4];
    auto issue = [&](int b_, int h_, int lo_, int hi_, int nls_, int st) {
        int t_ = tid; asm volatile("" : "+v"(t_));
#pragma unroll
        for (int i = 0; i < 4; ++i) { const int T = t_ + 512 * i, key = T >> 4, ch = T & 15;
            const int tok = st < nls_ ? min(lo_ + 2 * st + (key >> 6), hi_) * 64 + (key & 63) : S + (st - nls_) * 128 + key;
            const bf16_t* kp = KVB + ((size_t)((b_ * 16 + h_) * (S + L) + tok) * 256 + 8 * ch);
            rk[i] = *(const u32x4*)kp; rv[i] = *(const u32x4*)(kp + 128); }
    };
    auto commit = [&](int bo) {
        int t_ = tid; asm volatile("" : "+v"(t_));
#pragma unroll
        for (int i = 0; i < 4; ++i) { const int T = t_ + 512 * i, key = T >> 4, ch = T & 15;
            *(LAS u32x4*)(lds + bo + N_K + key * NPK_ + ch * 16) = rk[i]; *(LAS u32x4*)(lds + bo + N_V + key * NP_ + ch * 16) = rv[i]; }
    };
    auto rpb_load = [&](int h_) { const int ix = tid - 16; return (ix >= 0 && ix < 465) ? F.in[14][h_ * 465 + ix] * LOG2E : 0.0f; };
    int bufo = par * NBUF;
    auto softmax64 = [&](NaState& st_, int qrow, const f32x4 (&Sx)[2][2], int k0a, int k0b, bool acta, bool actb, bool local, int kra, int krb, bf16x8 (&pf)[2], int fr, int fq) {
        const int qc = 16 * j + fr, cs = min(max(qc - 8, 0), 48);
        f32x4 s4[4];
#pragma unroll
        for (int q = 0; q < 4; ++q) s4[q] = Sx[q >> 1][q & 1];
        if (local) {
            f32x4 bias[4];
#pragma unroll
            for (int i = 0; i < 2; ++i) { const int kb0 = i ? k0b : k0a, kr = i ? krb : kra; const int br = min(max(kr - qrow + 7, 0), 14);
                const LAS float* bp = (const LAS float*)(lds + N_RPB) + 16 + br * 31 + ((kb0 & 63) + 4 * fq - qc + 15);
#pragma unroll
                for (int t = 0; t < 2; ++t)
#pragma unroll
                    for (int e = 0; e < 4; ++e) bias[2 * i + t][e] = bp[16 * t + e]; }
            asm volatile("" : "+v"(bias[0]), "+v"(bias[1]), "+v"(bias[2]), "+v"(bias[3]));
#pragma unroll
            for (int q = 0; q < 4; ++q) { const int i = q >> 1, t = q & 1, kb0 = i ? k0b : k0a; const bool act = i ? actb : acta;
                const f32x4 v = s4[q] + bias[q];
#pragma unroll
                for (int e = 0; e < 4; ++e) { const int kc = (kb0 & 63) + 16 * t + 4 * fq + e; s4[q][e] = (((unsigned)(kc - cs) < 16u) && act) ? v[e] : -3e38f; } } }
        float mx = -3e38f;
#pragma unroll
        for (int q = 0; q < 4; ++q)
#pragma unroll
            for (int e = 0; e < 4; ++e) mx = fmaxf(mx, s4[q][e]);
        { const auto r16 = __builtin_amdgcn_permlane16_swap(__builtin_bit_cast(unsigned, mx), __builtin_bit_cast(unsigned, mx), false, false);
          mx = fmaxf(__builtin_bit_cast(float, r16[0]), __builtin_bit_cast(float, r16[1]));
          const auto r32 = __builtin_amdgcn_permlane32_swap(__builtin_bit_cast(unsigned, mx), __builtin_bit_cast(unsigned, mx), false, false);
          mx = fmaxf(__builtin_bit_cast(float, r32[0]), __builtin_bit_cast(float, r32[1])); }
        const float m_new = fmaxf(st_.m_run, mx), alpha = ex2(st_.m_run - m_new);
        const f32x4 m4 = {m_new, m_new, m_new, m_new}; f32x4 ps4 = {0.f, 0.f, 0.f, 0.f};
#pragma unroll
        for (int q = 0; q < 4; ++q) { const f32x4 d = s4[q] - m4;
#pragma unroll
            for (int e = 0; e < 4; ++e) s4[q][e] = ex2(d[e]);
            ps4 += s4[q]; }
        st_.l_part = st_.l_part * alpha + ((ps4[0] + ps4[1]) + (ps4[2] + ps4[3]));
        if (__any(m_new > st_.m_run)) {
#pragma unroll
            for (int d = 0; d < 8; ++d) st_.O[d] *= alpha; }
        st_.m_run = m_new;
#pragma unroll
        for (int i = 0; i < 2; ++i) { u32x4 pw; pw.x = pk2(s4[2 * i][0], s4[2 * i][1]); pw.y = pk2(s4[2 * i][2], s4[2 * i][3]); pw.z = pk2(s4[2 * i + 1][0], s4[2 * i + 1][1]); pw.w = pk2(s4[2 * i + 1][2], s4[2 * i + 1][3]); pf[i] = __builtin_bit_cast(bf16x8, pw); }
    };
    auto block64x2 = [&](int k0a, int k0b, bool aA, bool bA, bool aB, bool bB, bool local, int kra, int krb) {
        int fq = lane >> 4, fr = lane & 15; asm volatile("" : "+v"(fq), "+v"(fr));
        f32x4 SA[2][2], SB[2][2];
        bf16x8 kf[2][4];
        auto ldk = [&](int g, bf16x8 (&dst)[4]) { const int kb0 = (g >> 1) ? k0b : k0a;
#pragma unroll
            for (int ks = 0; ks < 4; ++ks) dst[ks] = *(const LAS bf16x8*)(lds + bufo + N_K + (kb0 + 16 * (g & 1) + fr) * NPK_ + (32 * ks + 8 * fq) * 2); };
        ldk(0, kf[0]);
#pragma unroll
        for (int g = 0; g < 4; ++g) { f32x4 xa = (f32x4){0.f, 0.f, 0.f, 0.f}, xb = xa, ya = xa, yb = xa;
            if (g + 1 < 4) ldk(g + 1, kf[(g + 1) & 1]);
            xa = MFMA16(kf[g & 1][0], sa.Qf[0], xa); xb = MFMA16(kf[g & 1][0], sb.Qf[0], xb); ya = MFMA16(kf[g & 1][1], sa.Qf[1], ya); yb = MFMA16(kf[g & 1][1], sb.Qf[1], yb);
            xa = MFMA16(kf[g & 1][2], sa.Qf[2], xa); xb = MFMA16(kf[g & 1][2], sb.Qf[2], xb); ya = MFMA16(kf[g & 1][3], sa.Qf[3], ya); yb = MFMA16(kf[g & 1][3], sb.Qf[3], yb);
            SA[g >> 1][g & 1] = xa + ya; SB[g >> 1][g & 1] = xb + yb;
            __builtin_amdgcn_sched_barrier(0); }
        bf16x8 pfA[2], pfB[2];
        softmax64(sa, qrowA, SA, k0a, k0b, aA, bA, local, kra, krb, pfA, fr, fq);
        softmax64(sb, qrowA + 1, SB, k0a, k0b, aB, bB, local, kra, krb, pfB, fr, fq);
        __builtin_amdgcn_sched_barrier(0);
        bf16x8 vf[2][4];
        auto ldv = [&](int g, bf16x8 (&dst)[4]) { const int k0 = ((g >> 1) ? k0b : k0a) + 4 * fq + (fr >> 2);
#pragma unroll
            for (int q = 0; q < 4; ++q) { const int d = 4 * (g & 1) + q; dst[q] = cat8(ds_tr(lds + bufo + N_V + k0 * NP_ + (16 * d + 4 * (fr & 3)) * 2), ds_tr(lds + bufo + N_V + (k0 + 16) * NP_ + (16 * d + 4 * (fr & 3)) * 2)); } };
        ldv(0, vf[0]);
#pragma unroll
        for (int g = 0; g < 4; ++g) {
            if (g + 1 < 4) ldv(g + 1, vf[(g + 1) & 1]);
#pragma unroll
            for (int q = 0; q < 4; ++q) { const int d = 4 * (g & 1) + q; sa.O[d] = MFMA16(vf[g & 1][q], pfA[g >> 1], sa.O[d]); sb.O[d] = MFMA16(vf[g & 1][q], pfB[g >> 1], sb.O[d]); }
            __builtin_amdgcn_sched_barrier(0); }
    };
    auto stage_step = [&](int stg) {
        const bool local = stg < nls; const int nsub = local ? 1 : 2;
        const int kra = lo + 2 * stg, krb = kra + 1, rsA = min(max(qrowA - 4, 0), 56), rsB = min(max(qrowA + 1 - 4, 0), 56);
        const bool aA = !local || (kra >= rsA && kra < rsA + 8), bA = !local || (krb <= hi && krb >= rsA && krb < rsA + 8), aB = !local || (kra >= rsB && kra < rsB + 8), bB = !local || (krb <= hi && krb >= rsB && krb < rsB + 8);
        if (aA || bA || aB || bB) {
#pragma unroll 1
            for (int sub = 0; sub < nsub; ++sub) block64x2(local ? kstart : 64 * sub, local ? 64 + kstart : 64 * sub + 32, aA, bA, aB, bB, local, kra, krb); }
    };
    if (first) {
        issue(b, h, lo, hi, nls, 0); const float rp = rpb_load(h);
        commit(bufo); ((LAS float*)(lds + N_RPB))[tid] = rp;
        __syncthreads(); }
    const int nr0 = 4 * nrq, nlo = min(max(nr0 - 4, 0), 56), nhi = min(max(nr0 + 3 - 4, 0), 56) + 7;
    for (int st = 0; st < ns; ++st) {
        const bool lastst = st + 1 == ns; float rp = 0.f;
        if (!lastst) issue(b, h, lo, hi, nls, st + 1);
        else if (has_next) { issue(nb, nh, nlo, nhi, 1, 0); rp = rpb_load(nh); }
        stage_step(st);
        if (!lastst || has_next) commit(NBUF - bufo);
        if (lastst && has_next) ((LAS float*)(lds + N_RPB))[tid] = rp;
        bufo = NBUF - bufo;
        __syncthreads();
    }
    const int fr = lane & 15, fq = lane >> 4;
#pragma unroll
    for (int u = 0; u < 2; ++u) { NaState& st_ = u ? sb : sa;
        float l = st_.l_part; l += __shfl_xor(l, 16); l += __shfl_xor(l, 32);
        const float inv = 1.0f / l;
#if MK_FP8_PROJ
        unsigned char* op = (unsigned char*)NAOB + (size_t)(b * S + (qrowA + u) * 64 + 16 * j + fr) * D + h * 128 + 4 * fq; const float i8 = inv * H8_SCALE;
#pragma unroll
        for (int d = 0; d < 8; ++d) { int p = __builtin_amdgcn_cvt_pk_fp8_f32(pg8::clamp448(st_.O[d][0] * i8), pg8::clamp448(st_.O[d][1] * i8), 0, false); p = __builtin_amdgcn_cvt_pk_fp8_f32(pg8::clamp448(st_.O[d][2] * i8), pg8::clamp448(st_.O[d][3] * i8), p, true); *(int*)(op + 16 * d) = p; }
#else
        bf16_t* op = NAOB + (size_t)(b * S + (qrowA + u) * 64 + 16 * j + fr) * D + h * 128 + 4 * fq;
#pragma unroll
        for (int d = 0; d < 8; ++d) { u32x2 wv; wv.x = pk2(st_.O[d][0] * inv, st_.O[d][1] * inv); wv.y = pk2(st_.O[d][2] * inv, st_.O[d][3] * inv); *(u32x2*)(op + 16 * d) = wv; }
#endif
    }
    return bufo == 0 ? 0 : 1;
}

__device__ __forceinline__ float sum8(float v) { v += __shfl_xor(v, 1); v += __shfl_xor(v, 2); v += __shfl_xor(v, 4); return v; }
__device__ __forceinline__ void p4_rows(Frame& F) {
    const int gw = F.bx * 8 + F.wave, NGW = F.G * 8;
    const bf16_t* OF = (const bf16_t*)(F.ws + WS_OF); const bf16_t* OB = (const bf16_t*)(F.ws + WS_OB); const bf16_t* YB = (const bf16_t*)(F.ws + WS_YB);
    bf16_t* A1B = (bf16_t*)(F.ws + WS_HB);
    for (int m = gw; m < NTOK; m += NGW) {
        const size_t o = (size_t)m * D + 32 * F.lane;
        u32x4 a[4], c[4], g[4];
#pragma unroll
        for (int q = 0; q < 4; ++q) { a[q] = *(const u32x4*)(OF + o + 8 * q); c[q] = *(const u32x4*)(OB + o + 8 * q); g[q] = *(const u32x4*)(YB + (size_t)m * INW + C_GR + 32 * F.lane + 8 * q); }
        float v[32]; float sm = 0.f;
#pragma unroll
        for (int q = 0; q < 4; ++q) { const unsigned aw[4] = {a[q].x, a[q].y, a[q].z, a[q].w}, cw[4] = {c[q].x, c[q].y, c[q].z, c[q].w};
#pragma unroll
            for (int t = 0; t < 4; ++t) { v[8 * q + 2 * t] = bf_lo(aw[t]) + bf_lo(cw[t]); v[8 * q + 2 * t + 1] = bf_hi(aw[t]) + bf_hi(cw[t]); sm += v[8 * q + 2 * t] + v[8 * q + 2 * t + 1]; } }
        const float mu = sum8(sm) * (1.0f / 256.0f); float sq = 0.f;
#pragma unroll
        for (int i = 0; i < 32; ++i) { v[i] -= mu; sq += v[i] * v[i]; }
        const float rstd = rsqrtf(sum8(sq) * (1.0f / 256.0f) + 1e-5f);
#pragma unroll
        for (int q = 0; q < 4; ++q) { const unsigned gw4[4] = {g[q].x, g[q].y, g[q].z, g[q].w};
#pragma unroll
            for (int t = 0; t < 4; ++t) { const float g0 = bf_lo(gw4[t]), g1 = bf_hi(gw4[t]); v[8 * q + 2 * t] *= rstd * g0 * pg8::sigm(g0); v[8 * q + 2 * t + 1] *= rstd * g1 * pg8::sigm(g1); } }
#if MK_FP8_PROJ
        unsigned w8[8];
#pragma unroll
        for (int q = 0; q < 8; ++q) { int p = __builtin_amdgcn_cvt_pk_fp8_f32(pg8::clamp448(v[4 * q] * H8_SCALE), pg8::clamp448(v[4 * q + 1] * H8_SCALE), 0, false);
            p = __builtin_amdgcn_cvt_pk_fp8_f32(pg8::clamp448(v[4 * q + 2] * H8_SCALE), pg8::clamp448(v[4 * q + 3] * H8_SCALE), p, true); w8[q] = (unsigned)p; }
        unsigned char* dst = (unsigned char*)A1B + o;
        *(u32x4*)dst = (u32x4){w8[0], w8[1], w8[2], w8[3]}; *(u32x4*)(dst + 16) = (u32x4){w8[4], w8[5], w8[6], w8[7]};
#else
#pragma unroll
        for (int q = 0; q < 4; ++q) { u32x4 wv; wv.x = pk2(v[8 * q], v[8 * q + 1]); wv.y = pk2(v[8 * q + 2], v[8 * q + 3]); wv.z = pk2(v[8 * q + 4], v[8 * q + 5]); wv.w = pk2(v[8 * q + 6], v[8 * q + 7]); *(u32x4*)(A1B + o + 8 * q) = wv; }
#endif
    }
}

constexpr size_t WS_QC = WS_MOD + 256 * 1024;
__device__ __forceinline__ void p1_router_const(Frame& F) {
    LAS float* red = (LAS float*)F.lds;
    const int b = F.bx >> 3, part = F.bx & 7, e = F.tid & 31, pt = F.tid >> 5; const float* md = (const float*)(F.ws + WS_MOD) + (size_t)b * MODW + 3 * D; const float* Wr = F.in[15];
    float sacc = 0.f;
#pragma unroll
    for (int q = 0; q < 16; ++q) { const int k = part * 256 + pt * 16 + q; sacc += md[k] * Wr[k * 32 + e]; }
    __syncthreads(); red[pt * 32 + e] = sacc; __syncthreads();
    if (F.tid < 32) { float q = 0.f;
#pragma unroll
        for (int p = 0; p < 16; ++p) q += red[p * 32 + F.tid];
        ((float*)(F.ws + WS_QC))[(b * 8 + part) * 32 + F.tid] = q; }
    __syncthreads();
}
__device__ __forceinline__ void p7_route(Frame& F) {
    LAS float* gs = (LAS float*)(F.lds);
    LAS float* shv = (LAS float*)(F.lds + 32768);
    LAS float* part = (LAS float*)(F.lds + 65536);
    LAS float* ssq = (LAS float*)(F.lds + 131072);
    LAS float* lgt = (LAS float*)(F.lds + 133120);
    LAS float* rsd = (LAS float*)(F.lds + 141312);
    const int tid = F.tid, lane = F.lane, w = F.wave, ri = lane & 15, kq = lane >> 4;
    const bf16_t* X1 = (const bf16_t*)(F.ws + WS_X1B); const float* g2 = F.in[7]; const float* Wr = F.in[15];
    const float* mod = (const float*)(F.ws + WS_MOD); const float* QC = (const float*)(F.ws + WS_QC);
    unsigned char* H2B = F.ws + WS_HB;
    int* asg_e = (int*)(F.ws + WS_ASG_E); int* asg_pos = (int*)(F.ws + WS_ASG_POS); float* asg_w = (float*)(F.ws + WS_ASG_W);
    unsigned* counts = F.ctl + CW_CNT;
    for (int g0 = F.bx; g0 < 256; g0 += F.G) {
        __syncthreads();
#pragma unroll
        for (int j = 0; j < 4; ++j) { const int i = 4 * (tid + 512 * j), bb = i >> 11, k = i & (D - 1); const float* md = mod + (size_t)bb * MODW;
            const f32x4 gg = *(const f32x4*)(g2 + k), sc = *(const f32x4*)(md + 4 * D + k), sh = *(const f32x4*)(md + 3 * D + k);
            *(LAS f32x4*)(gs + i) = gg * (sc + 1.0f); *(LAS f32x4*)(shv + i) = sh; }
        __syncthreads();
        f32x4 acc[4][2]; float ss[4];
#pragma unroll
        for (int g = 0; g < 4; ++g) { acc[g][0] = (f32x4){0.f, 0.f, 0.f, 0.f}; acc[g][1] = acc[g][0]; ss[g] = 0.f; }
        const bf16_t* xr = X1 + (size_t)(g0 * 16 + ri) * D + 256 * w + 4 * kq;
#pragma unroll 4
        for (int s = 0; s < 16; ++s) { const int k0 = 256 * w + 16 * s + 4 * kq;
            float b0[4], b1[4];
#pragma unroll
            for (int q = 0; q < 4; ++q) { b0[q] = Wr[(k0 + q) * 32 + ri]; b1[q] = Wr[(k0 + q) * 32 + 16 + ri]; }
#pragma unroll
            for (int g = 0; g < 4; ++g) { const u32x2 xw = *(const u32x2*)(xr + (size_t)g * (4096 * D) + 16 * s); const f32x4 xv = {bf_lo(xw.x), bf_hi(xw.x), bf_lo(xw.y), bf_hi(xw.y)}; const f32x4 gv = *(const LAS f32x4*)(gs + g * D + k0);
                ss[g] += (xv[0] * xv[0] + xv[1] * xv[1]) + (xv[2] * xv[2] + xv[3] * xv[3]);
#pragma unroll
                for (int q = 0; q < 4; ++q) { const float a = xv[q] * gv[q];
                    acc[g][0] = __builtin_amdgcn_mfma_f32_16x16x4f32(a, b0[q], acc[g][0], 0, 0, 0); acc[g][1] = __builtin_amdgcn_mfma_f32_16x16x4f32(a, b1[q], acc[g][1], 0, 0, 0); } } }
#pragma unroll
        for (int g = 0; g < 4; ++g) { float t = ss[g]; t += __shfl_xor(t, 16); t += __shfl_xor(t, 32);
#pragma unroll
            for (int q = 0; q < 4; ++q) { part[(w * 64 + g * 16 + 4 * kq + q) * 32 + ri] = acc[g][0][q]; part[(w * 64 + g * 16 + 4 * kq + q) * 32 + 16 + ri] = acc[g][1][q]; }
            if (kq == 0) ssq[w * 64 + g * 16 + ri] = t; }
        __syncthreads();
#pragma unroll
        for (int i = 0; i < 4; ++i) { const int row = (tid >> 5) + 16 * i, e = tid & 31; float sq = 0.f, pp = 0.f;
#pragma unroll
            for (int q = 0; q < 8; ++q) { sq += ssq[q * 64 + row]; pp += part[(q * 64 + row) * 32 + e]; }
            const float rstd = rsqrtf(sq * (1.0f / D) + 1e-6f);
            float qq = F.in[16][e];
#pragma unroll
            for (int q = 0; q < 8; ++q) qq += QC[(i * 8 + q) * 32 + e];
            lgt[row * 32 + e] = rstd * pp + qq; if (e == 0) rsd[row] = rstd; }
        __syncthreads();
        LAS unsigned* lcnt = (LAS unsigned*)(F.lds + 141568);
        if (tid < 32) lcnt[tid] = 0u;
        __syncthreads();
        LAS unsigned* sl = (LAS unsigned*)(F.lds + 141568 + 256);
        LAS float* wl = (LAS float*)(F.lds + 141568 + 256 + 1024);
        if (tid < 64) { int sel[4]; float val[4]; unsigned used = 0u;
#pragma unroll
            for (int k = 0; k < 4; ++k) { int bi = -1; float bv = 0.f;
                for (int e = 0; e < 32; ++e) { const float x = lgt[tid * 32 + e]; if (!((used >> e) & 1u) && (bi < 0 || x > bv)) { bi = e; bv = x; } }
                used |= 1u << bi; sel[k] = bi; val[k] = bv; }
            float den = 0.f, ex[4];
#pragma unroll
            for (int k = 0; k < 4; ++k) { ex[k] = __expf(val[k] - val[0]); den += ex[k]; }
#pragma unroll
            for (int k = 0; k < 4; ++k) { const unsigned lr = atomicAdd((unsigned*)&lcnt[sel[k]], 1u); sl[tid * 4 + k] = ((unsigned)sel[k] << 16) | lr; wl[tid * 4 + k] = ex[k] / den; } }
        __syncthreads();
        if (tid < 32) { const unsigned c = lcnt[tid]; lcnt[32 + tid] = c ? atomicAdd(&counts[CW_CNT_STRIDE * tid], c) : 0u; }
        __syncthreads();
        if (tid < 256) { const int row = tid >> 2, k = tid & 3, m = (g0 + 256 * (row >> 4)) * 16 + (row & 15); const unsigned v = sl[tid]; const int e = (int)(v >> 16);
            const int pos = (int)(lcnt[32 + e] + (v & 0xffffu));
            asg_e[m * 4 + k] = e; asg_pos[m * 4 + k] = pos; asg_w[m * 4 + k] = wl[tid];
            ((unsigned short*)(F.ws + WS_TOKL))[(size_t)(e * 64 + (pos >> 8)) * 256 + (pos & 63) * 4 + ((pos >> 6) & 3)] = (unsigned short)m; }
#pragma unroll 8
        for (int i = tid; i < 64 * (D / 8); i += 512) { const int row = i >> 8, g = row >> 4, k = (i & 255) * 8; const float rstd = rsd[row]; float y[8];
            const size_t xo = (size_t)((g0 + 256 * g) * 16 + (row & 15)) * D + k;
            const u32x4 xw = *(const u32x4*)(X1 + xo); const f32x4 xa = {bf_lo(xw.x), bf_hi(xw.x), bf_lo(xw.y), bf_hi(xw.y)}, xb = {bf_lo(xw.z), bf_hi(xw.z), bf_lo(xw.w), bf_hi(xw.w)};
            const f32x4 ga = *(const LAS f32x4*)(gs + g * D + k), gb = *(const LAS f32x4*)(gs + g * D + k + 4), sa = *(const LAS f32x4*)(shv + g * D + k), sb = *(const LAS f32x4*)(shv + g * D + k + 4);
#pragma unroll
            for (int q = 0; q < 4; ++q) { y[q] = pg8::clamp448((xa[q] * rstd * ga[q] + sa[q]) * H8_SCALE); y[4 + q] = pg8::clamp448((xb[q] * rstd * gb[q] + sb[q]) * H8_SCALE); }
            u32x2 wv; int p = __builtin_amdgcn_cvt_pk_fp8_f32(y[0], y[1], 0, false); p = __builtin_amdgcn_cvt_pk_fp8_f32(y[2], y[3], p, true); wv.x = (unsigned)p;
            p = __builtin_amdgcn_cvt_pk_fp8_f32(y[4], y[5], 0, false); p = __builtin_amdgcn_cvt_pk_fp8_f32(y[6], y[7], p, true); wv.y = (unsigned)p;
            *(u32x2*)(H2B + xo) = wv; }
    }
}

__device__ __forceinline__ void load_tp(Frame& F, LAS int* tp) {
    __syncthreads();
    if (F.tid == 0) { int a = 0; for (int e = 0; e < 32; ++e) { tp[e] = a; a += ((int)__hip_atomic_load(F.ctl + CW_CNT + CW_CNT_STRIDE * e, RLX_AGENT) + 255) >> 8; } tp[32] = a; }
    __syncthreads();
}
__device__ __forceinline__ void p8_gather(Frame& F, LAS int* tp) {
    const int gw = F.bx * 8 + F.wave, NGW = F.G * 8;
    const unsigned char* H2B = F.ws + WS_HB; unsigned char* XB = F.ws + WS_XB;
    const int* asg_e = (const int*)(F.ws + WS_ASG_E); const int* asg_pos = (const int*)(F.ws + WS_ASG_POS);
    for (int a0 = gw; a0 < NTOK * 4; a0 += 4 * NGW) {
        u32x4 v0[4], v1[4]; int slot[4];
#pragma unroll
        for (int u = 0; u < 4; ++u) { const int a = min(a0 + u * NGW, NTOK * 4 - 1); slot[u] = 256 * tp[asg_e[a]] + asg_pos[a];
            const u32x4* src = (const u32x4*)(H2B + (size_t)(a >> 2) * D) + F.lane; v0[u] = src[0]; v1[u] = src[64]; }
#pragma unroll
        for (int u = 0; u < 4; ++u) if (a0 + u * NGW < NTOK * 4) { u32x4* dst = (u32x4*)(XB + (size_t)slot[u] * D) + F.lane; dst[0] = v0[u]; dst[64] = v1[u]; }
    }
}
__device__ __forceinline__ void p11_final(Frame& F, LAS int* tp) {
    const int gw = F.bx * 8 + F.wave, NGW = F.G * 8;
    const bf16_t* YSB = (const bf16_t*)(F.ws + WS_XB);
    const int* asg_e = (const int*)(F.ws + WS_ASG_E); const int* asg_pos = (const int*)(F.ws + WS_ASG_POS); const float* asg_w = (const float*)(F.ws + WS_ASG_W);
    const float* mod = (const float*)(F.ws + WS_MOD); const float* fg = F.in[23];
    float tscale = 1.0f;
    if (MK_TPROBE >= 0) { const int k_ = MK_TPROBE < 10 ? MK_TPROBE : 9; const unsigned a_ = __hip_atomic_load(F.ctl + 3000 + 2 * k_, RLX_AGENT), b_ = __hip_atomic_load(F.ctl + 3000 + 2 * (MK_TPROBE < 10 ? k_ + 1 : 11), RLX_AGENT);
        tscale = MK_TPROBE_FINE ? 1.1f + (float)(((b_ - a_) + 200u) / 400u) * (4.0f / 2000.0f) : 1.1f + (float)(((b_ - a_) + 800u) / 1600u) * (16.0f / 8000.0f); }
    for (int m0 = gw; m0 < NTOK; m0 += 2 * NGW) {
        size_t so[2][4]; float wk[2][4];
#pragma unroll
        for (int u = 0; u < 2; ++u) { const int m = min(m0 + u * NGW, NTOK - 1);
#pragma unroll
            for (int k = 0; k < 4; ++k) { so[u][k] = (size_t)(256 * tp[asg_e[m * 4 + k]] + asg_pos[m * 4 + k]) * D; wk[u][k] = asg_w[m * 4 + k]; } }
        u32x2 t[2][8][4]; f32x4 x1v[2][8];
#pragma unroll
        for (int u = 0; u < 2; ++u) { const int m = min(m0 + u * NGW, NTOK - 1);
#pragma unroll
            for (int j = 0; j < 8; ++j) { const int n = 4 * F.lane + 256 * j; { const u32x2 xw = *(const u32x2*)((const bf16_t*)(F.ws + WS_X1B) + (size_t)m * D + n); x1v[u][j] = (f32x4){bf_lo(xw.x), bf_hi(xw.x), bf_lo(xw.y), bf_hi(xw.y)}; }
#pragma unroll
                for (int k = 0; k < 4; ++k) t[u][j][k] = *(const u32x2*)(YSB + so[u][k] + n); } }
#pragma unroll
        for (int u = 0; u < 2; ++u) { const int m = m0 + u * NGW; if (m >= NTOK) break;
            const float* g2v = mod + (size_t)(m / S) * MODW + 5 * D;
            f32x4 v[8]; float ss = 0.f;
#pragma unroll
            for (int j = 0; j < 8; ++j) { const int n = 4 * F.lane + 256 * j; f32x4 y = (f32x4){0.f, 0.f, 0.f, 0.f};
#pragma unroll
                for (int k = 0; k < 4; ++k) y += (f32x4){bf_lo(t[u][j][k].x), bf_hi(t[u][j][k].x), bf_lo(t[u][j][k].y), bf_hi(t[u][j][k].y)} * wk[u][k];
                v[j] = x1v[u][j] + *(const f32x4*)(g2v + n) * y;
                ss += (v[j][0] * v[j][0] + v[j][1] * v[j][1]) + (v[j][2] * v[j][2] + v[j][3] * v[j][3]); }
            const float rstd = rsqrtf(wave_sum(ss) * (1.0f / D) + 1e-6f);
#pragma unroll
            for (int j = 0; j < 8; ++j) { const int n = 4 * F.lane + 256 * j; *(f32x4*)(F.out + (size_t)m * D + n) = v[j] * (rstd * tscale) * *(const f32x4*)(fg + n); }
        }
    }
}

__device__ __forceinline__ void phase_skew(int bx, unsigned step_ticks) {
    const unsigned long long t0 = __builtin_amdgcn_s_memrealtime(), dt = (unsigned long long)((bx >> 3) & 7) * step_ticks;
    while (__builtin_amdgcn_s_memrealtime() - t0 < dt) __builtin_amdgcn_s_sleep(8);
}
#ifndef MK_KREP9
#define MK_KREP9 1
#endif
#ifndef MK_SKEW2
#define MK_SKEW2 0
#endif
#ifndef MK_SKEW9
#define MK_SKEW9 0
#endif
#ifndef MK_SKEW10
#define MK_SKEW10 0
#endif
struct Args { const float* in[24]; float* out; unsigned char* ws; int ph_lo, ph_hi; };
constexpr int NPH = 12;
__global__ void __launch_bounds__(512, 2) mk_fwd(Args args) {
    extern __shared__ __attribute__((aligned(16))) unsigned char lds[];
    Frame F;
    F.lds = (LAS unsigned char*)lds; F.MISC = (volatile LAS unsigned*)(F.lds + MISC_OFF);
    const int wave0 = __builtin_amdgcn_readfirstlane((int)threadIdx.x >> 6);
    F.lane = pg8::lane_id(); F.wave = wave0; F.tid = wave0 * 64 + F.lane; F.G = gridDim.x; F.bx = blockIdx.x;
    F.ws = args.ws; F.ctl = (unsigned*)(args.ws + WS_CTL); F.out = args.out;
    F.in = (const __attribute__((address_space(4))) fptr_t*)__builtin_amdgcn_kernarg_segment_ptr();
    for (int u = F.tid; u < (LDS_BYTES - MISC_OFF) / 4; u += 512) ((LAS unsigned*)(F.lds + MISC_OFF))[u] = 0u;
    __syncthreads();
    const int lo = args.ph_lo, hi = args.ph_hi;
    const bool multi = (hi - lo) > 1;
    XcdBarrier bar; bar.bar = F.ctl + CW_BAR; bar.x = 0; bar.st = nullptr;
    if (multi) bar = xcd_barrier_post(F.ctl + CW_BAR, F.MISC + 8, F.tid);
#ifndef MK_PHMASK
#define MK_PHMASK 0xfff
#endif
#define IN(k) (((MK_PHMASK >> (k)) & 1) && lo <= (k) && (k) < hi)
#define SEAM(k) do { if (IN(k) && IN((k) + 1)) xcd_barrier(bar, wave0 * 64 + pg8::lane_id()); \
    if (MK_TPROBE >= 0 && F.bx == 0 && wave0 == 0 && pg8::lane_id() == 0) { const unsigned long long t_ = __builtin_amdgcn_s_memrealtime(); __hip_atomic_store(F.ctl + 3000 + 2 * ((k) + 1), (unsigned)t_, RLX_AGENT); } } while (0)
    LAS int* tp = (LAS int*)(F.lds + MISC_OFF + 256);
#ifndef MK_REPMASK
#define MK_REPMASK 0x0
#ifndef MK_TPROBE
#define MK_TPROBE -1
#endif
#ifndef MK_FP8_PROJ
#define MK_FP8_PROJ 1
#endif
#ifndef MK_FP8_INPROJ
#define MK_FP8_INPROJ 1
#endif
#endif
#define REP(k) for (int rep_ = 0; rep_ < (((MK_REPMASK >> (k)) & 1) ? 2 : 1); ++rep_)
#define PHASE_IDS() do { int l_ = pg8::lane_id(); asm volatile("" : "+v"(l_)); F.lane = l_; F.wave = wave0; F.tid = wave0 * 64 + l_; } while (0)

    if (MK_TPROBE >= 0 && F.bx == 0 && F.tid == 0) __hip_atomic_store(F.ctl + 3000, (unsigned)__builtin_amdgcn_s_memrealtime(), RLX_AGENT);
    const int grp_ = F.bx >> 3; const bool split_ = MK_SPLIT && F.G == 256, conv_ = split_ && grp_ >= 32 - MK_SPLIT_NCG;
    const int bx0_ = F.bx, G0_ = F.G, crank_ = F.bx - 8 * (32 - MK_SPLIT_NCG);
    if (IN(0)) REP(0) { PHASE_IDS(); p0_prologue(F, !split_); } SEAM(0);
    if (split_) F.G = 8 * (32 - MK_SPLIT_NCG);
    if (IN(1)) REP(1) { PHASE_IDS(); if (conv_) p0_moe_items(F, crank_ * 8 + F.wave, 64 * MK_SPLIT_NCG, 0, MK_SPLIT_A); else { if (F.bx < 32) p1_router_const(F); p1_rows(F); } } SEAM(1);
    if (IN(2)) REP(2) { PHASE_IDS();
        if (conv_) p0_moe_items(F, crank_ * 8 + F.wave, 64 * MK_SPLIT_NCG, MK_SPLIT_A, MOE_ITEMS); else {
        if (MK_SKEW2) phase_skew(F.bx, MK_SKEW2);
        pg8::Gemm g{(const bf16_t*)(F.ws + WS_HB), (const bf16_t*)(F.ws + WS_WIN), D, nullptr, nullptr}; pg8::StaticOrder So; So.init(MR, INW, F.G, F.bx);
        pg8::EpiInProj E{(bf16_t*)(F.ws + WS_YB), INW, MK_FP8_INPROJ ? 1.0f / (W8_SCALE * H8_SCALE) : 1.0f, C_VR / 256, NTOK / 256, F.ws + WS_G8, H8_SCALE, (bf16_t*)(F.ws + WS_KV)};
        pg8::gemm_phase<pg8::EpiInProj, pg8::StaticOrder, true, true, MK_FP8_INPROJ != 0>(F.lds, g, So, E, F.wave); }
    } SEAM(2);
    F.bx = bx0_; F.G = G0_;
    if (IN(3)) REP(3) { PHASE_IDS();
        ConvCur cv; cv.cur = (F.bx * 8 + F.wave) * CONV_PER_WAVE; cv.end = cv.cur + CONV_PER_WAVE;
        if (F.G != 256) { cv.cur = (int)(((long)CONV_TOTAL * (F.bx * 8 + F.wave)) / (F.G * 8)); cv.end = (int)(((long)CONV_TOTAL * (F.bx * 8 + F.wave + 1)) / (F.G * 8)); }
        REP(12) for (int u = F.bx; u < 256; u += F.G) { const int x = u & 7, jj = u >> 3; ret_unit(F, (x + 8 * (jj >> 3)) >> 3, (x + 8 * (jj >> 3)) & 7, (jj & 7) >> 2, jj & 3, cv); }
        REP(13) { int par = 0; __syncthreads();
            for (int i = 0; ; ++i) { const int L_ = i * F.G + F.bx; if (L_ >= 1024) break; const int c = L_ % 256, ii = L_ / 256; const int Ln = L_ + F.G, cn = Ln % 256, in_ = Ln / 256;
                par = na_unit(F, (16 * ii + (c & 15)) >> 4, (16 * ii + (c & 15)) & 15, c >> 4, par, i == 0, Ln < 1024, (16 * in_ + (cn & 15)) >> 4, (16 * in_ + (cn & 15)) & 15, cn >> 4); } }
        for (; cv.cur < cv.end; ++cv.cur) { float r[16]; conv_issue(F, cv.cur, r); conv_commit(F, cv.cur, r); }
        __syncthreads();
    } SEAM(3);
    if (IN(4)) REP(4) { PHASE_IDS(); p4_rows(F); } SEAM(4);
    if (IN(5)) REP(5) { PHASE_IDS();
        pg8::StaticOrder So; So.init(NTOK, D, F.G, F.bx);
#if MK_FP8_PROJ
        pg8::ChainOrder Sc; Sc.init(NTOK, D, F.G, F.bx);
        pg8::Gemm g{(const bf16_t*)(F.ws + WS_HB), (const bf16_t*)(F.ws + WS_WPA), D, (const bf16_t*)(F.ws + WS_NAOB), (const bf16_t*)(F.ws + WS_WPB)};
        pg8::EpiMerge8 E{F.ws + WS_OF, D, F.ws + WS_G8 + 2048, F.ws + WS_G8 + 4096, G8W, 1.0f / (W8_SCALE * H8_SCALE), H8_SCALE, 1.0f / H8_SCALE};
        pg8::gemm_phase<pg8::EpiMerge8, pg8::ChainOrder, true, true, true>(F.lds, g, Sc, E, F.wave);
#else
        { pg8::Gemm g{(const bf16_t*)(F.ws + WS_HB), (const bf16_t*)(F.ws + WS_WPA), D, nullptr, nullptr}; pg8::EpiGate<false, false> E{(bf16_t*)(F.ws + WS_T1), D, (const bf16_t*)(F.ws + WS_YB) + C_GA, INW, 1.0f, nullptr, 1.0f};
          pg8::gemm_phase<pg8::EpiGate<false, false>, pg8::StaticOrder, true, true, false>(F.lds, g, So, E, F.wave); }
        { pg8::Gemm g{(const bf16_t*)(F.ws + WS_NAOB), (const bf16_t*)(F.ws + WS_WPB), D, nullptr, nullptr}; pg8::EpiGate<true, false> E{(bf16_t*)(F.ws + WS_T1), D, (const bf16_t*)(F.ws + WS_YB) + C_GB, INW, 1.0f, nullptr, 1.0f};
          pg8::gemm_phase<pg8::EpiGate<true, false>, pg8::StaticOrder, true, true, false>(F.lds, g, So, E, F.wave); }
#endif
    } SEAM(5);
    if (IN(6)) REP(6) { PHASE_IDS();
        constexpr bool P8 = MK_FP8_PROJ != 0;
        pg8::Gemm g{(const bf16_t*)(F.ws + (P8 ? WS_OF : WS_T1)), (const bf16_t*)(F.ws + WS_WO), D, nullptr, nullptr}; pg8::StaticOrder So; So.init(NTOK, D, F.G, F.bx);
        pg8::EpiResid E{F.in[0], (bf16_t*)(F.ws + WS_X1B), D, (const float*)(F.ws + WS_MOD) + 2 * D, MODW, S, P8 ? 1.0f / (W8_SCALE * H8_SCALE) : 1.0f};
        pg8::gemm_phase<pg8::EpiResid, pg8::StaticOrder, true, true, P8>(F.lds, g, So, E, F.wave);
    } SEAM(6);
    if (IN(7)) REP(7) { PHASE_IDS(); p7_route(F); } SEAM(7);
    if (IN(9)) REP(9) { PHASE_IDS();
        load_tp(F, tp);
        if (MK_SKEW9) phase_skew(F.bx, MK_SKEW9);
        pg8::Gemm g{(const bf16_t*)(F.ws + WS_HB), (const bf16_t*)(F.ws + WS_WGU), D, nullptr, nullptr, (const unsigned short*)(F.ws + WS_TOKL)}; pg8::GroupedOrder So; So.init(16, F.G, F.bx, tp, tp + 64, F.tid);
        pg8::EpiSwiglu8 E{F.ws + WS_ACTB, FF, F.in[18], F.in[20], FF, 1.0f / (W8_SCALE * H8_SCALE * MK_KREP9), A8_SCALE};
        pg8::gemm_phase<pg8::EpiSwiglu8, pg8::GroupedOrder, true, true, true, MK_KREP9, true>(F.lds, g, So, E, F.wave);
    } SEAM(9);
    if (IN(10)) REP(10) { PHASE_IDS();
        load_tp(F, tp);
        if (MK_SKEW10) phase_skew(F.bx, MK_SKEW10);
        pg8::Gemm g{(const bf16_t*)(F.ws + WS_ACTB), (const bf16_t*)(F.ws + WS_WDN), FF, nullptr, nullptr}; pg8::GroupedOrder So; So.init(8, F.G, F.bx, tp, tp + 64, F.tid);
        pg8::EpiBf16B E{(bf16_t*)(F.ws + WS_XB), D, F.in[22], D, 1.0f / (W8_SCALE * A8_SCALE)};
        pg8::gemm_phase<pg8::EpiBf16B, pg8::GroupedOrder, true, true, true>(F.lds, g, So, E, F.wave);
    } SEAM(10);
    if (IN(11)) REP(11) { PHASE_IDS(); load_tp(F, tp); p11_final(F, tp); }
#undef IN
#undef SEAM
}
}

extern "C" void kernel_launch(void* const* d_in, const int* in_sizes, int n_in, void* d_out, int out_size, void* d_ws, size_t ws_size, hipStream_t stream) {
    using namespace mk;
    (void)in_sizes; (void)n_in; (void)out_size; (void)ws_size;
    static int grid = 0;
    if (grid == 0) {
        int dev = 0, cus = 0, per_cu = 0;
        if (hipGetDevice(&dev) != hipSuccess || hipDeviceGetAttribute(&cus, hipDeviceAttributeMultiprocessorCount, dev) != hipSuccess) { grid = -1; return; }
        if (hipFuncSetAttribute((const void*)mk_fwd, hipFuncAttributeMaxDynamicSharedMemorySize, LDS_BYTES) != hipSuccess) { fprintf(stderr, "kernel_launch: hipFuncSetAttribute failed\n"); grid = -1; return; }
        if (hipOccupancyMaxActiveBlocksPerMultiprocessor(&per_cu, (const void*)mk_fwd, 512, LDS_BYTES) != hipSuccess || per_cu < 1) fprintf(stderr, "kernel_launch: occupancy query reports %d\n", per_cu);
        (void)hipGetLastError();
        grid = cus;
    }
    if (grid < 0) return;
    unsigned char* ws = (unsigned char*)d_ws;
    (void)hipMemsetAsync(ws + WS_CTL, 0, CTL_ZERO_BYTES, stream);
    Args a{};
    for (int i = 0; i < 24; ++i) a.in[i] = (const float*)d_in[i];
    a.out = (float*)d_out; a.ws = ws;
    auto run = [&](int lo, int hi) { a.ph_lo = lo; a.ph_hi = hi; hipLaunchKernelGGL(mk_fwd, dim3(grid), dim3(512), LDS_BYTES, stream, a); };
    run(0, NPH);
}
```

```cpp
#include <hip/hip_runtime.h>
#include <stdint.h>
#include <stdio.h>

#define MK_REPMASK 0x0
#ifndef MK_SPLIT
#define MK_SPLIT 1
#endif
#ifndef MK_SPLIT_NCG
#define MK_SPLIT_NCG 10
#endif
#ifndef MK_SPLIT_A
#define MK_SPLIT_A 11520
#endif
#ifndef MK_TPROBE_FINE
#define MK_TPROBE_FINE 1
#endif
#ifndef MK_TPROBE
#define MK_TPROBE -1
#endif
#ifndef MK_FP8_PROJ
#define MK_FP8_PROJ 1
#endif
#ifndef MK_FP8_INPROJ
#define MK_FP8_INPROJ 1
#endif

namespace pg8 {
#define PG8_LAS __attribute__((address_space(3)))
__device__ __forceinline__ int lane_id() { int l; asm volatile("v_mbcnt_lo_u32_b32 %0, -1, 0\n\tv_mbcnt_hi_u32_b32 %0, -1, %0" : "=v"(l)); return l; }
typedef unsigned short bf16_t;
typedef short bf16x8 __attribute__((ext_vector_type(8)));
typedef float f32x4 __attribute__((ext_vector_type(4)));
typedef unsigned u32x4 __attribute__((ext_vector_type(4)));
typedef unsigned u32x2 __attribute__((ext_vector_type(2)));
constexpr int BM = 256, BK = 64, HALF = 128, HTB = HALF * BK * 2, STAGE_BYTES = 8 * HTB, NXCD = 8, WGM = 4;

__host__ __device__ __forceinline__ int lds_byte(int r, int c) { const int st = (r >> 4) * 2 + (c >> 5), rr = r & 15, cc = c & 31, ob = rr * 64 + cc * 2; return st * 1024 + (ob ^ (((ob >> 9) & 1) << 5)); }
__host__ __device__ __forceinline__ void stage_rc(int b, int& R, int& C) { const int st = b / 1024, sb = b % 1024, swz = sb ^ (((sb >> 9) & 1) << 5); R = (st >> 1) * 16 + swz / 64; C = (st & 1) * 32 + (swz % 64) / 2; }
__host__ __device__ __forceinline__ int perm32(int rho) { const int n = rho >> 4, i = rho & 15; return 8 * (i >> 2) + 4 * n + (i & 3); }

struct Unit { int pm, pn, pb, e, half; };
struct Gemm { const bf16_t* A; const bf16_t* Bt; int K; const bf16_t* A2; const bf16_t* Bt2; const unsigned short* list; };

struct StaticOrder {
    int nM, nN, nwg, G, c;
    __device__ void init(int M, int N, int G_, int c_) { nM = M / BM; nN = N / BM; nwg = nM * nN; G = G_; c = c_; }
    __device__ bool next(int i, Unit& u) const {
        const long L = (long)i * G + c; if (L >= nwg) return false;
        int wgid = (int)L; { const int q = nwg / NXCD, r = nwg % NXCD, xcd = wgid % NXCD, off = wgid / NXCD; wgid = (xcd < r ? xcd * (q + 1) : r * (q + 1) + (xcd - r) * q) + off; }
        const int nig = WGM * nN, gid = wgid / nig, fm = gid * WGM, gsz = (nM - fm) < WGM ? (nM - fm) : WGM;
        u.pm = fm + ((wgid % nig) % gsz); u.pn = (wgid % nig) / gsz; u.pb = u.pn; u.e = 0; u.half = 0; return true;
    }
};
struct ChainOrder : StaticOrder {
    __device__ bool next(int i, Unit& u) const { if (!StaticOrder::next(i >> 1, u)) return false; u.half = i & 1; return true; }
};
struct GroupedOrder {
    int NP, G, c, U, nu; const PG8_LAS int* tp; PG8_LAS int* ul;
    __device__ bool calc(int i, Unit& u) const {
        const int L = i * G + c; if (L >= U) return false;
        int w; { const int q = U / NXCD, r = U % NXCD, xcd = L % NXCD, off = L / NXCD; w = (xcd < r ? xcd * (q + 1) : r * (q + 1) + (xcd - r) * q) + off; }
        int e = 0; while (e < 31 && NP * tp[e + 1] <= w) ++e;
        const int local = w - NP * tp[e], nrt = tp[e + 1] - tp[e];
        const int pn = local / nrt, rt = tp[e] + (local - pn * nrt);
        u.pm = rt; u.pn = pn; u.pb = e * NP + pn; u.e = e; u.half = 0; return true;
    }
    __device__ void init(int NP_, int G_, int c_, const PG8_LAS int* tp_, PG8_LAS int* ul_, int tid_) { NP = NP_; G = G_; c = c_; tp = tp_; ul = ul_; U = __builtin_amdgcn_readfirstlane(NP_ * tp_[32]);
        nu = U > c ? (U - c + G - 1) / G : 0;
        __syncthreads();
        if (tid_ < nu && tid_ < 32) { Unit u; calc(tid_, u); ul[4 * tid_] = u.pm; ul[4 * tid_ + 1] = u.pn; ul[4 * tid_ + 2] = u.pb; ul[4 * tid_ + 3] = u.e; }
        __syncthreads(); }
    __device__ bool next(int i, Unit& u) const {
        if (i >= nu) return false;
        u.pm = __builtin_amdgcn_readfirstlane(ul[4 * i]); u.pn = __builtin_amdgcn_readfirstlane(ul[4 * i + 1]); u.pb = __builtin_amdgcn_readfirstlane(ul[4 * i + 2]); u.e = __builtin_amdgcn_readfirstlane(ul[4 * i + 3]); u.half = 0; return true;
    }
};

__device__ __forceinline__ unsigned cvt_pk_bf16(float lo, float hi) { unsigned r; asm volatile("v_cvt_pk_bf16_f32 %0, %1, %2" : "=v"(r) : "v"(lo), "v"(hi)); return r; }
__device__ __forceinline__ float bf_lo(unsigned w) { return __uint_as_float(w << 16); }
__device__ __forceinline__ float bf_hi(unsigned w) { return __uint_as_float(w & 0xffff0000u); }
__device__ __forceinline__ float sigm(float x) { return __builtin_amdgcn_rcpf(1.0f + __expf(-x)); }
__device__ __forceinline__ float clamp448(float v) { return fminf(fmaxf(v, -448.0f), 448.0f); }
typedef float f32x2d __attribute__((ext_vector_type(2)));
__device__ __forceinline__ void dec8(unsigned w, float (&o)[4]) { const f32x2d lo = __builtin_amdgcn_cvt_pk_f32_fp8((int)w, false), hi = __builtin_amdgcn_cvt_pk_f32_fp8((int)w, true); o[0] = lo.x; o[1] = lo.y; o[2] = hi.x; o[3] = hi.y; }

struct EpiBf16B {
    static constexpr bool PERM = true, CHAIN = false;
    bf16_t* O; int ldc; const float* bias; int bias_stride; float scale;
    __device__ __forceinline__ void operator()(const f32x4 (&acc)[2][2][4][2], const Unit& u, int wr, int wc, int fr, int fq) const {
        asm volatile("" : "+v"(fr), "+v"(fq));
        const int row0 = u.pm * BM + wr * 64 + fr, col0 = u.pn * BM + wc * 32 + 8 * fq;
        f32x4 bv[2][2];
#pragma unroll
        for (int bj = 0; bj < 2; ++bj)
#pragma unroll
            for (int n = 0; n < 2; ++n) bv[bj][n] = bias ? *(const f32x4*)(bias + (size_t)u.e * bias_stride + col0 + bj * HALF + 4 * n) : (f32x4){0.f, 0.f, 0.f, 0.f};
#pragma unroll
        for (int ai = 0; ai < 2; ++ai)
#pragma unroll
            for (int m = 0; m < 4; ++m) { bf16_t* rowp = O + (size_t)(row0 + ai * HALF + m * 16) * ldc + col0;
#pragma unroll
                for (int bj = 0; bj < 2; ++bj) { const f32x4 v0 = acc[ai][bj][m][0] * scale + bv[bj][0], v1 = acc[ai][bj][m][1] * scale + bv[bj][1];
                    u32x4 w; w.x = cvt_pk_bf16(v0[0], v0[1]); w.y = cvt_pk_bf16(v0[2], v0[3]); w.z = cvt_pk_bf16(v1[0], v1[1]); w.w = cvt_pk_bf16(v1[2], v1[3]);
                    *(u32x4*)(rowp + bj * HALF) = w; } }
    }
};
struct EpiInProj {
    static constexpr bool PERM = true, CHAIN = false;
    bf16_t* O; int ldc; float scale; int rope_pn, rope_pm; unsigned char* G8; float gscale; bf16_t* KV;
    __device__ __forceinline__ void operator()(const f32x4 (&acc)[2][2][4][2], const Unit& u, int wr, int wc, int fr, int fq) const {
        asm volatile("" : "+v"(fr), "+v"(fq));
        const int row0 = u.pm * BM + wr * 64 + fr, col0 = u.pn * BM + wc * 32 + 8 * fq;
        const bool rope = u.pn < rope_pn && u.pm < rope_pm;
        const int gt = u.pn >= 48 ? u.pn - 40 : -1;
        if (gt >= 0) {
            if (u.pm >= rope_pm) return;
            const float gs = scale * gscale; const int gc0 = gt * BM + wc * 32 + 8 * fq;
#pragma unroll
            for (int ai = 0; ai < 2; ++ai)
#pragma unroll
                for (int m = 0; m < 4; ++m) { unsigned char* rowp = G8 + (size_t)(row0 + ai * HALF + m * 16) * 6144 + gc0;
#pragma unroll
                    for (int bj = 0; bj < 2; ++bj) { const f32x4 v0 = acc[ai][bj][m][0] * gs, v1 = acc[ai][bj][m][1] * gs; u32x2 w8;
                        int p = __builtin_amdgcn_cvt_pk_fp8_f32(clamp448(v0[0]), clamp448(v0[1]), 0, false); p = __builtin_amdgcn_cvt_pk_fp8_f32(clamp448(v0[2]), clamp448(v0[3]), p, true); w8.x = (unsigned)p;
                        p = __builtin_amdgcn_cvt_pk_fp8_f32(clamp448(v1[0]), clamp448(v1[1]), 0, false); p = __builtin_amdgcn_cvt_pk_fp8_f32(clamp448(v1[2]), clamp448(v1[3]), p, true); w8.y = (unsigned)p;
                        *(u32x2*)(rowp + bj * HALF) = w8; } }
            return; }
        const bool kv = u.pn >= 32 && u.pn < 48;
        const int kb_ = u.pm < 64 ? u.pm >> 4 : u.pm - 64, ktok0 = u.pm < 64 ? (u.pm & 15) * 256 : 4096;
        bf16_t* kvb = KV + ((size_t)((kb_ * 16 + 2 * (u.pn & 7)) * 4352 + ktok0) * 256 + (u.pn >= 40 ? 128 : 0));
        const size_t bjs = kv ? (size_t)4352 * 256 : (size_t)HALF;
        int fqz = fq;
        float invrev[4];
#pragma unroll
        for (int i = 0; i < 4; ++i) invrev[i] = __builtin_amdgcn_exp2f(-(float)(16 * (wc & 1) + 4 * fqz + i) * (13.287712379549449f / 32.0f)) * 0.15915494309189535f;
#pragma unroll
        for (int ai = 0; ai < 2; ++ai)
#pragma unroll
            for (int m = 0; m < 4; ++m) { bf16_t* rowp = kv ? kvb + (size_t)(wr * 64 + fr + ai * HALF + m * 16) * 256 + wc * 32 + 8 * fq : O + (size_t)(row0 + ai * HALF + m * 16) * ldc + col0;
                float cs[4], sn[4];
                if (rope) { const float pos = (float)((wc >> 1) ? (m * 16 + fr) : ((u.pm * 4 + ai * 2 + wr) & 63));
#pragma unroll
                    for (int i = 0; i < 4; ++i) { const float rev = pos * invrev[i]; cs[i] = __builtin_amdgcn_cosf(rev); sn[i] = __builtin_amdgcn_sinf(rev); } }
#pragma unroll
                for (int bj = 0; bj < 2; ++bj) { f32x4 v0 = acc[ai][bj][m][0] * scale, v1 = acc[ai][bj][m][1] * scale;
                    if (rope) { const f32x4 a = v0, b = v1;
                        v0[0] = a[0] * cs[0] - a[1] * sn[0]; v0[1] = a[1] * cs[0] + a[0] * sn[0]; v0[2] = a[2] * cs[1] - a[3] * sn[1]; v0[3] = a[3] * cs[1] + a[2] * sn[1];
                        v1[0] = b[0] * cs[2] - b[1] * sn[2]; v1[1] = b[1] * cs[2] + b[0] * sn[2]; v1[2] = b[2] * cs[3] - b[3] * sn[3]; v1[3] = b[3] * cs[3] + b[2] * sn[3]; }
                    u32x4 w; w.x = cvt_pk_bf16(v0[0], v0[1]); w.y = cvt_pk_bf16(v0[2], v0[3]); w.z = cvt_pk_bf16(v1[0], v1[1]); w.w = cvt_pk_bf16(v1[2], v1[3]);
                    *(u32x4*)(rowp + (size_t)bj * bjs) = w; } }
    }
};
template <bool ADD, bool OUT8 = false> struct EpiGate {
    static constexpr bool PERM = true, CHAIN = false;
    bf16_t* T; int ldc; const bf16_t* gate; int gld; float scale; unsigned char* O8; float out_scale;
    __device__ __forceinline__ void operator()(const f32x4 (&acc)[2][2][4][2], const Unit& u, int wr, int wc, int fr, int fq) const {
        asm volatile("" : "+v"(fr), "+v"(fq));
        const int row0 = u.pm * BM + wr * 64 + fr, col0 = u.pn * BM + wc * 32 + 8 * fq;
#pragma unroll
        for (int ai = 0; ai < 2; ++ai)
#pragma unroll
            for (int m = 0; m < 4; ++m) { const size_t r = (size_t)(row0 + ai * HALF + m * 16); bf16_t* rowp = T + r * ldc + col0; const bf16_t* gp = gate + r * gld + col0;
#pragma unroll
                for (int bj = 0; bj < 2; ++bj) { const u32x4 g = *(const u32x4*)(gp + bj * HALF); const f32x4 a0 = acc[ai][bj][m][0] * scale, a1 = acc[ai][bj][m][1] * scale;
                    float o[8];
                    o[0] = sigm(bf_lo(g.x)) * a0[0]; o[1] = sigm(bf_hi(g.x)) * a0[1]; o[2] = sigm(bf_lo(g.y)) * a0[2]; o[3] = sigm(bf_hi(g.y)) * a0[3];
                    o[4] = sigm(bf_lo(g.z)) * a1[0]; o[5] = sigm(bf_hi(g.z)) * a1[1]; o[6] = sigm(bf_lo(g.w)) * a1[2]; o[7] = sigm(bf_hi(g.w)) * a1[3];
                    if (ADD) { const u32x4 t = *(const u32x4*)(rowp + bj * HALF);
                        o[0] += bf_lo(t.x); o[1] += bf_hi(t.x); o[2] += bf_lo(t.y); o[3] += bf_hi(t.y); o[4] += bf_lo(t.z); o[5] += bf_hi(t.z); o[6] += bf_lo(t.w); o[7] += bf_hi(t.w); }
                    if (OUT8) { u32x2 w8; int p = __builtin_amdgcn_cvt_pk_fp8_f32(clamp448(o[0] * out_scale), clamp448(o[1] * out_scale), 0, false); p = __builtin_amdgcn_cvt_pk_fp8_f32(clamp448(o[2] * out_scale), clamp448(o[3] * out_scale), p, true); w8.x = (unsigned)p;
                        p = __builtin_amdgcn_cvt_pk_fp8_f32(clamp448(o[4] * out_scale), clamp448(o[5] * out_scale), 0, false); p = __builtin_amdgcn_cvt_pk_fp8_f32(clamp448(o[6] * out_scale), clamp448(o[7] * out_scale), p, true); w8.y = (unsigned)p;
                        *(u32x2*)(O8 + r * ldc + col0 + bj * HALF) = w8; }
                    else { u32x4 w; w.x = cvt_pk_bf16(o[0], o[1]); w.y = cvt_pk_bf16(o[2], o[3]); w.z = cvt_pk_bf16(o[4], o[5]); w.w = cvt_pk_bf16(o[6], o[7]);
                        *(u32x4*)(rowp + bj * HALF) = w; } } }
    }
};
struct EpiMerge8 {
    static constexpr bool PERM = true, CHAIN = true;
    unsigned char* O8; int ldc; const unsigned char* ga; const unsigned char* gb; int gld; float scale, out_scale, ginv;
    __device__ __forceinline__ void mid(f32x4 (&acc)[2][2][4][2], const Unit& u, int wr, int wc, int fr, int fq) const {
        asm volatile("" : "+v"(fr), "+v"(fq));
        const int row0 = u.pm * BM + wr * 64 + fr, col0 = u.pn * BM + wc * 32 + 8 * fq;
#pragma unroll
        for (int ai = 0; ai < 2; ++ai)
#pragma unroll
            for (int m = 0; m < 4; ++m) { const size_t r = (size_t)(row0 + ai * HALF + m * 16);
#pragma unroll
                for (int bj = 0; bj < 2; ++bj) { const u32x2 a = *(const u32x2*)(ga + r * gld + col0 + bj * HALF), b = *(const u32x2*)(gb + r * gld + col0 + bj * HALF);
                    float av[8], bv[8]; { float t4[4]; dec8(a.x, t4); av[0] = t4[0]; av[1] = t4[1]; av[2] = t4[2]; av[3] = t4[3]; dec8(a.y, t4); av[4] = t4[0]; av[5] = t4[1]; av[6] = t4[2]; av[7] = t4[3];
                        dec8(b.x, t4); bv[0] = t4[0]; bv[1] = t4[1]; bv[2] = t4[2]; bv[3] = t4[3]; dec8(b.y, t4); bv[4] = t4[0]; bv[5] = t4[1]; bv[6] = t4[2]; bv[7] = t4[3]; }
#pragma unroll
                    for (int t = 0; t < 8; ++t) {
                        const float r0 = (1.0f + __expf(-bv[t] * ginv)) * __builtin_amdgcn_rcpf(1.0f + __expf(-av[t] * ginv));
                        acc[ai][bj][m][t >> 2][t & 3] *= r0; } } }
    }
    __device__ __forceinline__ void operator()(const f32x4 (&acc)[2][2][4][2], const Unit& u, int wr, int wc, int fr, int fq) const {
        asm volatile("" : "+v"(fr), "+v"(fq));
        const int row0 = u.pm * BM + wr * 64 + fr, col0 = u.pn * BM + wc * 32 + 8 * fq; const float sc = scale * out_scale;
#pragma unroll
        for (int ai = 0; ai < 2; ++ai)
#pragma unroll
            for (int m = 0; m < 4; ++m) { const size_t r = (size_t)(row0 + ai * HALF + m * 16);
#pragma unroll
                for (int bj = 0; bj < 2; ++bj) { const u32x2 b = *(const u32x2*)(gb + r * gld + col0 + bj * HALF); float bv[8], o[8]; { float t4[4]; dec8(b.x, t4); bv[0] = t4[0]; bv[1] = t4[1]; bv[2] = t4[2]; bv[3] = t4[3]; dec8(b.y, t4); bv[4] = t4[0]; bv[5] = t4[1]; bv[6] = t4[2]; bv[7] = t4[3]; }
#pragma unroll
                    for (int t = 0; t < 8; ++t) o[t] = clamp448(acc[ai][bj][m][t >> 2][t & 3] * sc * __builtin_amdgcn_rcpf(1.0f + __expf(-bv[t] * ginv)));
                    u32x2 w8; int p = __builtin_amdgcn_cvt_pk_fp8_f32(o[0], o[1], 0, false); p = __builtin_amdgcn_cvt_pk_fp8_f32(o[2], o[3], p, true); w8.x = (unsigned)p;
                    p = __builtin_amdgcn_cvt_pk_fp8_f32(o[4], o[5], 0, false); p = __builtin_amdgcn_cvt_pk_fp8_f32(o[6], o[7], p, true); w8.y = (unsigned)p;
                    *(u32x2*)(O8 + r * ldc + col0 + bj * HALF) = w8; } }
    }
};
struct EpiResid {
    static constexpr bool PERM = false, CHAIN = false;
    const float* x; bf16_t* out; int ldc; const float* gvec; int gstride; int rows_per_batch; float scale;
    __device__ __forceinline__ void operator()(const f32x4 (&acc)[2][2][4][2], const Unit& u, int wr, int wc, int fr, int fq) const {
        asm volatile("" : "+v"(fr), "+v"(fq));
        const int row0 = u.pm * BM + wr * 64 + fr, col0 = u.pn * BM + wc * 32 + 4 * fq;
        const float* gp = gvec + (size_t)((u.pm * BM) / rows_per_batch) * gstride + col0;
        f32x4 gv[2][2];
#pragma unroll
        for (int bj = 0; bj < 2; ++bj)
#pragma unroll
            for (int n = 0; n < 2; ++n) gv[bj][n] = *(const f32x4*)(gp + bj * HALF + n * 16) * scale;
#pragma unroll
        for (int ai = 0; ai < 2; ++ai)
#pragma unroll
            for (int m = 0; m < 4; ++m) { const size_t off = (size_t)(row0 + ai * HALF + m * 16) * ldc + col0;
#pragma unroll
                for (int bj = 0; bj < 2; ++bj)
#pragma unroll
                    for (int n = 0; n < 2; ++n) { const f32x4 xv = *(const f32x4*)(x + off + bj * HALF + n * 16); const f32x4 r = xv + gv[bj][n] * acc[ai][bj][m][n];
                        u32x2 w; w.x = cvt_pk_bf16(r[0], r[1]); w.y = cvt_pk_bf16(r[2], r[3]); *(u32x2*)(out + off + bj * HALF + n * 16) = w; } }
    }
};
struct EpiSwiglu {
    static constexpr bool PERM = true, CHAIN = false;
    bf16_t* O; int ldc; const float* bgate; const float* bup; int bias_stride;
    __device__ __forceinline__ void operator()(const f32x4 (&acc)[2][2][4][2], const Unit& u, int wr, int wc, int fr, int fq) const {
        asm volatile("" : "+v"(fr), "+v"(fq));
        const int row0 = u.pm * BM + wr * 64 + fr, col0 = u.pn * HALF + wc * 32 + 8 * fq;
        f32x4 bg[2], bu[2];
#pragma unroll
        for (int n = 0; n < 2; ++n) { bg[n] = *(const f32x4*)(bgate + (size_t)u.e * bias_stride + col0 + 4 * n); bu[n] = *(const f32x4*)(bup + (size_t)u.e * bias_stride + col0 + 4 * n); }
#pragma unroll
        for (int ai = 0; ai < 2; ++ai)
#pragma unroll
            for (int m = 0; m < 4; ++m) { float o[8];
#pragma unroll
                for (int n = 0; n < 2; ++n)
#pragma unroll
                    for (int j = 0; j < 4; ++j) { const float gt = fminf(acc[ai][0][m][n][j] + bg[n][j], 7.0f), up = fminf(fmaxf(acc[ai][1][m][n][j] + bu[n][j], -7.0f), 7.0f);
                        o[4 * n + j] = gt * sigm(1.702f * gt) * (up + 1.0f); }
                u32x4 w; w.x = cvt_pk_bf16(o[0], o[1]); w.y = cvt_pk_bf16(o[2], o[3]); w.z = cvt_pk_bf16(o[4], o[5]); w.w = cvt_pk_bf16(o[6], o[7]);
                *(u32x4*)(O + (size_t)(row0 + ai * HALF + m * 16) * ldc + col0) = w; }
    }
};

struct EpiSwiglu8 {
    static constexpr bool PERM = true, CHAIN = false;
    unsigned char* O; int ldc; const float* bgate; const float* bup; int bias_stride; float in_scale, out_scale;
    __device__ __forceinline__ void operator()(const f32x4 (&acc)[2][2][4][2], const Unit& u, int wr, int wc, int fr, int fq) const {
        asm volatile("" : "+v"(fr), "+v"(fq));
        const int row0 = u.pm * BM + wr * 64 + fr, col0 = u.pn * HALF + wc * 32 + 8 * fq;
        f32x4 bg[2], bu[2];
#pragma unroll
        for (int n = 0; n < 2; ++n) { bg[n] = *(const f32x4*)(bgate + (size_t)u.e * bias_stride + col0 + 4 * n); bu[n] = *(const f32x4*)(bup + (size_t)u.e * bias_stride + col0 + 4 * n); }
#pragma unroll
        for (int ai = 0; ai < 2; ++ai)
#pragma unroll
            for (int m = 0; m < 4; ++m) { float o[8];
#pragma unroll
                for (int n = 0; n < 2; ++n)
#pragma unroll
                    for (int j = 0; j < 4; ++j) { const float gt = fminf(acc[ai][0][m][n][j] * in_scale + bg[n][j], 7.0f), up = fminf(fmaxf(acc[ai][1][m][n][j] * in_scale + bu[n][j], -7.0f), 7.0f);
                        const float sg = __builtin_amdgcn_rcpf(1.0f + __builtin_amdgcn_exp2f(gt * (-1.702f * 1.4426950408889634f)));
                        o[4 * n + j] = (gt * sg) * (up * out_scale + out_scale); }
                u32x2 w; int p = __builtin_amdgcn_cvt_pk_fp8_f32(o[0], o[1], 0, false); p = __builtin_amdgcn_cvt_pk_fp8_f32(o[2], o[3], p, true); w.x = (unsigned)p;
                p = __builtin_amdgcn_cvt_pk_fp8_f32(o[4], o[5], 0, false); p = __builtin_amdgcn_cvt_pk_fp8_f32(o[6], o[7], p, true); w.y = (unsigned)p;
                *(u32x2*)(O + (size_t)(row0 + ai * HALF + m * 16) * ldc + col0) = w; }
    }
};

typedef int i32x4 __attribute__((ext_vector_type(4)));
typedef int i32x8 __attribute__((ext_vector_type(8)));
__device__ __forceinline__ i32x8 cat32(bf16x8 a, bf16x8 b) { const i32x4 x = __builtin_bit_cast(i32x4, a), y = __builtin_bit_cast(i32x4, b); return __builtin_shufflevector(x, y, 0, 1, 2, 3, 4, 5, 6, 7); }
template <class Epi, class Sched, bool ALIGN_EPI = false, bool SP2 = false, bool FP8 = false, int KREP = 1, bool GATHER = false>
__device__ __forceinline__ void gemm_phase(PG8_LAS unsigned char* lds, const Gemm g, const Sched& S, const Epi& E, int wave_) {
    const int wid = wave_, lane = lane_id(), tid = wid * 64 + lane, wr = wid >> 2, wc = wid & 3, fr = lane & 15, fq = lane >> 4;
    constexpr int KD = 2048;
    constexpr int RB = FP8 ? KD : KD * 2, nt = RB / 128;
    unsigned voffA[2], voffB[2];
#pragma unroll
    for (int i = 0; i < 2; ++i) { int R, C; stage_rc(tid * 16 + i * 8192, R, C); const int Rb = Epi::PERM ? ((R & ~31) + perm32(R & 31)) : R;
        voffA[i] = (unsigned)(R * RB + C * 2); voffB[i] = (unsigned)(Rb * RB + C * 2); }
    constexpr size_t kstep = (size_t)(BK * 2);
    constexpr size_t hstep = (size_t)HALF * RB;
    constexpr size_t tstep = 2 * hstep;
    const unsigned ldsw = (unsigned)wid * 1024u;
    const int aoff = lds_byte(wr * 64 + fr, fq * 8), boff = lds_byte(wc * 32 + fr, fq * 8);
#define PG8_SA(b, h) (((b) * 2 + (h)) * HTB)
#define PG8_SB(b, h) ((4 + (b) * 2 + (h)) * HTB)
#define PG8_STAGE(bufoff, gbase, voff) do { _Pragma("unroll") for (int _i = 0; _i < 2; ++_i) { unsigned _o = (voff)[_i]; asm volatile("" : "+v"(_o));   \
        __builtin_amdgcn_global_load_lds((const unsigned*)((const char*)(gbase) + _o), (PG8_LAS unsigned*)(lds + (bufoff) + ldsw + _i * 8192), 16, 0, 0); } } while (0)
#define PG8_STAGE_G(bufoff, gbase, tkw) do { { unsigned _o = (((tkw) << 11) & 0x01fff800u) | cbA; asm volatile("" : "+v"(_o)); \
        __builtin_amdgcn_global_load_lds((const unsigned*)((const char*)(gbase) + _o), (PG8_LAS unsigned*)(lds + (bufoff) + ldsw), 16, 0, 0); } \
      { unsigned _o = (((tkw) >> 5) & 0x01fff800u) | cbA; asm volatile("" : "+v"(_o)); \
        __builtin_amdgcn_global_load_lds((const unsigned*)((const char*)(gbase) + _o), (PG8_LAS unsigned*)(lds + (bufoff) + ldsw + 8192), 16, 0, 0); } } while (0)
#define PG8_STAGE_A(bufoff, gbase, h) do { if constexpr (GATHER) PG8_STAGE_G(bufoff, gbase, tk[h]); else PG8_STAGE(bufoff, (gbase) + (h) * hstep, voffA); } while (0)
#define PG8_LD32(p) cat32(*(const PG8_LAS bf16x8*)(p), *(const PG8_LAS bf16x8*)((p) + 1024))
#define PG8_LDA(dst, b, h) do { _Pragma("unroll") for (int m = 0; m < 4; ++m) dst[m] = PG8_LD32(lds + PG8_SA(b, h) + aoff + m * 2048); } while (0)
#define PG8_LDB(dst, b, h) do { _Pragma("unroll") for (int n = 0; n < 2; ++n) dst[n] = PG8_LD32(lds + PG8_SB(b, h) + boff + n * 2048); } while (0)
#define PG8_LO(v) __builtin_bit_cast(bf16x8, __builtin_shufflevector(v, v, 0, 1, 2, 3))
#define PG8_HI(v) __builtin_bit_cast(bf16x8, __builtin_shufflevector(v, v, 4, 5, 6, 7))
#define PG8_MMA(ai, bj, At, Bt) do { __builtin_amdgcn_s_setprio(1); _Pragma("unroll") for (int m = 0; m < 4; ++m) _Pragma("unroll") for (int n = 0; n < 2; ++n) { \
        if constexpr (FP8) acc[ai][bj][m][n] = __builtin_amdgcn_mfma_scale_f32_16x16x128_f8f6f4(Bt[n], At[m], acc[ai][bj][m][n], 0, 0, 0, 0, 0, 0); \
        else { acc[ai][bj][m][n] = __builtin_amdgcn_mfma_f32_16x16x32_bf16(PG8_LO(Bt[n]), PG8_LO(At[m]), acc[ai][bj][m][n], 0, 0, 0); \
               acc[ai][bj][m][n] = __builtin_amdgcn_mfma_f32_16x16x32_bf16(PG8_HI(Bt[n]), PG8_HI(At[m]), acc[ai][bj][m][n], 0, 0, 0); } } \
        __builtin_amdgcn_s_setprio(0); } while (0)
#define PG8_WAIT_V(n) asm volatile("s_waitcnt vmcnt(" #n ")" ::: "memory")
#define PG8_WAIT_L(n) asm volatile("s_waitcnt lgkmcnt(" #n ")" ::: "memory")
#define PG8_BAR __builtin_amdgcn_s_barrier()
#define PG8_SCHED __builtin_amdgcn_sched_barrier(0)
    Unit cur, nxt; int ui = 0;
    if (!S.next(0, cur)) return;
    f32x4 acc[2][2][4][2];
#pragma unroll
    for (int a = 0; a < 2; ++a)
#pragma unroll
        for (int b = 0; b < 2; ++b)
#pragma unroll
            for (int m = 0; m < 4; ++m)
#pragma unroll
                for (int n = 0; n < 2; ++n) acc[a][b][m][n] = (f32x4){0.f, 0.f, 0.f, 0.f};
    i32x8 At[4], B0[2], B1[2];
    unsigned tk[2] = {0u, 0u}; unsigned cbA = 0u;
    if constexpr (GATHER) {
        { int R0_, C0_; stage_rc(tid * 16, R0_, C0_); cbA = (unsigned)(C0_ * 2); }
        unsigned tv[8];
#pragma unroll
        for (int k = 0; k < 8; ++k) { const int i = (tid >> 7) + 4 * k; tv[k] = 0u;
            if (i < S.nu) { const int pm_ = S.ul[4 * i], e_ = S.ul[4 * i + 3]; tv[k] = ((const unsigned*)g.list)[(size_t)(e_ * 64 + (pm_ - S.tp[e_])) * 128 + (tid & 127)] & 0x3fff3fffu; } }
#pragma unroll
        for (int k = 0; k < 8; ++k) { const int i = (tid >> 7) + 4 * k; if (i < S.nu) *(PG8_LAS unsigned*)(lds + 131072 + 512 * i + 4 * (tid & 127)) = tv[k]; }
        __syncthreads();
        { int R0_, C0_; stage_rc(tid * 16, R0_, C0_); const u32x2 t_ = *(const PG8_LAS u32x2*)(lds + 131072 + 8 * R0_); tk[0] = t_.x; tk[1] = t_.y; }
    }
    const char* cA = GATHER ? (const char*)g.A : (const char*)(cur.half ? g.A2 : g.A) + (size_t)cur.pm * tstep; const char* cB = (const char*)(cur.half ? g.Bt2 : g.Bt) + (size_t)cur.pb * tstep;
    if constexpr (SP2) {
        PG8_STAGE(PG8_SB(0, 0), cB, voffB); PG8_STAGE(PG8_SB(0, 1), cB + hstep, voffB); PG8_STAGE_A(PG8_SA(0, 0), cA, 0); PG8_STAGE_A(PG8_SA(0, 1), cA, 1);
        if (wr == 1) PG8_BAR;
        PG8_WAIT_V(2); PG8_BAR;
        PG8_STAGE(PG8_SB(1, 0), cB + kstep, voffB); PG8_STAGE(PG8_SB(1, 1), cB + hstep + kstep, voffB);
        PG8_WAIT_V(6); PG8_BAR;
    } else {
        PG8_STAGE(PG8_SB(0, 0), cB, voffB); PG8_STAGE(PG8_SA(0, 0), cA, voffA); PG8_STAGE(PG8_SB(0, 1), cB + hstep, voffB); PG8_STAGE(PG8_SA(0, 1), cA + hstep, voffA);
        if (wr == 1) PG8_BAR;
        PG8_WAIT_V(4); PG8_BAR;
        PG8_STAGE(PG8_SB(1, 0), cB + kstep, voffB); PG8_STAGE(PG8_SA(1, 0), cA + kstep, voffA); PG8_STAGE(PG8_SB(1, 1), cB + hstep + kstep, voffB);
        PG8_WAIT_V(6); PG8_BAR;
    }
    for (;;) {
        const bool has_next = S.next(ui + 1, nxt);
        const char* nA = GATHER ? cA : (has_next ? (const char*)(nxt.half ? g.A2 : g.A) + (size_t)nxt.pm * tstep : cA); const char* nB = has_next ? (const char*)(nxt.half ? g.Bt2 : g.Bt) + (size_t)nxt.pb * tstep : cB;
        for (int tt = 0; tt < nt * KREP; tt += 2) {
            const int t = KREP == 1 ? tt : tt % nt;
            const bool last = (t == nt - 2);
            const bool lastrep = KREP == 1 || tt >= nt * (KREP - 1);
            const char* a1 = cA + (size_t)(t + 1) * kstep;
            const char* a2 = last ? (lastrep ? nA : cA) : cA + (size_t)(t + 2) * kstep; const char* b2 = last ? (lastrep ? nB : cB) : cB + (size_t)(t + 2) * kstep;
            const char* a3 = a2 + kstep; const char* b3 = b2 + kstep;
            if constexpr (SP2) {
            PG8_LDB(B0, 0, 0); PG8_LDB(B1, 0, 1); PG8_SCHED; PG8_LDA(At, 0, 0); PG8_STAGE_A(PG8_SA(1, 0), a1, 0); PG8_STAGE_A(PG8_SA(1, 1), a1, 1);
            if constexpr (GATHER) { if (last && lastrep && has_next) { int R0_, C0_; stage_rc(tid * 16, R0_, C0_); asm volatile("" : "+v"(R0_)); const u32x2 t_ = *(const PG8_LAS u32x2*)(lds + 131072 + 512 * (ui + 1) + 8 * R0_); tk[0] = t_.x; tk[1] = t_.y; } }
            PG8_WAIT_V(8); PG8_WAIT_L(0); PG8_BAR; PG8_MMA(0, 0, At, B0); PG8_MMA(0, 1, At, B1); PG8_BAR; PG8_SCHED;
            PG8_LDA(At, 0, 1); PG8_STAGE(PG8_SB(0, 0), b2, voffB); PG8_STAGE(PG8_SB(0, 1), b2 + hstep, voffB);
            PG8_WAIT_V(6); PG8_WAIT_L(0); PG8_BAR; PG8_MMA(1, 0, At, B0); PG8_MMA(1, 1, At, B1); PG8_BAR; PG8_SCHED;
            PG8_LDB(B0, 1, 0); PG8_LDB(B1, 1, 1); PG8_SCHED; PG8_LDA(At, 1, 0); PG8_STAGE_A(PG8_SA(0, 0), a2, 0); PG8_STAGE_A(PG8_SA(0, 1), a2, 1);
            PG8_WAIT_V(8); PG8_WAIT_L(0); PG8_BAR; PG8_MMA(0, 0, At, B0); PG8_MMA(0, 1, At, B1); PG8_BAR; PG8_SCHED;
            PG8_LDA(At, 1, 1); PG8_STAGE(PG8_SB(1, 0), b3, voffB); PG8_STAGE(PG8_SB(1, 1), b3 + hstep, voffB);
            PG8_WAIT_V(6); PG8_WAIT_L(0); PG8_BAR; PG8_MMA(1, 0, At, B0); PG8_MMA(1, 1, At, B1); PG8_BAR; PG8_SCHED;
            } else {
            PG8_LDB(B0, 0, 0); PG8_SCHED; PG8_LDA(At, 0, 0); PG8_STAGE(PG8_SA(1, 1), a1 + hstep, voffA);
            PG8_WAIT_L(8); PG8_BAR; PG8_WAIT_L(0); PG8_MMA(0, 0, At, B0); PG8_BAR; PG8_SCHED;
            PG8_LDB(B1, 0, 1); PG8_STAGE(PG8_SB(0, 0), b2, voffB);
            PG8_BAR; PG8_WAIT_L(0); PG8_MMA(0, 1, At, B1); PG8_BAR;
            PG8_LDA(At, 0, 1); PG8_STAGE(PG8_SA(0, 0), a2, voffA);
            PG8_BAR; PG8_WAIT_L(0); PG8_MMA(1, 0, At, B0); PG8_BAR; PG8_SCHED;
            PG8_STAGE(PG8_SB(0, 1), b2 + hstep, voffB);
            PG8_WAIT_V(6); PG8_BAR; PG8_MMA(1, 1, At, B1); PG8_BAR;
            PG8_LDB(B0, 1, 0); PG8_SCHED; PG8_LDA(At, 1, 0); PG8_STAGE(PG8_SA(0, 1), a2 + hstep, voffA);
            PG8_WAIT_L(8); PG8_BAR; PG8_WAIT_L(0); PG8_MMA(0, 0, At, B0); PG8_BAR; PG8_SCHED;
            PG8_LDB(B1, 1, 1); PG8_STAGE(PG8_SB(1, 0), b3, voffB);
            PG8_BAR; PG8_WAIT_L(0); PG8_MMA(0, 1, At, B1); PG8_BAR;
            PG8_LDA(At, 1, 1); PG8_STAGE(PG8_SA(1, 0), a3, voffA);
            PG8_BAR; PG8_WAIT_L(0); PG8_MMA(1, 0, At, B0); PG8_BAR; PG8_SCHED;
            PG8_STAGE(PG8_SB(1, 1), b3 + hstep, voffB);
            PG8_WAIT_V(6); PG8_BAR; PG8_MMA(1, 1, At, B1); PG8_BAR;
            }
        }
        if constexpr (ALIGN_EPI) { if (wr == 0) PG8_BAR; }
        bool keep = false;
        if constexpr (Epi::CHAIN) { if (cur.half == 0) { E.mid(acc, cur, wr, wc, fr, fq); keep = true; } else E(acc, cur, wr, wc, fr, fq); }
        else E(acc, cur, wr, wc, fr, fq);
        if (!has_next) break;
        if (!keep) {
#pragma unroll
        for (int a = 0; a < 2; ++a)
#pragma unroll
            for (int b = 0; b < 2; ++b)
#pragma unroll
                for (int m = 0; m < 4; ++m)
#pragma unroll
                    for (int n = 0; n < 2; ++n) acc[a][b][m][n] = (f32x4){0.f, 0.f, 0.f, 0.f};
        }
        cur = nxt; cA = nA; cB = nB; ++ui;
        if constexpr (ALIGN_EPI) { if (wr == 1) PG8_BAR; }
    }
    PG8_WAIT_V(0);
    if constexpr (!ALIGN_EPI) { if (wr == 0) PG8_BAR; }
    PG8_BAR;
#undef PG8_SA
#undef PG8_SB
#undef PG8_STAGE
#undef PG8_STAGE_G
#undef PG8_STAGE_A
#undef PG8_LDA
#undef PG8_LD32
#undef PG8_LO
#undef PG8_HI
#undef PG8_LDB
#undef PG8_MMA
#undef PG8_WAIT_V
#undef PG8_WAIT_L
#undef PG8_BAR
#undef PG8_SCHED
}
}

namespace mk {
using pg8::bf16_t; using pg8::bf16x8; using pg8::f32x4; using pg8::u32x4; using pg8::u32x2; using pg8::cvt_pk_bf16; using pg8::bf_lo; using pg8::bf_hi;
constexpr int D = 2048, NB = 4, S = 4096, L = 256, NTOK = NB * S, NCTX = NB * L, MR = NTOK + NCTX;
constexpr int INW = 16384, MODW = 12288;
constexpr int RH = 8, NH = 16;
constexpr int NE = 32, FF = 2048, NSLOT256 = 288 * 256;
constexpr int C_QR = 0, C_KR = 1024, C_VR = 2048, C_GR = 4096, C_QN = 6144, C_KN = 8192, C_VN = 10240, C_GA = 12288, C_GB = 14336;
constexpr float QK_SCALE = 0.08838834764831845f, LOG2E = 1.4426950408889634f;
constexpr int CONV_P3_MATS_ = 0;
constexpr float W8_SCALE = 256.0f, H8_SCALE = 16.0f, A8_SCALE = 4.0f;
constexpr size_t MiB = 1u << 20;
constexpr size_t WS_CTL = 0, CTL_ZERO_BYTES = 1 * MiB;
constexpr size_t WS_MOD = 1 * MiB;
constexpr size_t WS_ASG_E = 2 * MiB, WS_ASG_POS = 3 * MiB, WS_ASG_W = 4 * MiB;
constexpr size_t WS_TOKL = 5 * MiB;
constexpr size_t WS_WIN = 16 * MiB;
constexpr size_t WS_WPA = 80 * MiB, WS_WPB = 88 * MiB, WS_WO = 96 * MiB;
constexpr size_t WS_WGU = 104 * MiB;
constexpr size_t WS_WDN = 616 * MiB;
constexpr size_t WS_HB = 872 * MiB;
constexpr size_t WS_YB = 940 * MiB;
constexpr size_t WS_XB = 940 * MiB, WS_ACTB = 1228 * MiB;
constexpr size_t WS_OF = 1484 * MiB, WS_OB = 1548 * MiB, WS_NAOB = 1612 * MiB, WS_T1 = 1676 * MiB;
constexpr size_t WS_X1B = 1676 * MiB;
constexpr size_t WS_KV = 1840 * MiB;
constexpr size_t WS_G8 = 1744 * MiB;
constexpr int G8W = 6144;
constexpr int CW_CNT = 64, CW_CNT_STRIDE = 64;
constexpr int CW_BAR = 4096;
constexpr int LDS_BYTES = 155648, MISC_OFF = 153600;

#define GAS __attribute__((address_space(1)))
#define LAS __attribute__((address_space(3)))
typedef GAS unsigned gu32;
#define RLX_AGENT __ATOMIC_RELAXED, __HIP_MEMORY_SCOPE_AGENT

__device__ __forceinline__ unsigned f2bf(float f) { unsigned u = __float_as_uint(f); return (u + 0x7fffu + ((u >> 16) & 1u)) >> 16; }
typedef __bf16 bf16x2_hw __attribute__((ext_vector_type(2)));
typedef float f32x2_hw __attribute__((ext_vector_type(2)));
__device__ __forceinline__ unsigned pk2(float lo, float hi) { const f32x2_hw v = {lo, hi}; const bf16x2_hw b = __builtin_convertvector(v, bf16x2_hw); return __builtin_bit_cast(unsigned, b); }
__device__ __forceinline__ float ex2(float x) { return __builtin_amdgcn_exp2f(x); }
__device__ __forceinline__ float wave_sum(float v) {
#pragma unroll
    for (int o = 1; o < 64; o <<= 1) v += __shfl_xor(v, o);
    return v;
}

#define XB_TMO      128
#define XB_XCNT(j)  (256  + 64 * (j))
#define XB_XSUB(j)  (1280 + 64 * (j))
#define XB_XGEN(j)  (2304 + 64 * (j))
#define XB_TOP      3328
#define XB_TOPGEN   3392
#define XCD_BAR_WORDS 3456
#define XB_SPIN_CAP (1u << 18)
__device__ __forceinline__ unsigned xb_ld(unsigned* p)              { return __hip_atomic_load(p, __ATOMIC_RELAXED, __HIP_MEMORY_SCOPE_AGENT); }
__device__ __forceinline__ unsigned xb_add(unsigned* p, unsigned v) { return __hip_atomic_fetch_add(p, v, __ATOMIC_RELAXED, __HIP_MEMORY_SCOPE_AGENT); }
__device__ __forceinline__ unsigned xb_xcc_id() { return (unsigned)__builtin_amdgcn_s_getreg((3 << 11) | 20) & 0xFu; }
#define XB_SPIN(cond, bar) do { unsigned _sp = 0; while (cond) { __builtin_amdgcn_s_sleep(1); \
    if ((++_sp & 255u) == 0u) { if (xb_ld(&(bar)[XB_TMO])) break; if (_sp > XB_SPIN_CAP) { atomicAdd(&(bar)[XB_TMO], 1u); break; } } } } while (0)
struct XcdBarrier { unsigned* bar; unsigned x; volatile LAS unsigned* st; };
__device__ __forceinline__ XcdBarrier xcd_barrier_post(unsigned* bar, volatile LAS unsigned* st, int tid_) {
    XcdBarrier b; b.bar = bar; b.x = xb_xcc_id(); b.st = st;
    if (tid_ == 0) (void)xb_add(&bar[XB_XCNT(b.x)], 1u);
    return b;
}
__device__ __forceinline__ void xcd_barrier_complete(unsigned* bar, unsigned x, unsigned& nloc, unsigned& nx) {
    const unsigned G = gridDim.x * gridDim.y * gridDim.z;
    unsigned sum, cnt, mine, sp = 0u;
    for (;;) {
        sum = 0u; cnt = 0u; mine = 0u;
#pragma unroll
        for (unsigned j = 0; j < 16; ++j) { const unsigned c = xb_ld(&bar[XB_XCNT(j)]); sum += c; cnt += (c > 0u) ? 1u : 0u; mine = (j == x) ? c : mine; }
        if (sum == G) break;
        __builtin_amdgcn_s_sleep(1);
        if ((++sp & 255u) == 0u) { if (xb_ld(&bar[XB_TMO])) break; if (sp > XB_SPIN_CAP) { atomicAdd(&bar[XB_TMO], 1u); break; } }
    }
    nloc = mine > 0u ? mine : 1u; nx = cnt > 0u ? cnt : 1u;
}
__device__ __forceinline__ void xcd_barrier(const XcdBarrier& b, int tid_) {
    asm volatile("s_waitcnt vmcnt(0)" ::: "memory");
    __syncthreads();
    if (tid_ == 0) {
        unsigned* bar = b.bar;
        __builtin_amdgcn_s_waitcnt(0);
        unsigned nloc = b.st[0], nx = b.st[1];
        if (nloc == 0u) { xcd_barrier_complete(bar, b.x, nloc, nx); b.st[0] = nloc; b.st[1] = nx; }
        const unsigned old = xb_add(&bar[XB_XSUB(b.x)], 1u);
        const unsigned gen = old / nloc;
        if (old + 1u == (gen + 1u) * nloc) {
            __builtin_amdgcn_fence(__ATOMIC_RELEASE, "agent");
            asm volatile("s_waitcnt vmcnt(0)" ::: "memory");
            const unsigned og = xb_add(&bar[XB_TOP], 1u);
            const unsigned tg = og / nx;
            if (og + 1u == (tg + 1u) * nx) xb_add(&bar[XB_TOPGEN], 1u);
            else XB_SPIN(xb_ld(&bar[XB_TOPGEN]) == tg, bar);
            __builtin_amdgcn_fence(__ATOMIC_ACQUIRE, "agent");
            xb_add(&bar[XB_XGEN(b.x)], 1u);
            asm volatile("s_waitcnt vmcnt(0)" ::: "memory");
        } else {
            XB_SPIN(xb_ld(&bar[XB_XGEN(b.x)]) == gen, bar);
            __builtin_amdgcn_fence(__ATOMIC_ACQUIRE, "agent");
            asm volatile("s_waitcnt vmcnt(0)" ::: "memory");
        }
    }
    __syncthreads();
}

typedef const float* fptr_t;
struct Frame {
    LAS unsigned char* lds;
    volatile LAS unsigned* MISC;
    unsigned* ctl;
    unsigned char* ws;
    int tid, lane, wave, G, bx;
    const __attribute__((address_space(4))) fptr_t* in;
    float* out;
};
#define LDS_WAIT() asm volatile("s_waitcnt lgkmcnt(0)" ::: "memory")

__device__ __forceinline__ void p0_transpose_item(const float* W, int K, int N, bf16_t* WT, int k0, int n0, size_t drow0, float scale, LAS float* scr, int lane, int rstride = 1) {
#pragma unroll 8
    for (int i = 0; i < 32; ++i) { const int kk = 2 * i + (lane >> 5); scr[kk * 33 + (lane & 31)] = W[(size_t)(k0 + kk) * N + n0 + (lane & 31)]; }
    LDS_WAIT(); asm volatile("" ::: "memory");
    const int c = lane & 7;
#pragma unroll
    for (int j = 0; j < 4; ++j) { const int n = (lane >> 3) + 8 * j; const LAS float* s = scr + (8 * c) * 33 + n;
        u32x4 o; o.x = pk2(s[0 * 33] * scale, s[1 * 33] * scale); o.y = pk2(s[2 * 33] * scale, s[3 * 33] * scale); o.z = pk2(s[4 * 33] * scale, s[5 * 33] * scale); o.w = pk2(s[6 * 33] * scale, s[7 * 33] * scale);
        *(u32x4*)(WT + (drow0 + (size_t)(n * rstride)) * (size_t)K + k0 + 8 * c) = o; }
    LDS_WAIT(); asm volatile("" ::: "memory");
}

__device__ __forceinline__ void p0_transpose_item8(const float* W, int K, int N, unsigned char* WT, int k0, int n0, size_t drow0, float scale, LAS float* scr, int lane, int rstride = 1) {
#pragma unroll 8
    for (int i = 0; i < 64; ++i) { const int kk = 2 * i + (lane >> 5); scr[kk * 33 + (lane & 31)] = W[(size_t)(k0 + kk) * N + n0 + (lane & 31)]; }
    LDS_WAIT(); asm volatile("" ::: "memory");
    const int c = lane & 7;
#pragma unroll
    for (int j = 0; j < 4; ++j) { const int n = (lane >> 3) + 8 * j; const LAS float* s = scr + (16 * c) * 33 + n; unsigned o[4];
#pragma unroll
        for (int q = 0; q < 4; ++q) { int p = __builtin_amdgcn_cvt_pk_fp8_f32(pg8::clamp448(s[(4 * q) * 33] * scale), pg8::clamp448(s[(4 * q + 1) * 33] * scale), 0, false);
            p = __builtin_amdgcn_cvt_pk_fp8_f32(pg8::clamp448(s[(4 * q + 2) * 33] * scale), pg8::clamp448(s[(4 * q + 3) * 33] * scale), p, true); o[q] = (unsigned)p; }
        *(u32x4*)(WT + (drow0 + (size_t)(n * rstride)) * (size_t)K + k0 + 16 * c) = (u32x4){o[0], o[1], o[2], o[3]}; }
    LDS_WAIT(); asm volatile("" ::: "memory");
}

__device__ __forceinline__ void p0_mod_slab(Frame& F, int slab) {
    LAS float* sv = (LAS float*)F.lds;
    LAS float* red = (LAS float*)(F.lds + 40960);
    const float* c = F.in[1]; const float* cc = F.in[3]; const float* W = F.in[4]; const float* bias = F.in[5];
    for (int i = F.tid; i < 5 * D; i += 512) { const int r = i / D, k = i % D; const float v = r < 4 ? c[r * D + k] : cc[k]; sv[i] = v / (1.0f + __expf(-v)); }
    __syncthreads();
    const int rr = F.tid >> 4, cq = F.tid & 15, col0 = slab * 64 + 4 * cq;
    f32x4 a[5];
#pragma unroll
    for (int r = 0; r < 5; ++r) a[r] = (f32x4){0.f, 0.f, 0.f, 0.f};
#pragma unroll 4
    for (int it = 0; it < 64; ++it) { const int k = rr + 32 * it; const f32x4 w = *(const f32x4*)(W + (size_t)k * MODW + col0);
#pragma unroll
        for (int r = 0; r < 5; ++r) a[r] += w * sv[r * D + k]; }
#pragma unroll
    for (int r = 0; r < 5; ++r) *(LAS f32x4*)(red + (rr * 5 + r) * 64 + 4 * cq) = a[r];
    __syncthreads();
    if (F.tid < 320) { const int r = F.tid >> 6, cl = F.tid & 63; float s = 0.f;
        for (int q = 0; q < 32; ++q) s += red[(q * 5 + r) * 64 + cl];
        ((float*)(F.ws + WS_MOD))[r * MODW + slab * 64 + cl] = s + bias[slab * 64 + cl]; }
    __syncthreads();
}

__device__ __forceinline__ void p0_prologue(Frame& F, bool conv_moe) {
    __syncthreads();
    if (F.bx < 192) p0_mod_slab(F, F.bx);
    LAS float* scr = (LAS float*)(F.lds + F.wave * 16896);
    const int gw = F.bx * 8 + F.wave, NGW = F.G * 8;
    constexpr int I_IN = (D / (MK_FP8_INPROJ ? 128 : 64)) * (INW / 32), I_SQ = (D / 64) * (D / 32);
    const int NIT = I_IN + 3 * (MK_FP8_PROJ ? I_SQ / 2 : I_SQ) + (conv_moe ? (96 - CONV_P3_MATS_) * (I_SQ / 2) : 0);
    LAS float* scr8 = (LAS float*)(F.lds + F.wave * 16896);
    for (int it = gw; it < NIT; it += NGW) {
        int r = it;
        if (r < I_IN) { const int kb = r / (INW / 32), nb = r % (INW / 32), n0 = nb * 32; const float wsc = (n0 >= C_KR && n0 < C_VR) ? QK_SCALE : ((n0 >= C_QN && n0 < C_KN) ? QK_SCALE * LOG2E : 1.0f);
            const bool rp = n0 < C_VR; const int d0 = n0 & 127; const size_t drow = rp ? (size_t)(n0 - d0 + (d0 >> 6) * 64 + ((d0 >> 5) & 1)) : (size_t)n0; const int rst = rp ? 2 : 1;
#if MK_FP8_INPROJ
            p0_transpose_item8(F.in[8], D, INW, F.ws + WS_WIN, kb * 128, n0, drow, wsc * W8_SCALE, scr8, F.lane, rst); continue; }
#else
            p0_transpose_item(F.in[8], D, INW, (bf16_t*)(F.ws + WS_WIN), kb * 64, n0, drow, wsc, scr, F.lane, rst); continue; }
#endif
        r -= I_IN;
#if MK_FP8_PROJ
        if (r < 3 * (I_SQ / 2)) { const int mtx = r / (I_SQ / 2), q = r % (I_SQ / 2), kb = q / 64, nb = q % 64;
            p0_transpose_item8(mtx == 0 ? F.in[9] : (mtx == 1 ? F.in[10] : F.in[11]), D, D, F.ws + WS_WPA + (size_t)mtx * 8 * MiB, kb * 128, nb * 32, (size_t)nb * 32, W8_SCALE, scr8, F.lane); continue; }
        r -= 3 * (I_SQ / 2);
#else
        if (r < 3 * I_SQ) { const int mtx = r / I_SQ, q = r % I_SQ, kb = q / 64, nb = q % 64;
            p0_transpose_item(mtx == 0 ? F.in[9] : (mtx == 1 ? F.in[10] : F.in[11]), D, D, (bf16_t*)(F.ws + WS_WPA + (size_t)mtx * 8 * MiB), kb * 64, nb * 32, (size_t)nb * 32, 1.0f, scr, F.lane); continue; }
        r -= 3 * I_SQ;
#endif
        { constexpr int I_8 = I_SQ / 2;
          const int m = CONV_P3_MATS_ + r / I_8, q2 = r % I_8, kind = m >> 5, e = m & 31, kb = q2 / 64, nb = q2 % 64, n0 = nb * 32;
          if (kind < 2) { const float* src = (kind == 0 ? F.in[17] : F.in[19]) + (size_t)e * D * FF;
              const size_t drow = (size_t)e * 4096 + (size_t)(n0 >> 7) * 256 + (size_t)(kind * 128) + (size_t)(n0 & 127);
              p0_transpose_item8(src, D, FF, F.ws + WS_WGU, kb * 128, n0, drow, W8_SCALE, scr8, F.lane); }
          else { const float* src = F.in[21] + (size_t)e * FF * D;
              p0_transpose_item8(src, FF, D, F.ws + WS_WDN, kb * 128, n0, (size_t)e * 2048 + n0, W8_SCALE, scr8, F.lane); } }
    }
}

__device__ __forceinline__ void p0_item8_fast(const float* W, int N, unsigned char* WT, int K, int k0, int n0, size_t drow0, float scale, LAS unsigned char* t8, int lane) {
    const int c = lane & 7, kg = lane >> 3;
    f32x4 v[16];
#pragma unroll
    for (int p = 0; p < 4; ++p)
#pragma unroll
        for (int i = 0; i < 4; ++i) v[4 * p + i] = __builtin_nontemporal_load((const f32x4*)(W + (size_t)(k0 + 32 * p + 4 * kg + i) * N + n0 + 4 * c));
#pragma unroll
    for (int p = 0; p < 4; ++p)
#pragma unroll
        for (int j = 0; j < 4; ++j) {
            int w = __builtin_amdgcn_cvt_pk_fp8_f32(pg8::clamp448(v[4 * p][j] * scale), pg8::clamp448(v[4 * p + 1][j] * scale), 0, false);
            w = __builtin_amdgcn_cvt_pk_fp8_f32(pg8::clamp448(v[4 * p + 2][j] * scale), pg8::clamp448(v[4 * p + 3][j] * scale), w, true);
            *(LAS int*)(t8 + (4 * c + j) * 136 + 32 * p + 4 * kg) = w; }
    LDS_WAIT(); asm volatile("" ::: "memory");
#pragma unroll
    for (int jj = 0; jj < 4; ++jj) { const int n = (lane >> 3) + 8 * jj; const LAS unsigned char* sp = t8 + n * 136 + 16 * (lane & 7);
        const u32x2 a = *(const LAS u32x2*)sp, b = *(const LAS u32x2*)(sp + 8);
        __builtin_nontemporal_store((u32x4){a.x, a.y, b.x, b.y}, (u32x4*)(WT + (drow0 + (size_t)n) * (size_t)K + k0 + 16 * (lane & 7))); }
    LDS_WAIT(); asm volatile("" ::: "memory");
}
constexpr int MOE_ITEMS = 96 * 1024;
__device__ __forceinline__ void p0_moe_items(Frame& F, int cw, int NCW, int lo, int hi) {
    LAS float* scr8 = (LAS float*)(F.lds + F.wave * 16896);
    for (int r = lo + cw; r < hi; r += NCW) {
        const int m = r >> 10, q2 = r & 1023, kind = m >> 5, e = m & 31, kb = q2 / 64, nb = q2 % 64, n0 = nb * 32;
        if (kind < 2) { const float* src = (kind == 0 ? F.in[17] : F.in[19]) + (size_t)e * D * FF;
            const size_t drow = (size_t)e * 4096 + (size_t)(n0 >> 7) * 256 + (size_t)(kind * 128) + (size_t)(n0 & 127);
            p0_item8_fast(src, FF, F.ws + WS_WGU, D, kb * 128, n0, drow, W8_SCALE, (LAS unsigned char*)scr8, F.lane); }
        else { const float* src = F.in[21] + (size_t)e * FF * D;
            p0_item8_fast(src, D, F.ws + WS_WDN, FF, kb * 128, n0, (size_t)e * 2048 + n0, W8_SCALE, (LAS unsigned char*)scr8, F.lane); } }
}

__device__ __forceinline__ void p1_rows(Frame& F) {
    const int gw = F.bx * 8 + F.wave, NGW = F.G * 8;
    const float* mod = (const float*)(F.ws + WS_MOD); const float* g = F.in[6];
    bf16_t* HB = (bf16_t*)(F.ws + WS_HB);
    for (int m0 = gw; m0 < MR; m0 += 2 * NGW) {
        f32x4 v[2][8]; float ss[2] = {0.f, 0.f};
#pragma unroll
        for (int u = 0; u < 2; ++u) { const int m = min(m0 + u * NGW, MR - 1); const float* src = m < NTOK ? F.in[0] + (size_t)m * D : F.in[2] + (size_t)(m - NTOK) * D;
#pragma unroll
            for (int j = 0; j < 8; ++j) v[u][j] = *(const f32x4*)(src + 4 * F.lane + 256 * j); }
#pragma unroll
        for (int u = 0; u < 2; ++u)
#pragma unroll
            for (int j = 0; j < 8; ++j) ss[u] += (v[u][j][0] * v[u][j][0] + v[u][j][1] * v[u][j][1]) + (v[u][j][2] * v[u][j][2] + v[u][j][3] * v[u][j][3]);
#pragma unroll
        for (int u = 0; u < 2; ++u) { const int m = m0 + u * NGW; if (m >= MR) break;
            const float* md = mod + (size_t)(m < NTOK ? m / S : 4) * MODW;
            const float rstd = rsqrtf(wave_sum(ss[u]) * (1.0f / D) + 1e-6f);
#pragma unroll
            for (int j = 0; j < 8; ++j) { const int k = 4 * F.lane + 256 * j; const f32x4 gg = *(const f32x4*)(g + k), sh = *(const f32x4*)(md + k), sc = *(const f32x4*)(md + D + k);
                const f32x4 y = v[u][j] * rstd * gg * (sc + 1.0f) + sh;
#if MK_FP8_INPROJ
                int p = __builtin_amdgcn_cvt_pk_fp8_f32(pg8::clamp448(y[0] * H8_SCALE), pg8::clamp448(y[1] * H8_SCALE), 0, false); p = __builtin_amdgcn_cvt_pk_fp8_f32(pg8::clamp448(y[2] * H8_SCALE), pg8::clamp448(y[3] * H8_SCALE), p, true);
                *(int*)((unsigned char*)HB + (size_t)m * D + k) = p; }
#else
                u32x2 o; o.x = pk2(y[0], y[1]); o.y = pk2(y[2], y[3]);
                *(u32x2*)(HB + (size_t)m * D + k) = o; }
#endif
        }
    }
}

static_assert(CONV_P3_MATS_ >= 0, ""); constexpr int CONV_P3_MATS = CONV_P3_MATS_;
constexpr int CONV_TOTAL = CONV_P3_MATS * 32 * 128, CONV_PER_WAVE = CONV_TOTAL / 2048;
__device__ __forceinline__ void conv_issue(Frame& F, int idx, float (&r)[16]) {
    const int kstep = idx & 127, t = idx >> 7, nblk = t & 31, m = t >> 5, e = m & 31, kind = m >> 5;
    const float* src = (kind == 0 ? F.in[17] : (kind == 1 ? F.in[19] : F.in[21])) + (size_t)e * (2048 * 2048) + (size_t)(kstep * 16) * 2048 + nblk * 64 + F.lane;
#pragma unroll
    for (int q = 0; q < 16; ++q) r[q] = __builtin_nontemporal_load(src + q * 2048);
}
__device__ __forceinline__ void conv_commit(Frame& F, int idx, const float (&r)[16]) {
    const int kstep = idx & 127, t = idx >> 7, nblk = t & 31, m = t >> 5, e = m & 31, kind = m >> 5;
    const int n = nblk * 64 + F.lane;
    const size_t drow = kind < 2 ? (size_t)e * 4096 + (size_t)(n >> 7) * 256 + (size_t)(kind * 128) + (size_t)(n & 127) : (size_t)e * 2048 + n;
    unsigned char* dst = F.ws + (kind < 2 ? WS_WGU : WS_WDN) + drow * 2048 + kstep * 16;
    unsigned o[4];
#pragma unroll
    for (int q = 0; q < 4; ++q) { int p = __builtin_amdgcn_cvt_pk_fp8_f32(pg8::clamp448(r[4 * q] * W8_SCALE), pg8::clamp448(r[4 * q + 1] * W8_SCALE), 0, false);
        p = __builtin_amdgcn_cvt_pk_fp8_f32(pg8::clamp448(r[4 * q + 2] * W8_SCALE), pg8::clamp448(r[4 * q + 3] * W8_SCALE), p, true); o[q] = (unsigned)p; }
    *(u32x4*)dst = (u32x4){o[0], o[1], o[2], o[3]};
}
struct ConvCur { int cur, end; };

typedef short v4i16_t __attribute__((ext_vector_type(4)));
__device__ __forceinline__ v4i16_t ds_tr(const LAS unsigned char* p) { return __builtin_amdgcn_ds_read_tr16_b64_v4i16((LAS v4i16_t*)p); }
__device__ __forceinline__ bf16x8 cat8(v4i16_t a, v4i16_t b) { bf16x8 r; r[0] = a[0]; r[1] = a[1]; r[2] = a[2]; r[3] = a[3]; r[4] = b[0]; r[5] = b[1]; r[6] = b[2]; r[7] = b[3]; return r; }
#define MFMA16(a, b, c) __builtin_amdgcn_mfma_f32_16x16x32_bf16((a), (b), (c), 0, 0, 0)

constexpr int R_QS = 0, R_KS = 34816, R_VS = 71680, R_RT = 92160;
constexpr int PQ = 272, PK = 288, PV = 160, PR = 272;

__device__ __forceinline__ void ret_unit(Frame& F, int b, int h, int dir, int dvs, ConvCur& cv) {
    LAS unsigned char* lds = F.lds;
    __syncthreads();
    const int tid = F.tid, w = F.wave;
    const bf16_t* YB = (const bf16_t*)(F.ws + WS_YB);
    bf16_t* OUT = (bf16_t*)(F.ws + (dir ? WS_OB : WS_OF));
    const float dec = (dir ? F.in[13] : F.in[12])[h];
    const float l2g = -log1pf(expf(-dec)) * LOG2E;
    u32x4 rq[2][2], rk[2][2], rv[2];
    f32x4 Racc[2][2];
#pragma unroll
    for (int a = 0; a < 2; ++a)
#pragma unroll
        for (int c = 0; c < 2; ++c) Racc[a][c] = (f32x4){0.f, 0.f, 0.f, 0.f};
    for (int i = tid; i < 64 * PR / 16; i += 512) *(LAS u32x4*)(lds + R_RT + i * 16) = (u32x4){0u, 0u, 0u, 0u};

    auto base_row = [&](int it) -> int { if (it < 2) { const int ci = dir ? 1 - it : it; return NTOK + b * L + ci * 128; } const int ci = dir ? 31 - (it - 2) : (it - 2); return b * S + ci * 128; };
    auto issue = [&](int it, int tz) {
        const int br = base_row(it); const int aj = tz & 7, colq = (aj >> 2) * 64 + 8 * (aj & 3);
#pragma unroll
        for (int i = 0; i < 2; ++i) { const int p = (tz >> 3) + 64 * i; const size_t row = (size_t)(br + (dir ? 127 - p : p));
            const bf16_t* rp = YB + row * INW;
            if (it >= 2) { rq[i][0] = *(const u32x4*)(rp + C_QR + h * 128 + colq); rq[i][1] = *(const u32x4*)(rp + C_QR + h * 128 + colq + 32); }
            rk[i][0] = *(const u32x4*)(rp + C_KR + h * 128 + colq); rk[i][1] = *(const u32x4*)(rp + C_KR + h * 128 + colq + 32);
            rv[i] = *(const u32x4*)(rp + C_VR + h * 256 + dvs * 64 + 8 * aj); }
    };
    auto commit = [&](int it, int tz, float l2z) {
        const bool lat = it >= 2; const int aj = tz & 7, colq = (aj >> 2) * 64 + 8 * (aj & 3);
#pragma unroll
        for (int i = 0; i < 2; ++i) { const int p = (tz >> 3) + 64 * i;
            const float gp = ex2((float)p * l2z), gm = ex2(-(float)p * l2z);
#pragma unroll
            for (int hh = 0; hh < 2; ++hh) { const u32x4 kv = rk[i][hh]; u32x4 zv;
                zv.x = pk2(bf_lo(kv.x) * gm, bf_hi(kv.x) * gm); zv.y = pk2(bf_lo(kv.y) * gm, bf_hi(kv.y) * gm); zv.z = pk2(bf_lo(kv.z) * gm, bf_hi(kv.z) * gm); zv.w = pk2(bf_lo(kv.w) * gm, bf_hi(kv.w) * gm);
                *(LAS u32x4*)(lds + R_KS + p * PK + (colq + 32 * hh) * 2) = zv;
                if (lat) { const u32x4 qv = rq[i][hh]; u32x4 qd;
                    qd.x = pk2(bf_lo(qv.x) * gp, bf_hi(qv.x) * gp); qd.y = pk2(bf_lo(qv.y) * gp, bf_hi(qv.y) * gp); qd.z = pk2(bf_lo(qv.z) * gp, bf_hi(qv.z) * gp); qd.w = pk2(bf_lo(qv.w) * gp, bf_hi(qv.w) * gp);
                    *(LAS u32x4*)(lds + R_QS + p * PQ + (colq + 32 * hh) * 2) = qd; } }
            *(LAS u32x4*)(lds + R_VS + p * PV + aj * 16) = rv[i]; }
    };

    issue(0, tid);
    commit(0, tid, l2g);
    __syncthreads();
    const int wr4 = w >> 1, wc2 = w & 1;
    const int wr2 = w >> 2, wc4 = w & 3;
    for (int it = 0; it < 34; ++it) {
        const bool lat = it >= 2;
        float l2i = l2g; int tz = tid; asm volatile("" : "+v"(l2i), "+v"(tz));
        const int fr = tz & 15, fq = (tz & 63) >> 4;
        const float g1 = ex2(l2i), g127 = ex2(127.0f * l2i);
        if (it + 1 < 34) issue(it + 1, tz);
        const bool cvd = cv.cur < cv.end; float cvr[16];
        if (cvd) conv_issue(F, cv.cur, cvr);
        f32x4 Sacc[2][4], Oacc[2][2];
        if (lat) {
#pragma unroll
            for (int a = 0; a < 2; ++a) {
#pragma unroll
                for (int c = 0; c < 4; ++c) Sacc[a][c] = (f32x4){0.f, 0.f, 0.f, 0.f};
#pragma unroll
                for (int c = 0; c < 2; ++c) Oacc[a][c] = (f32x4){0.f, 0.f, 0.f, 0.f}; }
#pragma unroll
            for (int ks = 0; ks < 4; ++ks) {
                bf16x8 qa[2], kb[4], rb[2];
#pragma unroll
                for (int a = 0; a < 2; ++a) qa[a] = *(const LAS bf16x8*)(lds + R_QS + (32 * wr4 + 16 * a + fr) * PQ + (32 * ks + 8 * fq) * 2);
#pragma unroll
                for (int c = 0; c < 4; ++c) kb[c] = *(const LAS bf16x8*)(lds + R_KS + (64 * wc2 + 16 * c + fr) * PK + (32 * ks + 8 * fq) * 2);
#pragma unroll
                for (int c = 0; c < 2; ++c) rb[c] = *(const LAS bf16x8*)(lds + R_RT + (32 * wc2 + 16 * c + fr) * PR + (32 * ks + 8 * fq) * 2);
#pragma unroll
                for (int a = 0; a < 2; ++a) {
#pragma unroll
                    for (int c = 0; c < 4; ++c) Sacc[a][c] = MFMA16(kb[c], qa[a], Sacc[a][c]);
#pragma unroll
                    for (int c = 0; c < 2; ++c) Oacc[a][c] = MFMA16(rb[c], qa[a], Oacc[a][c]); }
            }
        }
        {
#pragma unroll
            for (int a = 0; a < 2; ++a)
#pragma unroll
                for (int c = 0; c < 2; ++c) Racc[a][c] *= g1;
#pragma unroll
            for (int ks = 0; ks < 4; ++ks) {
                bf16x8 va[2], zb[2];
                const int c0 = 32 * ks + 8 * fq + (fr >> 2);
#pragma unroll
                for (int a = 0; a < 2; ++a) va[a] = cat8(ds_tr(lds + R_VS + c0 * PV + (32 * wr2 + 16 * a + 4 * (fr & 3)) * 2), ds_tr(lds + R_VS + (c0 + 4) * PV + (32 * wr2 + 16 * a + 4 * (fr & 3)) * 2));
#pragma unroll
                for (int c = 0; c < 2; ++c) zb[c] = cat8(ds_tr(lds + R_KS + c0 * PK + (32 * wc4 + 16 * c + 4 * (fr & 3)) * 2), ds_tr(lds + R_KS + (c0 + 4) * PK + (32 * wc4 + 16 * c + 4 * (fr & 3)) * 2));
#pragma unroll
                for (int a = 0; a < 2; ++a)
#pragma unroll
                    for (int c = 0; c < 2; ++c) Racc[a][c] = MFMA16(zb[c], va[a], Racc[a][c]);
            }
        }
        __syncthreads();
        if (lat) {
#pragma unroll
            for (int a = 0; a < 2; ++a)
#pragma unroll
                for (int c = 0; c < 4; ++c) { const int cr = 32 * wr4 + 16 * a + fr, m0 = 64 * wc2 + 16 * c + 4 * fq; float o[4];
#pragma unroll
                    for (int j = 0; j < 4; ++j) o[j] = cr >= m0 + j ? Sacc[a][c][j] : 0.0f;
                    u32x2 wv; wv.x = pk2(o[0], o[1]); wv.y = pk2(o[2], o[3]);
                    *(LAS u32x2*)(lds + R_KS + cr * PK + m0 * 2) = wv; }
        }
#pragma unroll
        for (int a = 0; a < 2; ++a)
#pragma unroll
            for (int c = 0; c < 2; ++c) { Racc[a][c] *= g127; u32x2 wv; wv.x = pk2(Racc[a][c][0], Racc[a][c][1]); wv.y = pk2(Racc[a][c][2], Racc[a][c][3]);
                *(LAS u32x2*)(lds + R_RT + (32 * wr2 + 16 * a + fr) * PR + (32 * wc4 + 16 * c + 4 * fq) * 2) = wv; }
        __syncthreads();
        if (lat) {
#pragma unroll
            for (int a = 0; a < 2; ++a)
#pragma unroll
                for (int c = 0; c < 2; ++c) Oacc[a][c] *= g1;
#pragma unroll
            for (int ks = 0; ks < 4; ++ks) {
                bf16x8 sa[2], vb[2];
                const int c0 = 32 * ks + 8 * fq + (fr >> 2);
#pragma unroll
                for (int a = 0; a < 2; ++a) sa[a] = *(const LAS bf16x8*)(lds + R_KS + (32 * wr4 + 16 * a + fr) * PK + (32 * ks + 8 * fq) * 2);
#pragma unroll
                for (int c = 0; c < 2; ++c) vb[c] = cat8(ds_tr(lds + R_VS + c0 * PV + (32 * wc2 + 16 * c + 4 * (fr & 3)) * 2), ds_tr(lds + R_VS + (c0 + 4) * PV + (32 * wc2 + 16 * c + 4 * (fr & 3)) * 2));
#pragma unroll
                for (int a = 0; a < 2; ++a)
#pragma unroll
                    for (int c = 0; c < 2; ++c) Oacc[a][c] = MFMA16(vb[c], sa[a], Oacc[a][c]);
            }
            const int br = base_row(it);
#pragma unroll
            for (int a = 0; a < 2; ++a) { const int p = 32 * wr4 + 16 * a + fr; const size_t row = (size_t)(br + (dir ? 127 - p : p));
#pragma unroll
                for (int c = 0; c < 2; ++c) { u32x2 wv; wv.x = pk2(Oacc[a][c][0], Oacc[a][c][1]); wv.y = pk2(Oacc[a][c][2], Oacc[a][c][3]);
                    *(u32x2*)(OUT + row * D + h * 256 + dvs * 64 + 32 * wc2 + 16 * c + 4 * fq) = wv; } }
        }
        __syncthreads();
        if (it + 1 < 34) commit(it + 1, tz, l2i);
        if (cvd) { conv_commit(F, cv.cur, cvr); ++cv.cur; }
        __syncthreads();
    }
}

constexpr int N_K = 0, N_V = 34816, NBUF = 71680, N_RPB = 2 * NBUF, NPK_ = 272, NP_ = 288;
struct NaState { f32x4 O[8]; float m_run, l_part; bf16x8 Qf[4]; };
__device__ __forceinline__ int na_unit(Frame& F, int b, int h, int rq, int par, bool first, bool has_next, int nb, int nh, int nrq) {
    LAS unsigned char* lds = F.lds;
    const int tid = F.tid, lane = F.lane, w = F.wave;
    const bf16_t* YB = (const bf16_t*)(F.ws + WS_YB);
    bf16_t* NAOB = (bf16_t*)(F.ws + WS_NAOB); const bf16_t* KVB = (const bf16_t*)(F.ws + WS_KV);
    const int r0 = 4 * rq, qrowA = r0 + 2 * (w >> 2), j = w & 3;
    const int kstart = j == 0 ? 0 : (j == 1 ? 8 : (j == 2 ? 24 : 32));
    const int lo = min(max(r0 - 4, 0), 56), hi = min(max(r0 + 3 - 4, 0), 56) + 7, nloc = hi - lo + 1, nls = (nloc + 1) >> 1, ns = nls + 2;
    NaState sa, sb;
    { const int fr = lane & 15, fq = lane >> 4; const bf16_t* qp = YB + (size_t)(b * S + qrowA * 64 + 16 * j + fr) * INW + C_QN + h * 128 + 8 * fq;
#pragma unroll
      for (int ks = 0; ks < 4; ++ks) { sa.Qf[ks] = *(const bf16x8*)(qp + 32 * ks); sb.Qf[ks] = *(const bf16x8*)(qp + (size_t)64 * INW + 32 * ks); } }
#pragma unroll
    for (int d = 0; d < 8; ++d) { sa.O[d] = (f32x4){0.f, 0.f, 0.f, 0.f}; sb.O[d] = sa.O[d]; }
    sa.m_run = -1e30f; sa.l_part = 0.f; sb.m_run = -1e30f; sb.l_part = 0.f;
    u32x4 rk[4], rv[4];
    auto issue = [&](int b_, int h_, int lo_, int hi_, int nls_, int st) {
        int t_ = tid; asm volatile("" : "+v"(t_));
#pragma unroll
        for (int i = 0; i < 4; ++i) { const int T = t_ + 512 * i, key = T >> 4, ch = T & 15;
            const int tok = st < nls_ ? min(lo_ + 2 * st + (key >> 6), hi_) * 64 + (key & 63) : S + (st - nls_) * 128 + key;
            const bf16_t* kp = KVB + ((size_t)((b_ * 16 + h_) * (S + L) + tok) * 256 + 8 * ch);
            rk[i] = *(const u32x4*)kp; rv[i] = *(const u32x4*)(kp + 128); }
    };
    auto commit = [&](int bo) {
        int t_ = tid; asm volatile("" : "+v"(t_));
#pragma unroll
        for (int i = 0; i < 4; ++i) { const int T = t_ + 512 * i, key = T >> 4, ch = T & 15;
            *(LAS u32x4*)(lds + bo + N_K + key * NPK_ + ch * 16) = rk[i]; *(LAS u32x4*)(lds + bo + N_V + key * NP_ + ch * 16) = rv[i]; }
    };
    auto rpb_load = [&](int h_) { const int ix = tid - 16; return (ix >= 0 && ix < 465) ? F.in[14][h_ * 465 + ix] * LOG2E : 0.0f; };
    int bufo = par * NBUF;
    auto softmax64 = [&](NaState& st_, int qrow, const f32x4 (&Sx)[2][2], int k0a, int k0b, bool acta, bool actb, bool local, int kra, int krb, bf16x8 (&pf)[2], int fr, int fq) {
        const int qc = 16 * j + fr, cs = min(max(qc - 8, 0), 48);
        f32x4 s4[4];
#pragma unroll
        for (int q = 0; q < 4; ++q) s4[q] = Sx[q >> 1][q & 1];
        if (local) {
            f32x4 bias[4];
#pragma unroll
            for (int i = 0; i < 2; ++i) { const int kb0 = i ? k0b : k0a, kr = i ? krb : kra; const int br = min(max(kr - qrow + 7, 0), 14);
                const LAS float* bp = (const LAS float*)(lds + N_RPB) + 16 + br * 31 + ((kb0 & 63) + 4 * fq - qc + 15);
#pragma unroll
                for (int t = 0; t < 2; ++t)
#pragma unroll
                    for (int e = 0; e < 4; ++e) bias[2 * i + t][e] = bp[16 * t + e]; }
            asm volatile("" : "+v"(bias[0]), "+v"(bias[1]), "+v"(bias[2]), "+v"(bias[3]));
#pragma unroll
            for (int q = 0; q < 4; ++q) { const int i = q >> 1, t = q & 1, kb0 = i ? k0b : k0a; const bool act = i ? actb : acta;
                const f32x4 v = s4[q] + bias[q];
#pragma unroll
                for (int e = 0; e < 4; ++e) { const int kc = (kb0 & 63) + 16 * t + 4 * fq + e; s4[q][e] = (((unsigned)(kc - cs) < 16u) && act) ? v[e] : -3e38f; } } }
        float mx = -3e38f;
#pragma unroll
        for (int q = 0; q < 4; ++q)
#pragma unroll
            for (int e = 0; e < 4; ++e) mx = fmaxf(mx, s4[q][e]);
        { const auto r16 = __builtin_amdgcn_permlane16_swap(__builtin_bit_cast(unsigned, mx), __builtin_bit_cast(unsigned, mx), false, false);
          mx = fmaxf(__builtin_bit_cast(float, r16[0]), __builtin_bit_cast(float, r16[1]));
          const auto r32 = __builtin_amdgcn_permlane32_swap(__builtin_bit_cast(unsigned, mx), __builtin_bit_cast(unsigned, mx), false, false);
          mx = fmaxf(__builtin_bit_cast(float, r32[0]), __builtin_bit_cast(float, r32[1])); }
        const float m_new = fmaxf(st_.m_run, mx), alpha = ex2(st_.m_run - m_new);
        const f32x4 m4 = {m_new, m_new, m_new, m_new}; f32x4 ps4 = {0.f, 0.f, 0.f, 0.f};
#pragma unroll
        for (int q = 0; q < 4; ++q) { const f32x4 d = s4[q] - m4;
#pragma unroll
            for (int e = 0; e < 4; ++e) s4[q][e] = ex2(d[e]);
            ps4 += s4[q]; }
        st_.l_part = st_.l_part * alpha + ((ps4[0] + ps4[1]) + (ps4[2] + ps4[3]));
        if (__any(m_new > st_.m_run)) {
#pragma unroll
            for (int d = 0; d < 8; ++d) st_.O[d] *= alpha; }
        st_.m_run = m_new;
#pragma unroll
        for (int i = 0; i < 2; ++i) { u32x4 pw; pw.x = pk2(s4[2 * i][0], s4[2 * i][1]); pw.y = pk2(s4[2 * i][2], s4[2 * i][3]); pw.z = pk2(s4[2 * i + 1][0], s4[2 * i + 1][1]); pw.w = pk2(s4[2 * i + 1][2], s4[2 * i + 1][3]); pf[i] = __builtin_bit_cast(bf16x8, pw); }
    };
    auto block64x2 = [&](int k0a, int k0b, bool aA, bool bA, bool aB, bool bB, bool local, int kra, int krb) {
        int fq = lane >> 4, fr = lane & 15; asm volatile("" : "+v"(fq), "+v"(fr));
        f32x4 SA[2][2], SB[2][2];
        bf16x8 kf[2][4];
        auto ldk = [&](int g, bf16x8 (&dst)[4]) { const int kb0 = (g >> 1) ? k0b : k0a;
#pragma unroll
            for (int ks = 0; ks < 4; ++ks) dst[ks] = *(const LAS bf16x8*)(lds + bufo + N_K + (kb0 + 16 * (g & 1) + fr) * NPK_ + (32 * ks + 8 * fq) * 2); };
        ldk(0, kf[0]);
#pragma unroll
        for (int g = 0; g < 4; ++g) { f32x4 xa = (f32x4){0.f, 0.f, 0.f, 0.f}, xb = xa, ya = xa, yb = xa;
            if (g + 1 < 4) ldk(g + 1, kf[(g + 1) & 1]);
            xa = MFMA16(kf[g & 1][0], sa.Qf[0], xa); xb = MFMA16(kf[g & 1][0], sb.Qf[0], xb); ya = MFMA16(kf[g & 1][1], sa.Qf[1], ya); yb = MFMA16(kf[g & 1][1], sb.Qf[1], yb);
            xa = MFMA16(kf[g & 1][2], sa.Qf[2], xa); xb = MFMA16(kf[g & 1][2], sb.Qf[2], xb); ya = MFMA16(kf[g & 1][3], sa.Qf[3], ya); yb = MFMA16(kf[g & 1][3], sb.Qf[3], yb);
            SA[g >> 1][g & 1] = xa + ya; SB[g >> 1][g & 1] = xb + yb;
            __builtin_amdgcn_sched_barrier(0); }
        bf16x8 pfA[2], pfB[2];
        softmax64(sa, qrowA, SA, k0a, k0b, aA, bA, local, kra, krb, pfA, fr, fq);
        softmax64(sb, qrowA + 1, SB, k0a, k0b, aB, bB, local, kra, krb, pfB, fr, fq);
        __builtin_amdgcn_sched_barrier(0);
        bf16x8 vf[2][4];
        auto ldv = [&](int g, bf16x8 (&dst)[4]) { const int k0 = ((g >> 1) ? k0b : k0a) + 4 * fq + (fr >> 2);
#pragma unroll
            for (int q = 0; q < 4; ++q) { const int d = 4 * (g & 1) + q; dst[q] = cat8(ds_tr(lds + bufo + N_V + k0 * NP_ + (16 * d + 4 * (fr & 3)) * 2), ds_tr(lds + bufo + N_V + (k0 + 16) * NP_ + (16 * d + 4 * (fr & 3)) * 2)); } };
        ldv(0, vf[0]);
#pragma unroll
        for (int g = 0; g < 4; ++g) {
            if (g + 1 < 4) ldv(g + 1, vf[(g + 1) & 1]);
#pragma unroll
            for (int q = 0; q < 4; ++q) { const int d = 4 * (g & 1) + q; sa.O[d] = MFMA16(vf[g & 1][q], pfA[g >> 1], sa.O[d]); sb.O[d] = MFMA16(vf[g & 1][q], pfB[g >> 1], sb.O[d]); }
            __builtin_amdgcn_sched_barrier(0); }
    };
    auto stage_step = [&](int stg) {
        const bool local = stg < nls; const int nsub = local ? 1 : 2;
        const int kra = lo + 2 * stg, krb = kra + 1, rsA = min(max(qrowA - 4, 0), 56), rsB = min(max(qrowA + 1 - 4, 0), 56);
        const bool aA = !local || (kra >= rsA && kra < rsA + 8), bA = !local || (krb <= hi && krb >= rsA && krb < rsA + 8), aB = !local || (kra >= rsB && kra < rsB + 8), bB = !local || (krb <= hi && krb >= rsB && krb < rsB + 8);
        if (aA || bA || aB || bB) {
#pragma unroll 1
            for (int sub = 0; sub < nsub; ++sub) block64x2(local ? kstart : 64 * sub, local ? 64 + kstart : 64 * sub + 32, aA, bA, aB, bB, local, kra, krb); }
    };
    if (first) {
        issue(b, h, lo, hi, nls, 0); const float rp = rpb_load(h);
        commit(bufo); ((LAS float*)(lds + N_RPB))[tid] = rp;
        __syncthreads(); }
    const int nr0 = 4 * nrq, nlo = min(max(nr0 - 4, 0), 56), nhi = min(max(nr0 + 3 - 4, 0), 56) + 7;
    for (int st = 0; st < ns; ++st) {
        const bool lastst = st + 1 == ns; float rp = 0.f;
        if (!lastst) issue(b, h, lo, hi, nls, st + 1);
        else if (has_next) { issue(nb, nh, nlo, nhi, 1, 0); rp = rpb_load(nh); }
        stage_step(st);
        if (!lastst || has_next) commit(NBUF - bufo);
        if (lastst && has_next) ((LAS float*)(lds + N_RPB))[tid] = rp;
        bufo = NBUF - bufo;
        __syncthreads();
    }
    const int fr = lane & 15, fq = lane >> 4;
#pragma unroll
    for (int u = 0; u < 2; ++u) { NaState& st_ = u ? sb : sa;
        float l = st_.l_part; l += __shfl_xor(l, 16); l += __shfl_xor(l, 32);
        const float inv = 1.0f / l;
#if MK_FP8_PROJ
        unsigned char* op = (unsigned char*)NAOB + (size_t)(b * S + (qrowA + u) * 64 + 16 * j + fr) * D + h * 128 + 4 * fq; const float i8 = inv * H8_SCALE;
#pragma unroll
        for (int d = 0; d < 8; ++d) { int p = __builtin_amdgcn_cvt_pk_fp8_f32(pg8::clamp448(st_.O[d][0] * i8), pg8::clamp448(st_.O[d][1] * i8), 0, false); p = __builtin_amdgcn_cvt_pk_fp8_f32(pg8::clamp448(st_.O[d][2] * i8), pg8::clamp448(st_.O[d][3] * i8), p, true); *(int*)(op + 16 * d) = p; }
#else
        bf16_t* op = NAOB + (size_t)(b * S + (qrowA + u) * 64 + 16 * j + fr) * D + h * 128 + 4 * fq;
#pragma unroll
        for (int d = 0; d < 8; ++d) { u32x2 wv; wv.x = pk2(st_.O[d][0] * inv, st_.O[d][1] * inv); wv.y = pk2(st_.O[d][2] * inv, st_.O[d][3] * inv); *(u32x2*)(op + 16 * d) = wv; }
#endif
    }
    return bufo == 0 ? 0 : 1;
}

__device__ __forceinline__ float sum8(float v) { v += __shfl_xor(v, 1); v += __shfl_xor(v, 2); v += __shfl_xor(v, 4); return v; }
__device__ __forceinline__ void p4_rows(Frame& F) {
    const int gw = F.bx * 8 + F.wave, NGW = F.G * 8;
    const bf16_t* OF = (const bf16_t*)(F.ws + WS_OF); const bf16_t* OB = (const bf16_t*)(F.ws + WS_OB); const bf16_t* YB = (const bf16_t*)(F.ws + WS_YB);
    bf16_t* A1B = (bf16_t*)(F.ws + WS_HB);
    for (int m = gw; m < NTOK; m += NGW) {
        const size_t o = (size_t)m * D + 32 * F.lane;
        u32x4 a[4], c[4], g[4];
#pragma unroll
        for (int q = 0; q < 4; ++q) { a[q] = *(const u32x4*)(OF + o + 8 * q); c[q] = *(const u32x4*)(OB + o + 8 * q); g[q] = *(const u32x4*)(YB + (size_t)m * INW + C_GR + 32 * F.lane + 8 * q); }
        float v[32]; float sm = 0.f;
#pragma unroll
        for (int q = 0; q < 4; ++q) { const unsigned aw[4] = {a[q].x, a[q].y, a[q].z, a[q].w}, cw[4] = {c[q].x, c[q].y, c[q].z, c[q].w};
#pragma unroll
            for (int t = 0; t < 4; ++t) { v[8 * q + 2 * t] = bf_lo(aw[t]) + bf_lo(cw[t]); v[8 * q + 2 * t + 1] = bf_hi(aw[t]) + bf_hi(cw[t]); sm += v[8 * q + 2 * t] + v[8 * q + 2 * t + 1]; } }
        const float mu = sum8(sm) * (1.0f / 256.0f); float sq = 0.f;
#pragma unroll
        for (int i = 0; i < 32; ++i) { v[i] -= mu; sq += v[i] * v[i]; }
        const float rstd = rsqrtf(sum8(sq) * (1.0f / 256.0f) + 1e-5f);
#pragma unroll
        for (int q = 0; q < 4; ++q) { const unsigned gw4[4] = {g[q].x, g[q].y, g[q].z, g[q].w};
#pragma unroll
            for (int t = 0; t < 4; ++t) { const float g0 = bf_lo(gw4[t]), g1 = bf_hi(gw4[t]); v[8 * q + 2 * t] *= rstd * g0 * pg8::sigm(g0); v[8 * q + 2 * t + 1] *= rstd * g1 * pg8::sigm(g1); } }
#if MK_FP8_PROJ
        unsigned w8[8];
#pragma unroll
        for (int q = 0; q < 8; ++q) { int p = __builtin_amdgcn_cvt_pk_fp8_f32(pg8::clamp448(v[4 * q] * H8_SCALE), pg8::clamp448(v[4 * q + 1] * H8_SCALE), 0, false);
            p = __builtin_amdgcn_cvt_pk_fp8_f32(pg8::clamp448(v[4 * q + 2] * H8_SCALE), pg8::clamp448(v[4 * q + 3] * H8_SCALE), p, true); w8[q] = (unsigned)p; }
        unsigned char* dst = (unsigned char*)A1B + o;
        *(u32x4*)dst = (u32x4){w8[0], w8[1], w8[2], w8[3]}; *(u32x4*)(dst + 16) = (u32x4){w8[4], w8[5], w8[6], w8[7]};
#else
#pragma unroll
        for (int q = 0; q < 4; ++q) { u32x4 wv; wv.x = pk2(v[8 * q], v[8 * q + 1]); wv.y = pk2(v[8 * q + 2], v[8 * q + 3]); wv.z = pk2(v[8 * q + 4], v[8 * q + 5]); wv.w = pk2(v[8 * q + 6], v[8 * q + 7]); *(u32x4*)(A1B + o + 8 * q) = wv; }
#endif
    }
}

constexpr size_t WS_QC = WS_MOD + 256 * 1024;
__device__ __forceinline__ void p1_router_const(Frame& F) {
    LAS float* red = (LAS float*)F.lds;
    const int b = F.bx >> 3, part = F.bx & 7, e = F.tid & 31, pt = F.tid >> 5; const float* md = (const float*)(F.ws + WS_MOD) + (size_t)b * MODW + 3 * D; const float* Wr = F.in[15];
    float sacc = 0.f;
#pragma unroll
    for (int q = 0; q < 16; ++q) { const int k = part * 256 + pt * 16 + q; sacc += md[k] * Wr[k * 32 + e]; }
    __syncthreads(); red[pt * 32 + e] = sacc; __syncthreads();
    if (F.tid < 32) { float q = 0.f;
#pragma unroll
        for (int p = 0; p < 16; ++p) q += red[p * 32 + F.tid];
        ((float*)(F.ws + WS_QC))[(b * 8 + part) * 32 + F.tid] = q; }
    __syncthreads();
}
__device__ __forceinline__ void p7_route(Frame& F) {
    LAS float* gs = (LAS float*)(F.lds);
    LAS float* shv = (LAS float*)(F.lds + 32768);
    LAS float* part = (LAS float*)(F.lds + 65536);
    LAS float* ssq = (LAS float*)(F.lds + 131072);
    LAS float* lgt = (LAS float*)(F.lds + 133120);
    LAS float* rsd = (LAS float*)(F.lds + 141312);
    const int tid = F.tid, lane = F.lane, w = F.wave, ri = lane & 15, kq = lane >> 4;
    const bf16_t* X1 = (const bf16_t*)(F.ws + WS_X1B); const float* g2 = F.in[7]; const float* Wr = F.in[15];
    const float* mod = (const float*)(F.ws + WS_MOD); const float* QC = (const float*)(F.ws + WS_QC);
    unsigned char* H2B = F.ws + WS_HB;
    int* asg_e = (int*)(F.ws + WS_ASG_E); int* asg_pos = (int*)(F.ws + WS_ASG_POS); float* asg_w = (float*)(F.ws + WS_ASG_W);
    unsigned* counts = F.ctl + CW_CNT;
    for (int g0 = F.bx; g0 < 256; g0 += F.G) {
        __syncthreads();
#pragma unroll
        for (int j = 0; j < 4; ++j) { const int i = 4 * (tid + 512 * j), bb = i >> 11, k = i & (D - 1); const float* md = mod + (size_t)bb * MODW;
            const f32x4 gg = *(const f32x4*)(g2 + k), sc = *(const f32x4*)(md + 4 * D + k), sh = *(const f32x4*)(md + 3 * D + k);
            *(LAS f32x4*)(gs + i) = gg * (sc + 1.0f); *(LAS f32x4*)(shv + i) = sh; }
        __syncthreads();
        f32x4 acc[4][2]; float ss[4];
#pragma unroll
        for (int g = 0; g < 4; ++g) { acc[g][0] = (f32x4){0.f, 0.f, 0.f, 0.f}; acc[g][1] = acc[g][0]; ss[g] = 0.f; }
        const bf16_t* xr = X1 + (size_t)(g0 * 16 + ri) * D + 256 * w + 4 * kq;
#pragma unroll 4
        for (int s = 0; s < 16; ++s) { const int k0 = 256 * w + 16 * s + 4 * kq;
            float b0[4], b1[4];
#pragma unroll
            for (int q = 0; q < 4; ++q) { b0[q] = Wr[(k0 + q) * 32 + ri]; b1[q] = Wr[(k0 + q) * 32 + 16 + ri]; }
#pragma unroll
            for (int g = 0; g < 4; ++g) { const u32x2 xw = *(const u32x2*)(xr + (size_t)g * (4096 * D) + 16 * s); const f32x4 xv = {bf_lo(xw.x), bf_hi(xw.x), bf_lo(xw.y), bf_hi(xw.y)}; const f32x4 gv = *(const LAS f32x4*)(gs + g * D + k0);
                ss[g] += (xv[0] * xv[0] + xv[1] * xv[1]) + (xv[2] * xv[2] + xv[3] * xv[3]);
#pragma unroll
                for (int q = 0; q < 4; ++q) { const float a = xv[q] * gv[q];
                    acc[g][0] = __builtin_amdgcn_mfma_f32_16x16x4f32(a, b0[q], acc[g][0], 0, 0, 0); acc[g][1] = __builtin_amdgcn_mfma_f32_16x16x4f32(a, b1[q], acc[g][1], 0, 0, 0); } } }
#pragma unroll
        for (int g = 0; g < 4; ++g) { float t = ss[g]; t += __shfl_xor(t, 16); t += __shfl_xor(t, 32);
#pragma unroll
            for (int q = 0; q < 4; ++q) { part[(w * 64 + g * 16 + 4 * kq + q) * 32 + ri] = acc[g][0][q]; part[(w * 64 + g * 16 + 4 * kq + q) * 32 + 16 + ri] = acc[g][1][q]; }
            if (kq == 0) ssq[w * 64 + g * 16 + ri] = t; }
        __syncthreads();
#pragma unroll
        for (int i = 0; i < 4; ++i) { const int row = (tid >> 5) + 16 * i, e = tid & 31; float sq = 0.f, pp = 0.f;
#pragma unroll
            for (int q = 0; q < 8; ++q) { sq += ssq[q * 64 + row]; pp += part[(q * 64 + row) * 32 + e]; }
            const float rstd = rsqrtf(sq * (1.0f / D) + 1e-6f);
            float qq = F.in[16][e];
#pragma unroll
            for (int q = 0; q < 8; ++q) qq += QC[(i * 8 + q) * 32 + e];
            lgt[row * 32 + e] = rstd * pp + qq; if (e == 0) rsd[row] = rstd; }
        __syncthreads();
        LAS unsigned* lcnt = (LAS unsigned*)(F.lds + 141568);
        if (tid < 32) lcnt[tid] = 0u;
        __syncthreads();
        LAS unsigned* sl = (LAS unsigned*)(F.lds + 141568 + 256);
        LAS float* wl = (LAS float*)(F.lds + 141568 + 256 + 1024);
        if (tid < 64) { int sel[4]; float val[4]; unsigned used = 0u;
#pragma unroll
            for (int k = 0; k < 4; ++k) { int bi = -1; float bv = 0.f;
                for (int e = 0; e < 32; ++e) { const float x = lgt[tid * 32 + e]; if (!((used >> e) & 1u) && (bi < 0 || x > bv)) { bi = e; bv = x; } }
                used |= 1u << bi; sel[k] = bi; val[k] = bv; }
            float den = 0.f, ex[4];
#pragma unroll
            for (int k = 0; k < 4; ++k) { ex[k] = __expf(val[k] - val[0]); den += ex[k]; }
#pragma unroll
            for (int k = 0; k < 4; ++k) { const unsigned lr = atomicAdd((unsigned*)&lcnt[sel[k]], 1u); sl[tid * 4 + k] = ((unsigned)sel[k] << 16) | lr; wl[tid * 4 + k] = ex[k] / den; } }
        __syncthreads();
        if (tid < 32) { const unsigned c = lcnt[tid]; lcnt[32 + tid] = c ? atomicAdd(&counts[CW_CNT_STRIDE * tid], c) : 0u; }
        __syncthreads();
        if (tid < 256) { const int row = tid >> 2, k = tid & 3, m = (g0 + 256 * (row >> 4)) * 16 + (row & 15); const unsigned v = sl[tid]; const int e = (int)(v >> 16);
            const int pos = (int)(lcnt[32 + e] + (v & 0xffffu));
            asg_e[m * 4 + k] = e; asg_pos[m * 4 + k] = pos; asg_w[m * 4 + k] = wl[tid];
            ((unsigned short*)(F.ws + WS_TOKL))[(size_t)(e * 64 + (pos >> 8)) * 256 + (pos & 63) * 4 + ((pos >> 6) & 3)] = (unsigned short)m; }
#pragma unroll 8
        for (int i = tid; i < 64 * (D / 8); i += 512) { const int row = i >> 8, g = row >> 4, k = (i & 255) * 8; const float rstd = rsd[row]; float y[8];
            const size_t xo = (size_t)((g0 + 256 * g) * 16 + (row & 15)) * D + k;
            const u32x4 xw = *(const u32x4*)(X1 + xo); const f32x4 xa = {bf_lo(xw.x), bf_hi(xw.x), bf_lo(xw.y), bf_hi(xw.y)}, xb = {bf_lo(xw.z), bf_hi(xw.z), bf_lo(xw.w), bf_hi(xw.w)};
            const f32x4 ga = *(const LAS f32x4*)(gs + g * D + k), gb = *(const LAS f32x4*)(gs + g * D + k + 4), sa = *(const LAS f32x4*)(shv + g * D + k), sb = *(const LAS f32x4*)(shv + g * D + k + 4);
#pragma unroll
            for (int q = 0; q < 4; ++q) { y[q] = pg8::clamp448((xa[q] * rstd * ga[q] + sa[q]) * H8_SCALE); y[4 + q] = pg8::clamp448((xb[q] * rstd * gb[q] + sb[q]) * H8_SCALE); }
            u32x2 wv; int p = __builtin_amdgcn_cvt_pk_fp8_f32(y[0], y[1], 0, false); p = __builtin_amdgcn_cvt_pk_fp8_f32(y[2], y[3], p, true); wv.x = (unsigned)p;
            p = __builtin_amdgcn_cvt_pk_fp8_f32(y[4], y[5], 0, false); p = __builtin_amdgcn_cvt_pk_fp8_f32(y[6], y[7], p, true); wv.y = (unsigned)p;
            *(u32x2*)(H2B + xo) = wv; }
    }
}

__device__ __forceinline__ void load_tp(Frame& F, LAS int* tp) {
    __syncthreads();
    if (F.tid == 0) { int a = 0; for (int e = 0; e < 32; ++e) { tp[e] = a; a += ((int)__hip_atomic_load(F.ctl + CW_CNT + CW_CNT_STRIDE * e, RLX_AGENT) + 255) >> 8; } tp[32] = a; }
    __syncthreads();
}
__device__ __forceinline__ void p8_gather(Frame& F, LAS int* tp) {
    const int gw = F.bx * 8 + F.wave, NGW = F.G * 8;
    const unsigned char* H2B = F.ws + WS_HB; unsigned char* XB = F.ws + WS_XB;
    const int* asg_e = (const int*)(F.ws + WS_ASG_E); const int* asg_pos = (const int*)(F.ws + WS_ASG_POS);
    for (int a0 = gw; a0 < NTOK * 4; a0 += 4 * NGW) {
        u32x4 v0[4], v1[4]; int slot[4];
#pragma unroll
        for (int u = 0; u < 4; ++u) { const int a = min(a0 + u * NGW, NTOK * 4 - 1); slot[u] = 256 * tp[asg_e[a]] + asg_pos[a];
            const u32x4* src = (const u32x4*)(H2B + (size_t)(a >> 2) * D) + F.lane; v0[u] = src[0]; v1[u] = src[64]; }
#pragma unroll
        for (int u = 0; u < 4; ++u) if (a0 + u * NGW < NTOK * 4) { u32x4* dst = (u32x4*)(XB + (size_t)slot[u] * D) + F.lane; dst[0] = v0[u]; dst[64] = v1[u]; }
    }
}
__device__ __forceinline__ void p11_final(Frame& F, LAS int* tp) {
    const int gw = F.bx * 8 + F.wave, NGW = F.G * 8;
    const bf16_t* YSB = (const bf16_t*)(F.ws + WS_XB);
    const int* asg_e = (const int*)(F.ws + WS_ASG_E); const int* asg_pos = (const int*)(F.ws + WS_ASG_POS); const float* asg_w = (const float*)(F.ws + WS_ASG_W);
    const float* mod = (const float*)(F.ws + WS_MOD); const float* fg = F.in[23];
    float tscale = 1.0f;
    if (MK_TPROBE >= 0) { const int k_ = MK_TPROBE < 10 ? MK_TPROBE : 9; const unsigned a_ = __hip_atomic_load(F.ctl + 3000 + 2 * k_, RLX_AGENT), b_ = __hip_atomic_load(F.ctl + 3000 + 2 * (MK_TPROBE < 10 ? k_ + 1 : 11), RLX_AGENT);
        tscale = MK_TPROBE_FINE ? 1.1f + (float)(((b_ - a_) + 200u) / 400u) * (4.0f / 2000.0f) : 1.1f + (float)(((b_ - a_) + 800u) / 1600u) * (16.0f / 8000.0f); }
    for (int m0 = gw; m0 < NTOK; m0 += 2 * NGW) {
        size_t so[2][4]; float wk[2][4];
#pragma unroll
        for (int u = 0; u < 2; ++u) { const int m = min(m0 + u * NGW, NTOK - 1);
#pragma unroll
            for (int k = 0; k < 4; ++k) { so[u][k] = (size_t)(256 * tp[asg_e[m * 4 + k]] + asg_pos[m * 4 + k]) * D; wk[u][k] = asg_w[m * 4 + k]; } }
        u32x2 t[2][8][4]; f32x4 x1v[2][8];
#pragma unroll
        for (int u = 0; u < 2; ++u) { const int m = min(m0 + u * NGW, NTOK - 1);
#pragma unroll
            for (int j = 0; j < 8; ++j) { const int n = 4 * F.lane + 256 * j; { const u32x2 xw = *(const u32x2*)((const bf16_t*)(F.ws + WS_X1B) + (size_t)m * D + n); x1v[u][j] = (f32x4){bf_lo(xw.x), bf_hi(xw.x), bf_lo(xw.y), bf_hi(xw.y)}; }
#pragma unroll
                for (int k = 0; k < 4; ++k) t[u][j][k] = *(const u32x2*)(YSB + so[u][k] + n); } }
#pragma unroll
        for (int u = 0; u < 2; ++u) { const int m = m0 + u * NGW; if (m >= NTOK) break;
            const float* g2v = mod + (size_t)(m / S) * MODW + 5 * D;
            f32x4 v[8]; float ss = 0.f;
#pragma unroll
            for (int j = 0; j < 8; ++j) { const int n = 4 * F.lane + 256 * j; f32x4 y = (f32x4){0.f, 0.f, 0.f, 0.f};
#pragma unroll
                for (int k = 0; k < 4; ++k) y += (f32x4){bf_lo(t[u][j][k].x), bf_hi(t[u][j][k].x), bf_lo(t[u][j][k].y), bf_hi(t[u][j][k].y)} * wk[u][k];
                v[j] = x1v[u][j] + *(const f32x4*)(g2v + n) * y;
                ss += (v[j][0] * v[j][0] + v[j][1] * v[j][1]) + (v[j][2] * v[j][2] + v[j][3] * v[j][3]); }
            const float rstd = rsqrtf(wave_sum(ss) * (1.0f / D) + 1e-6f);
#pragma unroll
            for (int j = 0; j < 8; ++j) { const int n = 4 * F.lane + 256 * j; *(f32x4*)(F.out + (size_t)m * D + n) = v[j] * (rstd * tscale) * *(const f32x4*)(fg + n); }
        }
    }
}

__device__ __forceinline__ void phase_skew(int bx, unsigned step_ticks) {
    const unsigned long long t0 = __builtin_amdgcn_s_memrealtime(), dt = (unsigned long long)((bx >> 3) & 7) * step_ticks;
    while (__builtin_amdgcn_s_memrealtime() - t0 < dt) __builtin_amdgcn_s_sleep(8);
}
#ifndef MK_KREP9
#define MK_KREP9 1
#endif
#ifndef MK_SKEW2
#define MK_SKEW2 0
#endif
#ifndef MK_SKEW9
#define MK_SKEW9 0
#endif
#ifndef MK_SKEW10
#define MK_SKEW10 0
#endif
struct Args { const float* in[24]; float* out; unsigned char* ws; int ph_lo, ph_hi; };
constexpr int NPH = 12;
__global__ void __launch_bounds__(512, 2) mk_fwd(Args args) {
    extern __shared__ __attribute__((aligned(16))) unsigned char lds[];
    Frame F;
    F.lds = (LAS unsigned char*)lds; F.MISC = (volatile LAS unsigned*)(F.lds + MISC_OFF);
    const int wave0 = __builtin_amdgcn_readfirstlane((int)threadIdx.x >> 6);
    F.lane = pg8::lane_id(); F.wave = wave0; F.tid = wave0 * 64 + F.lane; F.G = gridDim.x; F.bx = blockIdx.x;
    F.ws = args.ws; F.ctl = (unsigned*)(args.ws + WS_CTL); F.out = args.out;
    F.in = (const __attribute__((address_space(4))) fptr_t*)__builtin_amdgcn_kernarg_segment_ptr();
    for (int u = F.tid; u < (LDS_BYTES - MISC_OFF) / 4; u += 512) ((LAS unsigned*)(F.lds + MISC_OFF))[u] = 0u;
    __syncthreads();
    const int lo = args.ph_lo, hi = args.ph_hi;
    const bool multi = (hi - lo) > 1;
    XcdBarrier bar; bar.bar = F.ctl + CW_BAR; bar.x = 0; bar.st = nullptr;
    if (multi) bar = xcd_barrier_post(F.ctl + CW_BAR, F.MISC + 8, F.tid);
#ifndef MK_PHMASK
#define MK_PHMASK 0xfff
#endif
#define IN(k) (((MK_PHMASK >> (k)) & 1) && lo <= (k) && (k) < hi)
#define SEAM(k) do { if (IN(k) && IN((k) + 1)) xcd_barrier(bar, wave0 * 64 + pg8::lane_id()); \
    if (MK_TPROBE >= 0 && F.bx == 0 && wave0 == 0 && pg8::lane_id() == 0) { const unsigned long long t_ = __builtin_amdgcn_s_memrealtime(); __hip_atomic_store(F.ctl + 3000 + 2 * ((k) + 1), (unsigned)t_, RLX_AGENT); } } while (0)
    LAS int* tp = (LAS int*)(F.lds + MISC_OFF + 256);
#ifndef MK_REPMASK
#define MK_REPMASK 0x0
#ifndef MK_TPROBE
#define MK_TPROBE -1
#endif
#ifndef MK_FP8_PROJ
#define MK_FP8_PROJ 1
#endif
#ifndef MK_FP8_INPROJ
#define MK_FP8_INPROJ 1
#endif
#endif
#define REP(k) for (int rep_ = 0; rep_ < (((MK_REPMASK >> (k)) & 1) ? 2 : 1); ++rep_)
#define PHASE_IDS() do { int l_ = pg8::lane_id(); asm volatile("" : "+v"(l_)); F.lane = l_; F.wave = wave0; F.tid = wave0 * 64 + l_; } while (0)

    if (MK_TPROBE >= 0 && F.bx == 0 && F.tid == 0) __hip_atomic_store(F.ctl + 3000, (unsigned)__builtin_amdgcn_s_memrealtime(), RLX_AGENT);
    const int grp_ = F.bx >> 3; const bool split_ = MK_SPLIT && F.G == 256, conv_ = split_ && grp_ >= 32 - MK_SPLIT_NCG;
    const int bx0_ = F.bx, G0_ = F.G, crank_ = F.bx - 8 * (32 - MK_SPLIT_NCG);
    if (IN(0)) REP(0) { PHASE_IDS(); p0_prologue(F, !split_); } SEAM(0);
    if (split_) F.G = 8 * (32 - MK_SPLIT_NCG);
    if (IN(1)) REP(1) { PHASE_IDS(); if (conv_) p0_moe_items(F, crank_ * 8 + F.wave, 64 * MK_SPLIT_NCG, 0, MK_SPLIT_A); else { if (F.bx < 32) p1_router_const(F); p1_rows(F); } } SEAM(1);
    if (IN(2)) REP(2) { PHASE_IDS();
        if (conv_) p0_moe_items(F, crank_ * 8 + F.wave, 64 * MK_SPLIT_NCG, MK_SPLIT_A, MOE_ITEMS); else {
        if (MK_SKEW2) phase_skew(F.bx, MK_SKEW2);
        pg8::Gemm g{(const bf16_t*)(F.ws + WS_HB), (const bf16_t*)(F.ws + WS_WIN), D, nullptr, nullptr}; pg8::StaticOrder So; So.init(MR, INW, F.G, F.bx);
        pg8::EpiInProj E{(bf16_t*)(F.ws + WS_YB), INW, MK_FP8_INPROJ ? 1.0f / (W8_SCALE * H8_SCALE) : 1.0f, C_VR / 256, NTOK / 256, F.ws + WS_G8, H8_SCALE, (bf16_t*)(F.ws + WS_KV)};
        pg8::gemm_phase<pg8::EpiInProj, pg8::StaticOrder, true, true, MK_FP8_INPROJ != 0>(F.lds, g, So, E, F.wave); }
    } SEAM(2);
    F.bx = bx0_; F.G = G0_;
    if (IN(3)) REP(3) { PHASE_IDS();
        ConvCur cv; cv.cur = (F.bx * 8 + F.wave) * CONV_PER_WAVE; cv.end = cv.cur + CONV_PER_WAVE;
        if (F.G != 256) { cv.cur = (int)(((long)CONV_TOTAL * (F.bx * 8 + F.wave)) / (F.G * 8)); cv.end = (int)(((long)CONV_TOTAL * (F.bx * 8 + F.wave + 1)) / (F.G * 8)); }
        REP(12) for (int u = F.bx; u < 256; u += F.G) { const int x = u & 7, jj = u >> 3; ret_unit(F, (x + 8 * (jj >> 3)) >> 3, (x + 8 * (jj >> 3)) & 7, (jj & 7) >> 2, jj & 3, cv); }
        REP(13) { int par = 0; __syncthreads();
            for (int i = 0; ; ++i) { const int L_ = i * F.G + F.bx; if (L_ >= 1024) break; const int c = L_ % 256, ii = L_ / 256; const int Ln = L_ + F.G, cn = Ln % 256, in_ = Ln / 256;
                par = na_unit(F, (16 * ii + (c & 15)) >> 4, (16 * ii + (c & 15)) & 15, c >> 4, par, i == 0, Ln < 1024, (16 * in_ + (cn & 15)) >> 4, (16 * in_ + (cn & 15)) & 15, cn >> 4); } }
        for (; cv.cur < cv.end; ++cv.cur) { float r[16]; conv_issue(F, cv.cur, r); conv_commit(F, cv.cur, r); }
        __syncthreads();
    } SEAM(3);
    if (IN(4)) REP(4) { PHASE_IDS(); p4_rows(F); } SEAM(4);
    if (IN(5)) REP(5) { PHASE_IDS();
        pg8::StaticOrder So; So.init(NTOK, D, F.G, F.bx);
#if MK_FP8_PROJ
        pg8::ChainOrder Sc; Sc.init(NTOK, D, F.G, F.bx);
        pg8::Gemm g{(const bf16_t*)(F.ws + WS_HB), (const bf16_t*)(F.ws + WS_WPA), D, (const bf16_t*)(F.ws + WS_NAOB), (const bf16_t*)(F.ws + WS_WPB)};
        pg8::EpiMerge8 E{F.ws + WS_OF, D, F.ws + WS_G8 + 2048, F.ws + WS_G8 + 4096, G8W, 1.0f / (W8_SCALE * H8_SCALE), H8_SCALE, 1.0f / H8_SCALE};
        pg8::gemm_phase<pg8::EpiMerge8, pg8::ChainOrder, true, true, true>(F.lds, g, Sc, E, F.wave);
#else
        { pg8::Gemm g{(const bf16_t*)(F.ws + WS_HB), (const bf16_t*)(F.ws + WS_WPA), D, nullptr, nullptr}; pg8::EpiGate<false, false> E{(bf16_t*)(F.ws + WS_T1), D, (const bf16_t*)(F.ws + WS_YB) + C_GA, INW, 1.0f, nullptr, 1.0f};
          pg8::gemm_phase<pg8::EpiGate<false, false>, pg8::StaticOrder, true, true, false>(F.lds, g, So, E, F.wave); }
        { pg8::Gemm g{(const bf16_t*)(F.ws + WS_NAOB), (const bf16_t*)(F.ws + WS_WPB), D, nullptr, nullptr}; pg8::EpiGate<true, false> E{(bf16_t*)(F.ws + WS_T1), D, (const bf16_t*)(F.ws + WS_YB) + C_GB, INW, 1.0f, nullptr, 1.0f};
          pg8::gemm_phase<pg8::EpiGate<true, false>, pg8::StaticOrder, true, true, false>(F.lds, g, So, E, F.wave); }
#endif
    } SEAM(5);
    if (IN(6)) REP(6) { PHASE_IDS();
        constexpr bool P8 = MK_FP8_PROJ != 0;
        pg8::Gemm g{(const bf16_t*)(F.ws + (P8 ? WS_OF : WS_T1)), (const bf16_t*)(F.ws + WS_WO), D, nullptr, nullptr}; pg8::StaticOrder So; So.init(NTOK, D, F.G, F.bx);
        pg8::EpiResid E{F.in[0], (bf16_t*)(F.ws + WS_X1B), D, (const float*)(F.ws + WS_MOD) + 2 * D, MODW, S, P8 ? 1.0f / (W8_SCALE * H8_SCALE) : 1.0f};
        pg8::gemm_phase<pg8::EpiResid, pg8::StaticOrder, true, true, P8>(F.lds, g, So, E, F.wave);
    } SEAM(6);
    if (IN(7)) REP(7) { PHASE_IDS(); p7_route(F); } SEAM(7);
    if (IN(9)) REP(9) { PHASE_IDS();
        load_tp(F, tp);
        if (MK_SKEW9) phase_skew(F.bx, MK_SKEW9);
        pg8::Gemm g{(const bf16_t*)(F.ws + WS_HB), (const bf16_t*)(F.ws + WS_WGU), D, nullptr, nullptr, (const unsigned short*)(F.ws + WS_TOKL)}; pg8::GroupedOrder So; So.init(16, F.G, F.bx, tp, tp + 64, F.tid);
        pg8::EpiSwiglu8 E{F.ws + WS_ACTB, FF, F.in[18], F.in[20], FF, 1.0f / (W8_SCALE * H8_SCALE * MK_KREP9), A8_SCALE};
        pg8::gemm_phase<pg8::EpiSwiglu8, pg8::GroupedOrder, true, true, true, MK_KREP9, true>(F.lds, g, So, E, F.wave);
    } SEAM(9);
    if (IN(10)) REP(10) { PHASE_IDS();
        load_tp(F, tp);
        if (MK_SKEW10) phase_skew(F.bx, MK_SKEW10);
        pg8::Gemm g{(const bf16_t*)(F.ws + WS_ACTB), (const bf16_t*)(F.ws + WS_WDN), FF, nullptr, nullptr}; pg8::GroupedOrder So; So.init(8, F.G, F.bx, tp, tp + 64, F.tid);
        pg8::EpiBf16B E{(bf16_t*)(F.ws + WS_XB), D, F.in[22], D, 1.0f / (W8_SCALE * A8_SCALE)};
        pg8::gemm_phase<pg8::EpiBf16B, pg8::GroupedOrder, true, true, true>(F.lds, g, So, E, F.wave);
    } SEAM(10);
    if (IN(11)) REP(11) { PHASE_IDS(); load_tp(F, tp); p11_final(F, tp); }
#undef IN
#undef SEAM
}
}

extern "C" void kernel_launch(void* const* d_in, const int* in_sizes, int n_in, void* d_out, int out_size, void* d_ws, size_t ws_size, hipStream_t stream) {
    using namespace mk;
    (void)in_sizes; (void)n_in; (void)out_size; (void)ws_size;
    static int grid = 0;
    if (grid == 0) {
        int dev = 0, cus = 0, per_cu = 0;
        if (hipGetDevice(&dev) != hipSuccess || hipDeviceGetAttribute(&cus, hipDeviceAttributeMultiprocessorCount, dev) != hipSuccess) { grid = -1; return; }
        if (hipFuncSetAttribute((const void*)mk_fwd, hipFuncAttributeMaxDynamicSharedMemorySize, LDS_BYTES) != hipSuccess) { fprintf(stderr, "kernel_launch: hipFuncSetAttribute failed\n"); grid = -1; return; }
        if (hipOccupancyMaxActiveBlocksPerMultiprocessor(&per_cu, (const void*)mk_fwd, 512, LDS_BYTES) != hipSuccess || per_cu < 1) fprintf(stderr, "kernel_launch: occupancy query reports %d\n", per_cu);
        (void)hipGetLastError();
        grid = cus;
    }
    if (grid < 0) return;
    unsigned char* ws = (unsigned char*)d_ws;
    (void)hipMemsetAsync(ws + WS_CTL, 0, CTL_ZERO_BYTES, stream);
    Args a{};
    for (int i = 0; i < 24; ++i) a.in[i] = (const float*)d_in[i];
    a.out = (float*)d_out; a.ws = ws;
    auto run = [&](int lo, int hi) { a.ph_lo = lo; a.ph_hi = hi; hipLaunchKernelGGL(mk_fwd, dim3(grid), dim3(512), LDS_BYTES, stream, a); };
    run(0, NPH);
}
```
